# Optimizing an MI355X kernel written in HIP

```python
import math
import jax
import jax.numpy as jnp
from jax import lax
import numpy as np

D_MODEL = 2048
BATCH = 8
SEQ = 2048
DEPTH = 2

CHUNK = 64
N_MEM = 256
N_A_LAYERS = DEPTH // 2
N_B_LAYERS = DEPTH - N_A_LAYERS
MIX_WIDTH = D_MODEL
MAIN_WIDTH = 3 * MIX_WIDTH // 4
MEM_WIDTH = MIX_WIDTH - MAIN_WIDTH
HEAD_DIM = 128
SSM_GROUP = 16
SSM_GROUPS = MAIN_WIDTH // SSM_GROUP
SSM_STATE = 64
FOX_HEADS = MAIN_WIDTH // HEAD_DIM
MEM_HEADS = 4
MEM_HEAD_DIM = MEM_WIDTH // MEM_HEADS
Q_BLOCK = 128
IN_WIDTH = 2 * MAIN_WIDTH + 2 * MEM_WIDTH
EPS = 1e-6
DT_MIN = 1e-3
DT_MAX = 1e-1

kernel_name = "yoco_s5_fox_memory_hybrid"


def rmsnorm(x, g):
    xf = x.astype(jnp.float32)
    y = xf * lax.rsqrt(jnp.mean(xf * xf, axis=-1, keepdims=True) + EPS) * g.astype(jnp.float32)
    return y.astype(x.dtype)


def _scan_binop(e1, e2):
    a1r, a1i, b1r, b1i = e1
    a2r, a2i, b2r, b2i = e2
    ar = a2r * a1r - a2i * a1i
    ai = a2r * a1i + a2i * a1r
    br = a2r * b1r - a2i * b1i + b2r
    bi = a2r * b1i + a2i * b1r + b2i
    return (ar, ai, br, bi)


def s5_ssm(u, lam_re, lam_im, log_step, b_re, b_im, c_re, c_im, d_skip):
    bsz, seqlen, _ = u.shape
    uf = u.astype(jnp.float32)
    ug = uf.reshape(bsz, seqlen, SSM_GROUPS, SSM_GROUP)
    lr = lam_re.astype(jnp.float32)
    li = lam_im.astype(jnp.float32)
    dt = jnp.exp(log_step.astype(jnp.float32))[:, None]
    mag = jnp.exp(lr * dt)
    ar = mag * jnp.cos(li * dt)
    ai = mag * jnp.sin(li * dt)
    den = lr * lr + li * li
    cr = ((ar - 1.0) * lr + ai * li) / den
    ci = (ai * lr - (ar - 1.0) * li) / den
    br = b_re.astype(jnp.float32)
    bi = b_im.astype(jnp.float32)
    bbar_re = cr[..., None] * br - ci[..., None] * bi
    bbar_im = cr[..., None] * bi + ci[..., None] * br
    bu_re = jnp.einsum('blgh,gph->blgp', ug, bbar_re)
    bu_im = jnp.einsum('blgh,gph->blgp', ug, bbar_im)
    a_re = jnp.broadcast_to(ar[None, None], (1, seqlen, SSM_GROUPS, SSM_STATE))
    a_im = jnp.broadcast_to(ai[None, None], (1, seqlen, SSM_GROUPS, SSM_STATE))
    _, _, x_re, x_im = lax.associative_scan(_scan_binop, (a_re, a_im, bu_re, bu_im), axis=1)
    y = (jnp.einsum('blgp,ghp->blgh', x_re, c_re.astype(jnp.float32))
         - jnp.einsum('blgp,ghp->blgh', x_im, c_im.astype(jnp.float32)))
    y = y.reshape(bsz, seqlen, MAIN_WIDTH) + d_skip.astype(jnp.float32) * uf
    return y.astype(u.dtype)


def memory_attention(qm, mem, mem_g, w_mem_kv):
    bsz, seqlen, _ = qm.shape
    memn = rmsnorm(mem, mem_g)
    kv = memn @ w_mem_kv
    km, vm = jnp.split(kv, 2, axis=-1)
    km = km.reshape(bsz, -1, MEM_HEADS, MEM_HEAD_DIM).astype(jnp.float32)
    vm = vm.reshape(bsz, -1, MEM_HEADS, MEM_HEAD_DIM).astype(jnp.float32)
    q = qm.reshape(bsz, seqlen, MEM_HEADS, MEM_HEAD_DIM).astype(jnp.float32) * (MEM_HEAD_DIM ** -0.5)
    s = jnp.einsum('blhd,bmhd->bhlm', q, km)
    p = jax.nn.softmax(s, axis=-1)
    o = jnp.einsum('bhlm,bmhd->blhd', p, vm)
    return o.reshape(bsz, seqlen, MEM_WIDTH).astype(qm.dtype)


def forgetting_attention(q, k, v, fcum):
    _, seqlen, _, dh = q.shape
    qf = q.astype(jnp.float32) * (dh ** -0.5)
    kf = k.astype(jnp.float32)
    vf = v.astype(jnp.float32)
    outs = []
    for blk in range(seqlen // Q_BLOCK):
        q0 = blk * Q_BLOCK
        q1 = q0 + Q_BLOCK
        s = jnp.einsum('bqhd,bkhd->bhqk', qf[:, q0:q1], kf[:, :q1])
        s = s + fcum[:, :, q0:q1, None] - fcum[:, :, None, :q1]
        causal = jnp.arange(q0, q1)[:, None] >= jnp.arange(q1)[None, :]
        s = jnp.where(causal, s, -jnp.inf)
        p = jax.nn.softmax(s, axis=-1)
        outs.append(jnp.einsum('bhqk,bkhd->bqhd', p, vf[:, :q1]))
    return jnp.concatenate(outs, axis=1).astype(q.dtype)


def setup_inputs(seed: int = 0) -> dict:
    key = jax.random.key(seed)
    ks = jax.random.split(key, 32)
    f32 = jnp.float32
    D = D_MODEL
    nrm = lambda k, shape, scale: jax.random.normal(k, shape, f32) * scale
    x = jax.random.normal(ks[0], (BATCH, SEQ, D), f32)
    mem = jax.random.normal(ks[1], (BATCH, N_MEM, D), f32)
    pre_norm_g = 1.0 + nrm(ks[2], (DEPTH, D), 0.02)
    post_norm_g = 1.0 + nrm(ks[3], (DEPTH, D), 0.02)
    w_in_a = nrm(ks[4], (N_A_LAYERS, D, IN_WIDTH), D ** -0.5)
    lam_re = -0.5 + nrm(ks[5], (N_A_LAYERS, SSM_GROUPS, SSM_STATE), 0.01)
    lam_im = (math.pi * jnp.arange(SSM_STATE, dtype=f32))[None, None, :] + nrm(ks[6], (N_A_LAYERS, SSM_GROUPS, SSM_STATE), 0.01)
    log_step = jax.random.uniform(ks[7], (N_A_LAYERS, SSM_GROUPS), f32, math.log(DT_MIN), math.log(DT_MAX))
    b_re = nrm(ks[8], (N_A_LAYERS, SSM_GROUPS, SSM_STATE, SSM_GROUP), (2.0 * SSM_GROUP) ** -0.5)
    b_im = nrm(ks[9], (N_A_LAYERS, SSM_GROUPS, SSM_STATE, SSM_GROUP), (2.0 * SSM_GROUP) ** -0.5)
    c_re = nrm(ks[10], (N_A_LAYERS, SSM_GROUPS, SSM_GROUP, SSM_STATE), (2.0 * SSM_STATE) ** -0.5)
    c_im = nrm(ks[11], (N_A_LAYERS, SSM_GROUPS, SSM_GROUP, SSM_STATE), (2.0 * SSM_STATE) ** -0.5)
    d_skip = nrm(ks[12], (N_A_LAYERS, MAIN_WIDTH), 1.0)
    w_glu = nrm(ks[13], (N_A_LAYERS, MAIN_WIDTH, MAIN_WIDTH), MAIN_WIDTH ** -0.5)
    b_glu = nrm(ks[14], (N_A_LAYERS, MAIN_WIDTH), 0.01)
    kv_norm_g = 1.0 + nrm(ks[15], (D,), 0.02)
    w_kv = nrm(ks[16], (D, 2 * MAIN_WIDTH), D ** -0.5)
    w_fgate = nrm(ks[17], (D, FOX_HEADS), D ** -0.5)
    b_fgate = nrm(ks[18], (FOX_HEADS,), 0.1)
    w_in_b = nrm(ks[19], (N_B_LAYERS, D, IN_WIDTH), D ** -0.5)
    mem_norm_g = 1.0 + nrm(ks[20], (DEPTH, D), 0.02)
    w_mem_kv = nrm(ks[21], (DEPTH, D, 2 * MEM_WIDTH), D ** -0.5)
    w_out = nrm(ks[22], (DEPTH, MIX_WIDTH, D), MIX_WIDTH ** -0.5)
    return {"x": x, "mem": mem, "pre_norm_g": pre_norm_g, "post_norm_g": post_norm_g,
            "w_in_a": w_in_a, "lam_re": lam_re, "lam_im": lam_im, "log_step": log_step,
            "b_re": b_re, "b_im": b_im, "c_re": c_re, "c_im": c_im, "d_skip": d_skip,
            "w_glu": w_glu, "b_glu": b_glu, "kv_norm_g": kv_norm_g, "w_kv": w_kv,
            "w_fgate": w_fgate, "b_fgate": b_fgate, "w_in_b": w_in_b,
            "mem_norm_g": mem_norm_g, "w_mem_kv": w_mem_kv, "w_out": w_out}


def reference(x, mem, pre_norm_g, post_norm_g, w_in_a, lam_re, lam_im, log_step,
              b_re, b_im, c_re, c_im, d_skip, w_glu, b_glu, kv_norm_g, w_kv,
              w_fgate, b_fgate, w_in_b, mem_norm_g, w_mem_kv, w_out):
    bsz, seqlen, _ = x.shape
    h = x
    k_sh = v_sh = fcum = None
    split_pts = [MAIN_WIDTH, 2 * MAIN_WIDTH, 2 * MAIN_WIDTH + MEM_WIDTH]
    for i in range(DEPTH):
        hn = rmsnorm(h, pre_norm_g[i])
        if i < N_A_LAYERS:
            la = i
            proj = hn @ w_in_a[la]
            u, z, qm, zm = jnp.split(proj, split_pts, axis=-1)
            y = s5_ssm(u, lam_re[la], lam_im[la], log_step[la], b_re[la], b_im[la],
                       c_re[la], c_im[la], d_skip[la])
            yg = jax.nn.gelu(y)
            y = yg * jax.nn.sigmoid(yg @ w_glu[la] + b_glu[la])
            main = y * jax.nn.silu(z)
        else:
            lb = i - N_A_LAYERS
            proj = hn @ w_in_b[lb]
            q, z, qm, zm = jnp.split(proj, split_pts, axis=-1)
            q = q.reshape(bsz, seqlen, FOX_HEADS, HEAD_DIM)
            att = forgetting_attention(q, k_sh, v_sh, fcum).reshape(bsz, seqlen, MAIN_WIDTH)
            main = att * jax.nn.silu(z)
        memo = memory_attention(qm, mem, mem_norm_g[i], w_mem_kv[i]) * jax.nn.silu(zm)
        o = jnp.concatenate([main, memo], axis=-1) @ w_out[i]
        h = h + rmsnorm(o, post_norm_g[i])
        if i == N_A_LAYERS - 1:
            kv_in = rmsnorm(h, kv_norm_g)
            kv = kv_in @ w_kv
            k_sh, v_sh = jnp.split(kv, 2, axis=-1)
            k_sh = k_sh.reshape(bsz, seqlen, FOX_HEADS, HEAD_DIM)
            v_sh = v_sh.reshape(bsz, seqlen, FOX_HEADS, HEAD_DIM)
            logf = jax.nn.log_sigmoid((kv_in @ w_fgate).astype(jnp.float32) + b_fgate.astype(jnp.float32))
            fcum = jnp.transpose(jnp.cumsum(logf, axis=1), (0, 2, 1))
    return h
```

```cpp
#include <hip/hip_runtime.h>
#include <hip/hip_bf16.h>
#include <hip/hip_cooperative_groups.h>
#include <cstdio>
#include <cstdint>
namespace cg = cooperative_groups;
__device__ __forceinline__ int opaque_tid() { int t = threadIdx.x; asm volatile("" : "+v"(t)); return t; }
namespace pg8 {
#define PG8_LAS __attribute__((address_space(3)))
typedef unsigned short bf16_t;
typedef short bf16x8 __attribute__((ext_vector_type(8)));
typedef float f32x4 __attribute__((ext_vector_type(4)));
typedef unsigned u32x4 __attribute__((ext_vector_type(4)));
constexpr int BM = 256, BK = 64, HALF = 128, HTB = HALF * BK * 2  , STAGE_BYTES = 8 * HTB, NXCD = 8, WGM = 8;

__host__ __device__ __forceinline__ int lds_byte(int r, int c) { const int st = (r >> 4) * 2 + (c >> 5), rr = r & 15, cc = c & 31, ob = rr * 64 + cc * 2; return st * 1024 + (ob ^ (((ob >> 9) & 1) << 5)); }
__host__ __device__ __forceinline__ void stage_rc(int b, int& R, int& C) { const int st = b / 1024, sb = b % 1024, swz = sb ^ (((sb >> 9) & 1) << 5); R = (st >> 1) * 16 + swz / 64; C = (st & 1) * 32 + (swz % 64) / 2; }
__host__ __device__ __forceinline__ int perm32(int rho) { const int n = rho >> 4, i = rho & 15; return 8 * (i >> 2) + 4 * n + (i & 3); }

struct Unit { int pm, pn; };
struct Gemm { const bf16_t* A; const bf16_t* Bt; int M, N, K; };

struct StaticOrder {
    int nM, nN, nwg, G, c;
    __host__ __device__ void init(int M, int N, int G_, int c_) { nM = M / BM; nN = N / BM; nwg = nM * nN; G = G_; c = c_; }
    __host__ __device__ bool next(int i, Unit& u) const {
        const long L = (long)i * G + c; if (L >= nwg) return false;
        int wgid = (int)L; { const int q = nwg / NXCD, r = nwg % NXCD, xcd = wgid % NXCD, off = wgid / NXCD; wgid = (xcd < r ? xcd * (q + 1) : r * (q + 1) + (xcd - r) * q) + off; }
        const int nig = WGM * nN, gid = wgid / nig, fm = gid * WGM, gsz = (nM - fm) < WGM ? (nM - fm) : WGM;
        u.pm = fm + ((wgid % nig) % gsz); u.pn = (wgid % nig) / gsz; return true;
    }
    __device__ __forceinline__ void a_ready(const Unit&) const {}
    __device__ __forceinline__ void done(const Unit&) const {}
};

__device__ __forceinline__ unsigned cvt_pk_bf16(float lo, float hi) { unsigned r; asm volatile("v_cvt_pk_bf16_f32 %0, %1, %2" : "=v"(r) : "v"(lo), "v"(hi)); return r; }
__device__ __forceinline__ float sigmoid_f(float v) { return __builtin_amdgcn_rcpf(1.f + __builtin_amdgcn_exp2f(-1.4426950408889634f * v)); }
__device__ __forceinline__ float silu_f(float v) { return v * sigmoid_f(v); }
__device__ __forceinline__ float bf_lo(unsigned w) { return __uint_as_float(w << 16); }
__device__ __forceinline__ float bf_hi(unsigned w) { return __uint_as_float(w & 0xffff0000u); }

__device__ __forceinline__ float xfq_sum(float v) {
    { auto r = __builtin_amdgcn_permlane16_swap(__float_as_uint(v), __float_as_uint(v), false, false); v = __uint_as_float(r[0]) + __uint_as_float(r[1]); }
    { auto r = __builtin_amdgcn_permlane32_swap(__float_as_uint(v), __float_as_uint(v), false, false); v = __uint_as_float(r[0]) + __uint_as_float(r[1]); }
    return v;
}
struct SecInfo { bf16_t* dst; int start; int ld; int nh; int act; float* nrm; };
template <class Sel> struct EpiProj {
    static constexpr bool PERM = true, AFTER_DRAIN = false;
    const float* rstd; Sel sel; int lgS;
    __device__ __forceinline__ void operator()(const f32x4 (&acc)[2][2][4][2], const Unit& u, int wr, int wc, int fr, int fq) const {
        const int row0 = u.pm * BM + wr * 64 + fr, cin = wc * 32 + 8 * fq;
        float rsv[2][4];
#pragma unroll
        for (int ai = 0; ai < 2; ++ai)
#pragma unroll
            for (int m = 0; m < 4; ++m) rsv[ai][m] = rstd[row0 + ai * HALF + m * 16];
#pragma unroll
        for (int bj = 0; bj < 2; ++bj) {
            const int cs = u.pn * BM + bj * HALF; const SecInfo si = sel(cs);
#pragma unroll
            for (int ai = 0; ai < 2; ++ai)
#pragma unroll
                for (int m = 0; m < 4; ++m) {
                    const int row = row0 + ai * HALF + m * 16; const float rs = rsv[ai][m];
                    f32x4 v0 = acc[ai][bj][m][0] * rs, v1 = acc[ai][bj][m][1] * rs;
                    if (si.act) {
#pragma unroll
                        for (int e = 0; e < 4; ++e) { v0[e] = silu_f(v0[e]); v1[e] = silu_f(v1[e]); } }
                    bf16_t* p;
                    if (si.nh) { const int b = row >> lgS, s = row & ((1 << lgS) - 1); const size_t hr = (((size_t)(b * si.nh + ((cs - si.start) >> 7))) << lgS) + s; p = si.dst + hr * 128 + cin;
                        if (si.nrm) { float q = (v0[0] * v0[0] + v0[1] * v0[1]) + (v0[2] * v0[2] + v0[3] * v0[3]) + (v1[0] * v1[0] + v1[1] * v1[1]) + (v1[2] * v1[2] + v1[3] * v1[3]);
                            q = xfq_sum(q); if (fq == 0) atomicAdd(si.nrm + hr, q); } }
                    else p = si.dst + (size_t)row * si.ld + (cs - si.start) + cin;
                    u32x4 w; w.x = cvt_pk_bf16(v0[0], v0[1]); w.y = cvt_pk_bf16(v0[2], v0[3]); w.z = cvt_pk_bf16(v1[0], v1[1]); w.w = cvt_pk_bf16(v1[2], v1[3]);
                    *(u32x4*)p = w;
                }
        }
    }
};
struct EpiGlu {
    static constexpr bool PERM = true, AFTER_DRAIN = false;
    const bf16_t* yg; const bf16_t* sz; const float* bias; bf16_t* cat;
    __device__ __forceinline__ void operator()(const f32x4 (&acc)[2][2][4][2], const Unit& u, int wr, int wc, int fr, int fq) const {
        const int row0 = u.pm * BM + wr * 64 + fr, col0 = u.pn * BM + wc * 32 + 8 * fq;
#pragma unroll
        for (int bj = 0; bj < 2; ++bj) {
            const int col = col0 + bj * HALF; const f32x4 b0 = *(const f32x4*)(bias + col), b1 = *(const f32x4*)(bias + col + 4);
#pragma unroll
            for (int ai = 0; ai < 2; ++ai) {
                u32x4 yv[4], zv[4];
#pragma unroll
                for (int m = 0; m < 4; ++m) { const int row = row0 + ai * HALF + m * 16;
                    yv[m] = *(const u32x4*)(yg + (size_t)row * 1536 + col); zv[m] = *(const u32x4*)(sz + (size_t)row * 2048 + col); }
#pragma unroll
                for (int m = 0; m < 4; ++m) {
                    const int row = row0 + ai * HALF + m * 16;
                    const u32x4 y = yv[m], z = zv[m];
                    const f32x4 g0 = acc[ai][bj][m][0] + b0, g1 = acc[ai][bj][m][1] + b1;
                    float o[8];
                    o[0] = bf_lo(y.x) * bf_lo(z.x) * sigmoid_f(g0[0]); o[1] = bf_hi(y.x) * bf_hi(z.x) * sigmoid_f(g0[1]);
                    o[2] = bf_lo(y.y) * bf_lo(z.y) * sigmoid_f(g0[2]); o[3] = bf_hi(y.y) * bf_hi(z.y) * sigmoid_f(g0[3]);
                    o[4] = bf_lo(y.z) * bf_lo(z.z) * sigmoid_f(g1[0]); o[5] = bf_hi(y.z) * bf_hi(z.z) * sigmoid_f(g1[1]);
                    o[6] = bf_lo(y.w) * bf_lo(z.w) * sigmoid_f(g1[2]); o[7] = bf_hi(y.w) * bf_hi(z.w) * sigmoid_f(g1[3]);
                    u32x4 w; w.x = cvt_pk_bf16(o[0], o[1]); w.y = cvt_pk_bf16(o[2], o[3]); w.z = cvt_pk_bf16(o[4], o[5]); w.w = cvt_pk_bf16(o[6], o[7]);
                    *(u32x4*)(cat + (size_t)row * 2048 + col) = w;
                }
            }
        }
    }
};
struct EpiOut {
    static constexpr bool PERM = true, AFTER_DRAIN = false;
    bf16_t* o; float* rowsq;
    __device__ __forceinline__ void operator()(const f32x4 (&acc)[2][2][4][2], const Unit& u, int wr, int wc, int fr, int fq) const {
        const int row0 = u.pm * BM + wr * 64 + fr, col0 = u.pn * BM + wc * 32 + 8 * fq;
#pragma unroll
        for (int ai = 0; ai < 2; ++ai)
#pragma unroll
            for (int m = 0; m < 4; ++m) {
                const int row = row0 + ai * HALF + m * 16; float s = 0.f;
#pragma unroll
                for (int bj = 0; bj < 2; ++bj) {
                    const f32x4 v0 = acc[ai][bj][m][0], v1 = acc[ai][bj][m][1];
                    s += (v0[0] * v0[0] + v0[1] * v0[1]) + (v0[2] * v0[2] + v0[3] * v0[3]) + (v1[0] * v1[0] + v1[1] * v1[1]) + (v1[2] * v1[2] + v1[3] * v1[3]);
                    u32x4 w; w.x = cvt_pk_bf16(v0[0], v0[1]); w.y = cvt_pk_bf16(v0[2], v0[3]); w.z = cvt_pk_bf16(v1[0], v1[1]); w.w = cvt_pk_bf16(v1[2], v1[3]);
                    *(u32x4*)(o + (size_t)row * 2048 + col0 + bj * HALF) = w;
                }
                s = xfq_sum(s);
                if (fq == 0) atomicAdd(rowsq + row, s);
            }
    }
};

template <class Epi, class Sched, bool ALIGN_EPI = false, bool SP2 = false>
__device__ __forceinline__ void gemm_phase(PG8_LAS unsigned char* lds, const Gemm g, const Sched& S, const Epi& E) {
    const int tid = opaque_tid(), wid = __builtin_amdgcn_readfirstlane(tid >> 6), lane = tid & 63, wr = wid >> 2, wc = wid & 3, fr = lane & 15, fq = lane >> 4;
    const int K = g.K, nt = K / BK;
    unsigned voffA[2], voffB[2];
#pragma unroll
    for (int i = 0; i < 2; ++i) { int R, C; stage_rc(tid * 16 + i * 8192, R, C); const int Rb = Epi::PERM ? ((R & ~31) + perm32(R & 31)) : R;
        voffA[i] = (unsigned)(R * K + C) * 2u; voffB[i] = (unsigned)(Rb * K + C) * 2u; }
    const size_t kstep = (size_t)(BK * 2);
    const size_t hstep = (size_t)HALF * K * 2;
    const size_t tstep = 2 * hstep;
    const unsigned ldsw = (unsigned)wid * 1024u;
    const int aoff = lds_byte(wr * 64 + fr, fq * 8), boff = lds_byte(wc * 32 + fr, fq * 8);
#define PG8_SA(b, h) (((b) * 2 + (h)) * HTB)
#define PG8_SB(b, h) ((4 + (b) * 2 + (h)) * HTB)
#define PG8_STAGE(bufoff, gbase, voff) do { _Pragma("unroll") for (int _i = 0; _i < 2; ++_i) \
        __builtin_amdgcn_global_load_lds((const unsigned*)((const char*)(gbase) + (voff)[_i]), (PG8_LAS unsigned*)(lds + (bufoff) + ldsw + _i * 8192), 16, 0, 0); } while (0)
#define PG8_LDA(dst, b, h) do { _Pragma("unroll") for (int m = 0; m < 4; ++m) _Pragma("unroll") for (int k = 0; k < 2; ++k) dst[m][k] = *(const PG8_LAS bf16x8*)(lds + PG8_SA(b, h) + aoff + m * 2048 + k * 1024); } while (0)
#define PG8_LDB(dst, b, h) do { _Pragma("unroll") for (int n = 0; n < 2; ++n) _Pragma("unroll") for (int k = 0; k < 2; ++k) dst[n][k] = *(const PG8_LAS bf16x8*)(lds + PG8_SB(b, h) + boff + n * 2048 + k * 1024); } while (0)
#define PG8_MMA(ai, bj, At, Bt) do { __builtin_amdgcn_s_setprio(1); _Pragma("unroll") for (int m = 0; m < 4; ++m) _Pragma("unroll") for (int n = 0; n < 2; ++n) _Pragma("unroll") for (int k = 0; k < 2; ++k) \
        acc[ai][bj][m][n] = __builtin_amdgcn_mfma_f32_16x16x32_bf16(Bt[n][k], At[m][k], acc[ai][bj][m][n], 0, 0, 0); __builtin_amdgcn_s_setprio(0); } while (0)
#define PG8_WAIT_V(n) asm volatile("s_waitcnt vmcnt(" #n ")" ::: "memory")
#define PG8_WAIT_L(n) asm volatile("s_waitcnt lgkmcnt(" #n ")" ::: "memory")
#define PG8_BAR __builtin_amdgcn_s_barrier()
#define PG8_SCHED __builtin_amdgcn_sched_barrier(0)
    Unit cur, nxt; int ui = 0;
    if (!S.next(0, cur)) return;
    f32x4 acc[2][2][4][2];
#pragma unroll
    for (int a = 0; a < 2; ++a)
#pragma unroll
        for (int b = 0; b < 2; ++b)
#pragma unroll
            for (int m = 0; m < 4; ++m)
#pragma unroll
                for (int n = 0; n < 2; ++n) acc[a][b][m][n] = (f32x4){0.f, 0.f, 0.f, 0.f};
    bf16x8 At[4][2], B0[2][2], B1[2][2];
    const char* cA = (const char*)g.A + (size_t)cur.pm * tstep; const char* cB = (const char*)g.Bt + (size_t)cur.pn * tstep;
    S.a_ready(cur);
    if constexpr (SP2) {
        PG8_STAGE(PG8_SB(0, 0), cB, voffB); PG8_STAGE(PG8_SB(0, 1), cB + hstep, voffB); PG8_STAGE(PG8_SA(0, 0), cA, voffA); PG8_STAGE(PG8_SA(0, 1), cA + hstep, voffA);
        if (wr == 1) PG8_BAR;
        PG8_WAIT_V(2); PG8_BAR;
        PG8_STAGE(PG8_SB(1, 0), cB + kstep, voffB); PG8_STAGE(PG8_SA(1, 0), cA + kstep, voffA); PG8_STAGE(PG8_SB(1, 1), cB + hstep + kstep, voffB);
        PG8_WAIT_V(6); PG8_BAR;
    } else {
        PG8_STAGE(PG8_SB(0, 0), cB, voffB); PG8_STAGE(PG8_SA(0, 0), cA, voffA); PG8_STAGE(PG8_SB(0, 1), cB + hstep, voffB); PG8_STAGE(PG8_SA(0, 1), cA + hstep, voffA);
        if (wr == 1) PG8_BAR;
        PG8_WAIT_V(4); PG8_BAR;
        PG8_STAGE(PG8_SB(1, 0), cB + kstep, voffB); PG8_STAGE(PG8_SA(1, 0), cA + kstep, voffA); PG8_STAGE(PG8_SB(1, 1), cB + hstep + kstep, voffB);
        PG8_WAIT_V(6); PG8_BAR;
    }
    for (;;) {
        const bool has_next = S.next(ui + 1, nxt);
        const char* nA = has_next ? (const char*)g.A + (size_t)nxt.pm * tstep : cA; const char* nB = has_next ? (const char*)g.Bt + (size_t)nxt.pn * tstep : cB;
        for (int t = 0; t < nt; t += 2) {
            const bool last = (t == nt - 2);
            const char* a1 = cA + (size_t)(t + 1) * kstep;
            const char* a2 = last ? nA : cA + (size_t)(t + 2) * kstep; const char* b2 = last ? nB : cB + (size_t)(t + 2) * kstep;
            const char* a3 = a2 + kstep; const char* b3 = b2 + kstep;
            if (last && has_next) S.a_ready(nxt);
            if constexpr (SP2) {
            PG8_LDB(B0, 0, 0); PG8_LDB(B1, 0, 1); PG8_SCHED; PG8_LDA(At, 0, 0); PG8_STAGE(PG8_SA(1, 1), a1 + hstep, voffA);
            PG8_WAIT_V(8); PG8_WAIT_L(0); PG8_BAR; PG8_MMA(0, 0, At, B0); PG8_MMA(0, 1, At, B1); PG8_BAR; PG8_SCHED;
            PG8_LDA(At, 0, 1); PG8_STAGE(PG8_SB(0, 0), b2, voffB); PG8_STAGE(PG8_SB(0, 1), b2 + hstep, voffB); PG8_STAGE(PG8_SA(0, 0), a2, voffA);
            PG8_WAIT_V(8); PG8_WAIT_L(0); PG8_BAR; PG8_MMA(1, 0, At, B0); PG8_MMA(1, 1, At, B1); PG8_BAR; PG8_SCHED;
            PG8_LDB(B0, 1, 0); PG8_LDB(B1, 1, 1); PG8_SCHED; PG8_LDA(At, 1, 0); PG8_STAGE(PG8_SA(0, 1), a2 + hstep, voffA);
            PG8_WAIT_V(8); PG8_WAIT_L(0); PG8_BAR; PG8_MMA(0, 0, At, B0); PG8_MMA(0, 1, At, B1); PG8_BAR; PG8_SCHED;
            PG8_LDA(At, 1, 1); PG8_STAGE(PG8_SB(1, 0), b3, voffB); PG8_STAGE(PG8_SB(1, 1), b3 + hstep, voffB); PG8_STAGE(PG8_SA(1, 0), a3, voffA);
            PG8_WAIT_V(8); PG8_WAIT_L(0); PG8_BAR; PG8_MMA(1, 0, At, B0); PG8_MMA(1, 1, At, B1); PG8_BAR; PG8_SCHED;
            } else {
            PG8_LDB(B0, 0, 0); PG8_SCHED; PG8_LDA(At, 0, 0); PG8_STAGE(PG8_SA(1, 1), a1 + hstep, voffA);
            PG8_WAIT_L(8); PG8_BAR; PG8_WAIT_L(0); PG8_MMA(0, 0, At, B0); PG8_BAR; PG8_SCHED;
            PG8_LDB(B1, 0, 1); PG8_STAGE(PG8_SB(0, 0), b2, voffB);
            PG8_BAR; PG8_WAIT_L(0); PG8_MMA(0, 1, At, B1); PG8_BAR;
            PG8_LDA(At, 0, 1); PG8_STAGE(PG8_SA(0, 0), a2, voffA);
            PG8_BAR; PG8_WAIT_L(0); PG8_MMA(1, 0, At, B0); PG8_BAR; PG8_SCHED;
            PG8_STAGE(PG8_SB(0, 1), b2 + hstep, voffB);
            PG8_WAIT_V(6); PG8_BAR; PG8_MMA(1, 1, At, B1); PG8_BAR;
            PG8_LDB(B0, 1, 0); PG8_SCHED; PG8_LDA(At, 1, 0); PG8_STAGE(PG8_SA(0, 1), a2 + hstep, voffA);
            PG8_WAIT_L(8); PG8_BAR; PG8_WAIT_L(0); PG8_MMA(0, 0, At, B0); PG8_BAR; PG8_SCHED;
            PG8_LDB(B1, 1, 1); PG8_STAGE(PG8_SB(1, 0), b3, voffB);
            PG8_BAR; PG8_WAIT_L(0); PG8_MMA(0, 1, At, B1); PG8_BAR;
            PG8_LDA(At, 1, 1); PG8_STAGE(PG8_SA(1, 0), a3, voffA);
            PG8_BAR; PG8_WAIT_L(0); PG8_MMA(1, 0, At, B0); PG8_BAR; PG8_SCHED;
            PG8_STAGE(PG8_SB(1, 1), b3 + hstep, voffB);
            PG8_WAIT_V(6); PG8_BAR; PG8_MMA(1, 1, At, B1); PG8_BAR;
            }
        }
        if constexpr (ALIGN_EPI) { if (wr == 0) PG8_BAR; }
        if constexpr (!Epi::AFTER_DRAIN) { E(acc, cur, wr, wc, fr, fq); S.done(cur); }
        if (!has_next) break;
#pragma unroll
        for (int a = 0; a < 2; ++a)
#pragma unroll
            for (int b = 0; b < 2; ++b)
#pragma unroll
                for (int m = 0; m < 4; ++m)
#pragma unroll
                    for (int n = 0; n < 2; ++n) acc[a][b][m][n] = (f32x4){0.f, 0.f, 0.f, 0.f};
        cur = nxt; cA = nA; cB = nB; ++ui;
        if constexpr (ALIGN_EPI) { if (wr == 1) PG8_BAR; }
    }
    PG8_WAIT_V(0);
    if constexpr (!ALIGN_EPI) { if (wr == 0) PG8_BAR; }
    PG8_BAR;
    if constexpr (Epi::AFTER_DRAIN) { E.fused(acc, cur, wr, wc, fr, fq, lds, wid, lane); S.done(cur); }
#undef PG8_SA
#undef PG8_SB
#undef PG8_STAGE
#undef PG8_LDA
#undef PG8_LDB
#undef PG8_MMA
#undef PG8_WAIT_V
#undef PG8_WAIT_L
#undef PG8_BAR
#undef PG8_SCHED
}
}
namespace att {
constexpr int D = 128; constexpr bool WSKIP = false; constexpr float THR = 8.f;
constexpr float SCALE = 0.08838834764831845f;
constexpr int NW = 8, QBLK = 32, KVBLK = 64, QB = NW * QBLK;
constexpr int SHM_V = KVBLK * D * 2, SHM_K = KVBLK * D * 2;
constexpr int FB_OFF = 2 * SHM_V + 2 * SHM_K + NW * 64 * 4;
constexpr int QL_OFF = FB_OFF + 2048 * 4;
constexpr int LDS_BYTES = QL_OFF + NW * QBLK * D * 2;
constexpr int LDO = 2048; constexpr float INV_SCALE = 11.313708498984761f;

using bf16 = __hip_bfloat16;
typedef short bf16x8 __attribute__((ext_vector_type(8)));
typedef short s16x4 __attribute__((ext_vector_type(4)));
typedef float f32x16 __attribute__((ext_vector_type(16)));
typedef float f32x4 __attribute__((ext_vector_type(4)));
typedef unsigned u32x4 __attribute__((ext_vector_type(4)));
template <class A, class Bt> struct same_t { static constexpr bool v = false; };
template <class A> struct same_t<A, A> { static constexpr bool v = true; };

#define KSWZ(row, colB) ((row) * 256 + ((colB) ^ (((row) & 7) << 4)))
#define SBAR() __builtin_amdgcn_sched_barrier(0)
__device__ __forceinline__ int v_st(int k, int c) { const int kk = (k & ~0xC) | ((k & 4) << 1) | ((k & 8) >> 1); return ((kk >> 3) * 4 + (c >> 5)) * 512 + ((kk & 7) * 32 + (c & 31)) * 2; }
__device__ __forceinline__ int v_rd_base(int lane) { return ((lane & 3) << 3) | (((lane >> 2) & 3) << 6) | (((lane >> 4) & 1) << 5) | (((lane >> 5) & 1) << 8); }
constexpr int v_rd_off(int d0, int ks, int half) { return d0 * 512 + ks * 4096 + half * 2048; }
__device__ __forceinline__ int crow(int r, int hi) { return (r & 3) + 8 * (r >> 2) + 4 * hi; }
__device__ __forceinline__ unsigned cvtpk(float lo, float hi) {
    unsigned r; asm volatile("v_cvt_pk_bf16_f32 %0, %1, %2" : "=v"(r) : "v"(lo), "v"(hi)); return r;
}
__device__ __forceinline__ bf16x8 pack8(f32x4 a, f32x4 b) {
    u32x4 w = {cvtpk(a[0], a[1]), cvtpk(a[2], a[3]), cvtpk(b[0], b[1]), cvtpk(b[2], b[3])};
    return *reinterpret_cast<bf16x8*>(&w);
}
template <class T> __device__ __forceinline__ bf16x8 load8(const T* p) {
    if constexpr (same_t<T, float>::v) { return pack8(*(const f32x4*)p, *(const f32x4*)(p + 4)); }
    else { return *reinterpret_cast<const bf16x8*>(p); }
}
__device__ __forceinline__ void mask_tile(f32x16& p0, f32x16& p1, int dq, unsigned W) {
    const float NEG = -__builtin_inff();
#pragma unroll
    for (int r = 0; r < 16; ++r) {
        const int c = (r & 3) + 8 * (r >> 2);
        if ((unsigned)(dq - c) >= W) p0[r] = NEG;
        if ((unsigned)(dq - c - 32) >= W) p1[r] = NEG;
    }
}
__device__ __forceinline__ void partialSM(f32x16& p0, f32x16& p1, float& m_reg, float& mn, float& alpha) {
    float pmax = p0[0]; for (int r = 1; r < 16; ++r) pmax = fmaxf(pmax, p0[r]); for (int r = 0; r < 16; ++r) pmax = fmaxf(pmax, p1[r]);
    { auto rr = __builtin_amdgcn_permlane32_swap(__float_as_uint(pmax), __float_as_uint(pmax), false, false);
      pmax = fmaxf(__uint_as_float(rr[0]), __uint_as_float(rr[1])); }
    constexpr float C2 = 1.4426950408889634f * SCALE;
    if (__builtin_expect(__all((pmax - m_reg) * SCALE <= THR), 1)) { mn = m_reg; alpha = 1.f; }
    else { mn = fmaxf(m_reg, pmax); alpha = __builtin_amdgcn_exp2f((m_reg - mn) * C2); m_reg = mn; }
    const float mnL = -mn * C2;
    for (int r = 0; r < 16; ++r) p0[r] = fmaf(p0[r], C2, mnL); for (int r = 0; r < 16; ++r) p1[r] = fmaf(p1[r], C2, mnL);
    for (int r = 0; r < 16; ++r) p0[r] = __builtin_amdgcn_exp2f(p0[r]);
}
__device__ __forceinline__ void finishSM(f32x16& p0, f32x16& p1, float alpha, float& l_reg, bf16x8& pa0, bf16x8& pa1, bf16x8& pa2, bf16x8& pa3) {
    for (int r = 0; r < 16; ++r) p1[r] = __builtin_amdgcn_exp2f(p1[r]);
    float ps = 0; for (int r = 0; r < 16; ++r) ps += p0[r]; for (int r = 0; r < 16; ++r) ps += p1[r];
    { auto rr = __builtin_amdgcn_permlane32_swap(__float_as_uint(ps), __float_as_uint(ps), false, false);
      ps = __uint_as_float(rr[0]) + __uint_as_float(rr[1]); }
    l_reg = l_reg * alpha + ps;
#define PK4(P, B_, OUT) do { unsigned a0 = cvtpk(P[B_+0], P[B_+1]), a1 = cvtpk(P[B_+2], P[B_+3]);                          \
        unsigned b0 = cvtpk(P[B_+4], P[B_+5]), b1 = cvtpk(P[B_+6], P[B_+7]);                                             \
        auto r0 = __builtin_amdgcn_permlane32_swap(a0, b0, false, false); auto r1 = __builtin_amdgcn_permlane32_swap(a1, b1, false, false); \
        u32x4 w = {r0[0], r1[0], r0[1], r1[1]}; OUT = *reinterpret_cast<bf16x8*>(&w); } while (0)
    PK4(p0, 0, pa0); PK4(p0, 8, pa1); PK4(p1, 0, pa2); PK4(p1, 8, pa3);
#undef PK4
}
template <int KB, bool SK>
__device__ __forceinline__ void qkt(f32x16& p0, f32x16& p1, const char* K_lds, int r32, int hi, const char* q_w, bool act, const float* fbt) {
    if (SK && !act) { const float NEG = -__builtin_inff();
#pragma unroll
        for (int r = 0; r < 16; ++r) { p0[r] = NEG; p1[r] = NEG; } return; }
    {
#pragma unroll
        for (int r4 = 0; r4 < 4; ++r4) { const f32x4 a = *(const f32x4*)(fbt + 8 * r4 + 4 * hi), b = *(const f32x4*)(fbt + 32 + 8 * r4 + 4 * hi);
            p0[4 * r4] = a[0]; p0[4 * r4 + 1] = a[1]; p0[4 * r4 + 2] = a[2]; p0[4 * r4 + 3] = a[3];
            p1[4 * r4] = b[0]; p1[4 * r4 + 1] = b[1]; p1[4 * r4 + 2] = b[2]; p1[4 * r4 + 3] = b[3]; }
    }
    const char* kb[4]; const char* qb[4];
#pragma unroll
    for (int dd = 0; dd < 4; ++dd) { kb[dd] = K_lds + KB * SHM_K + KSWZ(r32, (dd * 16 + hi * 8) * 2); qb[dd] = q_w + KSWZ(r32, (dd * 16 + hi * 8) * 2); }
#pragma unroll
    for (int d0 = 0; d0 < 8; ++d0) { const char* a = kb[d0 & 3] + (d0 >> 2) * 128;
        bf16x8 b0 = *reinterpret_cast<const bf16x8*>(a);
        bf16x8 b1 = *reinterpret_cast<const bf16x8*>(a + 32 * 256);
        bf16x8 qf = *reinterpret_cast<const bf16x8*>(qb[d0 & 3] + (d0 >> 2) * 128);
        p0 = __builtin_amdgcn_mfma_f32_32x32x16_bf16(b0, qf, p0, 0, 0, 0);
        p1 = __builtin_amdgcn_mfma_f32_32x32x16_bf16(b1, qf, p1, 0, 0, 0); }
}
template <int VB, bool SK>
__device__ __forceinline__ void pv_tile(f32x16* o, int vb0, bf16x8 pa0, bf16x8 pa1, bf16x8 pa2, bf16x8 pa3, bool act) {
    if (SK && !act) return;
#define TRRD(dst, off) asm volatile("ds_read_b64_tr_b16 %0, %1 offset:%2" : "=&v"(dst) : "v"(vb0), "i"(off) : "memory")
#define PV_D0(d0) do { s16x4 l0, l1, l2, l3, h0, h1, h2, h3; constexpr int b_ = VB * SHM_V + v_rd_off(d0, 0, 0);     \
        TRRD(l0, b_); TRRD(h0, b_ + 2048); TRRD(l1, b_ + 4096); TRRD(h1, b_ + 6144); TRRD(l2, b_ + 8192); TRRD(h2, b_ + 10240); TRRD(l3, b_ + 12288); TRRD(h3, b_ + 14336); \
        asm volatile("s_waitcnt lgkmcnt(0)" ::: "memory"); SBAR();                 \
        o[d0] = __builtin_amdgcn_mfma_f32_32x32x16_bf16(pa0, (bf16x8){l0[0], l0[1], l0[2], l0[3], h0[0], h0[1], h0[2], h0[3]}, o[d0], 0, 0, 0);   \
        o[d0] = __builtin_amdgcn_mfma_f32_32x32x16_bf16(pa1, (bf16x8){l1[0], l1[1], l1[2], l1[3], h1[0], h1[1], h1[2], h1[3]}, o[d0], 0, 0, 0);   \
        o[d0] = __builtin_amdgcn_mfma_f32_32x32x16_bf16(pa2, (bf16x8){l2[0], l2[1], l2[2], l2[3], h2[0], h2[1], h2[2], h2[3]}, o[d0], 0, 0, 0);   \
        o[d0] = __builtin_amdgcn_mfma_f32_32x32x16_bf16(pa3, (bf16x8){l3[0], l3[1], l3[2], l3[3], h3[0], h3[1], h3[2], h3[3]}, o[d0], 0, 0, 0); } while (0)
    PV_D0(0); PV_D0(1); PV_D0(2); PV_D0(3);
#undef PV_D0
#undef TRRD
}

template <class TIn, class TOut> struct BlockRef { const TIn* Q; const TIn* K; const TIn* V; TOut* O; const float* FC; const TIn* G; int P0; int JLO; };
template <class TIn> struct Seam {
    bf16x8 qr[8];
    bf16x8 st_v0, st_v1, st_k0, st_k1; f32x4 sf0, sf1, sf2, sf3;
    f32x4 tq[16];
};
__device__ __forceinline__ int swa_jlo(int P0, int W) { const int lowk = P0 - W + 1; return lowk > 0 ? lowk / KVBLK : 0; }
#define ROW(p, k0, rr) ((p) + (size_t)((k0) + (rr)) * D + sc)
#define VMW() asm volatile("s_waitcnt vmcnt(0)" ::: "memory")
#define VMWN(n) asm volatile("s_waitcnt vmcnt(%0)" :: "i"(n) : "memory")
#define SLOAD_H(Kp, Vp, k0) do { S.st_v0 = load8<TIn>(ROW(Vp, k0, sr)); S.st_v1 = load8<TIn>(ROW(Vp, k0, 32 + sr));              \
                         S.st_k0 = load8<TIn>(ROW(Kp, k0, sr)); S.st_k1 = load8<TIn>(ROW(Kp, k0, 32 + sr)); } while (0)
#define SWRITE_HK(bf) do { *(bf16x8*)(K_lds + (bf) * SHM_K + kws) = S.st_k0; *(bf16x8*)(K_lds + (bf) * SHM_K + kws + 32 * 256) = S.st_k1; } while (0)
#define SWRITE_HV(bf) do { *(bf16x8*)(V_lds + (bf) * SHM_V + vst0) = S.st_v0; *(bf16x8*)(V_lds + (bf) * SHM_V + vst1) = S.st_v1; } while (0)
#define SWRITE_H(bf) do { SWRITE_HV(bf); SWRITE_HK(bf); } while (0)
#define SLOAD_F(p, k0) do { S.sf0 = *(const f32x4*)ROW(p, k0, sr); S.sf1 = *(const f32x4*)(ROW(p, k0, sr) + 4);                \
                            S.sf2 = *(const f32x4*)ROW(p, k0, 32 + sr); S.sf3 = *(const f32x4*)(ROW(p, k0, 32 + sr) + 4); } while (0)
#define SWRITE_KF(bf) do { *(bf16x8*)(K_lds + (bf) * SHM_K + kws) = pack8(S.sf0, S.sf1); *(bf16x8*)(K_lds + (bf) * SHM_K + kws + 32 * 256) = pack8(S.sf2, S.sf3); } while (0)
#define SWRITE_VF(bf) do { *(bf16x8*)(V_lds + (bf) * SHM_V + vst0) = pack8(S.sf0, S.sf1); *(bf16x8*)(V_lds + (bf) * SHM_V + vst1) = pack8(S.sf2, S.sf3); } while (0)
template <class TIn, class TOut>
__device__ __forceinline__ void causal_swa_prime(const BlockRef<TIn, TOut>& cur, int W, char* lds, Seam<TIn>& S) {
    constexpr bool F32 = same_t<TIn, float>::v;
    const int tid = opaque_tid(), wid = __builtin_amdgcn_readfirstlane(tid >> 6), lane = tid & 63, r32 = lane & 31, hi = lane >> 5;
    const int sr = tid >> 4, sc = (tid & 15) * 8, kws = KSWZ(sr, sc * 2); char* K_lds = lds + 2 * SHM_V;
    const int kb0 = cur.JLO * KVBLK;
    for (int d0 = 0; d0 < 8; ++d0) S.qr[d0] = load8<TIn>(cur.Q + (size_t)(wid * QBLK + r32) * D + d0 * 16 + hi * 8);
    { char* q_w = lds + QL_OFF + wid * (QBLK * D * 2);
      for (int d0 = 0; d0 < 8; ++d0) *reinterpret_cast<bf16x8*>(q_w + KSWZ(r32, (d0 * 16 + hi * 8) * 2)) = S.qr[d0]; }
    if constexpr (F32) { SLOAD_F((const float*)cur.K, kb0); VMW(); SWRITE_KF(0); SBAR(); SLOAD_F((const float*)cur.V, kb0); }
    else { SLOAD_H(cur.K, cur.V, kb0); VMW(); SWRITE_HK(0); }
    __syncthreads();
}
template <class TIn, class TOut>
__device__ __forceinline__ void causal_swa_block(const BlockRef<TIn, TOut>& cur, const BlockRef<TIn, TOut>& nxt, int skv, int W, char* lds, Seam<TIn>& S) {
    constexpr bool F32 = same_t<TIn, float>::v;
    const int tid = opaque_tid(), wid = __builtin_amdgcn_readfirstlane(tid >> 6), lane = tid & 63, r32 = lane & 31, hi = lane >> 5;
    const int j_lo = cur.JLO;
    int j_hi = (cur.P0 + QB - 1) / KVBLK + 1; if (j_hi > skv / KVBLK) j_hi = skv / KVBLK;
    const int NT = j_hi - j_lo;
    const int kbn = nxt.JLO * KVBLK;
    const int qlo = cur.P0 + wid * QBLK, qm = qlo + r32 - 4 * hi;
    char* V_lds = lds; char* K_lds = lds + 2 * SHM_V;
    float* ws = (float*)(lds + 2 * SHM_V + 2 * SHM_K) + wid * 64; float* li_l = ws, * al_l = ws + 32;
    float m_reg = -1e30f, l_reg = 0; f32x16 o[4] = {};
    const int sr = tid >> 4, sc = (tid & 15) * 8, vst0 = v_st(sr, sc), vst1 = v_st(32 + sr, sc), kws = KSWZ(sr, sc * 2);
    const int vb0 = (int)(uintptr_t)V_lds + v_rd_base(lane);
    const TIn* Kh = cur.K; const TIn* Vh = cur.V;
    char* q_w = lds + QL_OFF + wid * (QBLK * D * 2);
    float* fb = (float*)(lds + FB_OFF);
    { const int nk = j_hi * KVBLK; const float* FCp = cur.FC; const float c0 = FCp ? FCp[cur.P0] : 0.f;
#pragma unroll
      for (int k = 0; k < 4; ++k) { const int i = tid + 64 * NW * k;
          if (i < nk) { float v = 0.f; if (FCp) v = (c0 - FCp[i]) * INV_SCALE; fb[i] = v; } }
      __syncthreads(); }
#define RESC(a) do { if (__any((a) < 1.f)) { if (hi == 0) al_l[r32] = (a); asm volatile("s_waitcnt lgkmcnt(0)" ::: "memory");              \
                     for (int d_ = 0; d_ < 4; ++d_) for (int r = 0; r < 16; ++r) o[d_][r] *= al_l[crow(r, hi)]; } } while (0)
#define KBASE(t) ((j_lo + (t)) * KVBLK)
#define ACT(t) (KBASE(t) <= qlo + QBLK - 1 && KBASE(t) + KVBLK - 1 >= qlo - W + 1)
#define MASKT(P0_, P1_, t) do { const int kb_ = KBASE(t); if ((!SK || ACT(t)) && (kb_ + KVBLK - 1 > qlo || kb_ <= qlo + QBLK - 1 - W)) mask_tile(P0_, P1_, qm - kb_, (unsigned)W); } while (0)
    constexpr int NQL = F32 ? 16 : 8;
    constexpr bool SK = WSKIP && !F32;
#define SEAM_K0() do { VMWN(NQL); if constexpr (F32) { SWRITE_KF(0); SBAR(); SLOAD_F((const float*)nxt.V, kbn); } else { SWRITE_HK(0); } SBAR(); } while (0)
    f32x16 pA0, pA1, pB0, pB1; float mnA, mnB, alA, alB; bf16x8 pa0, pa1, pa2, pa3;
    if constexpr (F32) { VMW(); SWRITE_VF(0); SBAR(); } else { SWRITE_HV(0); SBAR(); }
    if (NT > 1) { if constexpr (F32) SLOAD_F((const float*)Kh, KBASE(1)); else SLOAD_H(Kh, Vh, KBASE(1)); }
    SBAR(); qkt<0, SK>(pA0, pA1, K_lds, r32, hi, q_w, ACT(0), fb + KBASE(0));
    if constexpr (F32) { if (NT > 1) { VMW(); SWRITE_KF(1); SBAR(); SLOAD_F((const float*)Vh, KBASE(1)); } }
    MASKT(pA0, pA1, 0); partialSM(pA0, pA1, m_reg, mnA, alA);
    if (NT > 1) { VMW(); if constexpr (F32) { SWRITE_VF(1); SBAR(); if (NT > 2) SLOAD_F((const float*)Kh, KBASE(2)); } else SWRITE_H(1); }
    __syncthreads();
#define HALF_STEP(PX0, PX1, mnX, alX, PY0, PY1, alY, t, KB, VB, SB) do {                                                      \
        SBAR(); qkt<KB, SK>(PX0, PX1, K_lds, r32, hi, q_w, ACT(t), fb + KBASE(t));                                             \
        finishSM(PY0, PY1, alY, l_reg, pa0, pa1, pa2, pa3); SBAR();                                                           \
        if ((t) + 1 < NT) { if constexpr (F32) { VMW(); SWRITE_KF(SB); SBAR(); SLOAD_F((const float*)Vh, KBASE((t) + 1)); }  \
                            else { SLOAD_H(Kh, Vh, KBASE((t) + 1)); } SBAR(); }                                               \
        pv_tile<VB, SK>(o, vb0, pa0, pa1, pa2, pa3, ACT((t) - 1)); MASKT(PX0, PX1, (t)); partialSM(PX0, PX1, m_reg, mnX, alX);                                        \
        __syncthreads();                                                                                                      \
        if ((t) + 1 < NT) { VMW(); if constexpr (F32) { SWRITE_VF(SB); SBAR(); if ((t) + 2 < NT) SLOAD_F((const float*)Kh, KBASE((t) + 2)); } \
                            else { SWRITE_H(SB); } }                                                                          \
        RESC(alX); __syncthreads(); } while (0)
    for (int t = 1; t + 1 < NT; t += 2) {
        HALF_STEP(pB0, pB1, mnB, alB, pA0, pA1, alA, t, 1, 0, 0);
        HALF_STEP(pA0, pA1, mnA, alA, pB0, pB1, alB, t + 1, 0, 1, 1);
    }
    const bool even = (NT & 1) == 0;
    if (even) { SBAR(); qkt<1, SK>(pB0, pB1, K_lds, r32, hi, q_w, ACT(NT - 1), fb + KBASE(NT - 1)); SBAR(); }
#define QROW(e) (nxt.Q + (size_t)(wid * QBLK + r32) * D + ((e) >> 1) * 16 + hi * 8 + ((e) & 1) * 4)
    if constexpr (F32) { SLOAD_F((const float*)nxt.K, kbn); SBAR();
#pragma unroll
        for (int e = 0; e < 8; ++e) S.tq[e] = *(const f32x4*)QROW(e); }
    else { SLOAD_H(nxt.K, nxt.V, kbn); SBAR();
#pragma unroll
        for (int d0 = 0; d0 < 8; ++d0) S.qr[d0] = load8<TIn>(nxt.Q + (size_t)(wid * QBLK + r32) * D + d0 * 16 + hi * 8); }
    SBAR();
    finishSM(pA0, pA1, alA, l_reg, pa0, pa1, pa2, pa3); SBAR();
    if constexpr (F32) {
#pragma unroll
        for (int e = 8; e < 16; ++e) S.tq[e] = *(const f32x4*)QROW(e); SBAR(); }
#undef QROW
    pv_tile<0, SK>(o, vb0, pa0, pa1, pa2, pa3, ACT(even ? NT - 2 : NT - 1));
    if (even) { MASKT(pB0, pB1, NT - 1); partialSM(pB0, pB1, m_reg, mnB, alB); __syncthreads(); RESC(alB);
        finishSM(pB0, pB1, alB, l_reg, pa0, pa1, pa2, pa3); SBAR(); pv_tile<1, SK>(o, vb0, pa0, pa1, pa2, pa3, ACT(NT - 1)); }
    SBAR(); SEAM_K0();
    if (hi == 0) li_l[r32] = l_reg; asm volatile("s_waitcnt lgkmcnt(0)" ::: "memory");
    float rli[16];
#pragma unroll
    for (int r = 0; r < 16; ++r) rli[r] = __builtin_amdgcn_rcpf(li_l[crow(r, hi)]);
    {
        unsigned short* ost = (unsigned short*)q_w;
        {
            const bool odd = (r32 & 1) != 0; unsigned short* ob_ = ost + (odd ? 32 : 0) + (r32 & ~1);
#pragma unroll
            for (int r = 0; r < 16; ++r) { const int orow = crow(r, hi);
#pragma unroll
                for (int dp = 0; dp < 4; dp += 2) { const float e0 = o[dp][r] * rli[r], e1 = o[dp + 1][r] * rli[r];
                    const float snd = odd ? e0 : e1;
                    const float rcv = __int_as_float(__builtin_amdgcn_update_dpp(0, __float_as_int(snd), 0xB1, 0xF, 0xF, true));
                    const float lo = odd ? rcv : e0, hi_ = odd ? e1 : rcv;
                    *(unsigned*)(ob_ + orow * 128 + dp * 32) = cvtpk(lo, hi_); } }
        }
        asm volatile("s_waitcnt lgkmcnt(0)" ::: "memory");
        const unsigned short* Gw = (const unsigned short*)cur.G + (size_t)(wid * QBLK) * LDO; TOut* Ow = cur.O + (size_t)(wid * QBLK) * LDO;
        const int ck = lane & 15, rq = lane >> 4;
        u32x4 gq[8];
#pragma unroll
        for (int i = 0; i < 8; ++i) gq[i] = *(const u32x4*)(Gw + (size_t)(4 * i + rq) * LDO + ck * 8);
#pragma unroll
        for (int i = 0; i < 8; ++i) { const u32x4 ov = *(const u32x4*)(ost + (4 * i + rq) * 128 + ck * 8); const u32x4 g = gq[i]; u32x4 w;
#define GMUL(a_, b_) cvtpk(__uint_as_float((a_) << 16) * __uint_as_float((b_) << 16), __uint_as_float((a_) & 0xffff0000u) * __uint_as_float((b_) & 0xffff0000u))
            w.x = GMUL(ov.x, g.x); w.y = GMUL(ov.y, g.y); w.z = GMUL(ov.z, g.z); w.w = GMUL(ov.w, g.w);
#undef GMUL
            *(u32x4*)(Ow + (size_t)(4 * i + rq) * LDO + ck * 8) = w; }
        asm volatile("s_waitcnt lgkmcnt(0)" ::: "memory");
    }
    if constexpr (F32) {
#pragma unroll
        for (int d0 = 0; d0 < 8; ++d0) S.qr[d0] = pack8(S.tq[2 * d0], S.tq[2 * d0 + 1]); }
#pragma unroll
    for (int d0 = 0; d0 < 8; ++d0) *reinterpret_cast<bf16x8*>(q_w + KSWZ(r32, (d0 * 16 + hi * 8) * 2)) = S.qr[d0];
    __syncthreads();
#undef RESC
#undef KBASE
#undef ACT
#undef MASKT
#undef SEAM_K0
#undef HALF_STEP
}
#undef ROW
#undef VMW
#undef VMWN
#undef SLOAD_H
#undef SWRITE_HK
#undef SWRITE_HV
#undef SWRITE_H
#undef SLOAD_F
#undef SWRITE_KF
#undef SWRITE_VF


#undef KSWZ
#undef SBAR
}
#define LAS __attribute__((address_space(3)))
typedef unsigned short bf16r;
typedef float f32x4 __attribute__((ext_vector_type(4)));
typedef float f32x16 __attribute__((ext_vector_type(16)));
typedef short bf16x8 __attribute__((ext_vector_type(8)));
typedef unsigned u32x4 __attribute__((ext_vector_type(4)));
typedef unsigned u32x2 __attribute__((ext_vector_type(2)));

constexpr int NTOK = 16384, DM = 2048, SEQL = 2048, NBATCH = 8, NMEM = 256, MAINW = 1536, MEMW = 512, NGRP = 96;
constexpr float EPSN = 1e-6f;
constexpr size_t MiB = (size_t)1 << 20;
constexpr size_t SM_RSTD0 = 0, SM_RSTDM = 64 * 1024, SM_ROWSQ0 = 128 * 1024, SM_ROWSQ1 = 192 * 1024, SM_RSTD1 = 256 * 1024,
                 SM_LOGF = 320 * 1024, SM_FCUM = 1152 * 1024, SM_WFT = 1984 * 1024, SM_QNRM = 2560 * 1024, SM_KNRM = 3328 * 1024;
constexpr size_t WS_WINA = 4 * MiB, WS_WKVB = 20 * MiB, WS_WGLU = 48 * MiB, WS_WMKV0 = 53 * MiB, WS_WMKV1 = 57 * MiB, WS_WOUT0 = 61 * MiB, WS_WOUT1 = 69 * MiB,
                 WS_XB = 77 * MiB, WS_MEMB = 141 * MiB, WS_MKV = 149 * MiB, WS_PROJ = 157 * MiB, WS_KVB = 285 * MiB, WS_CAT = 381 * MiB, WS_OB = 445 * MiB, WS_BAR = 509 * MiB, WS_END = 509 * MiB + 65536;
constexpr int LDS_TOTAL = 147456;

struct Params { const float* in[23]; float* out; unsigned char* ws; };
enum { I_X = 0, I_MEM, I_PREG, I_POSTG, I_WINA, I_LRE, I_LIM, I_LSTEP, I_BRE, I_BIM, I_CRE, I_CIM, I_DSKIP, I_WGLU, I_BGLU, I_KVG, I_WKV, I_WFG, I_BFG, I_WINB, I_MEMG, I_WMKV, I_WOUT };

__device__ __forceinline__ float wave_sum(float v) {
#pragma unroll
    for (int o = 1; o < 64; o <<= 1) v += __shfl_xor(v, o);
    return v;
}
__device__ __forceinline__ unsigned pkbf(float lo, float hi) { return pg8::cvt_pk_bf16(lo, hi); }
#define LDS_FENCE() asm volatile("s_waitcnt lgkmcnt(0)" ::: "memory")

__device__ __forceinline__ void transpose_item(const float* W, const float* gs, int K, int N, bf16r* WT, int row_off, LAS float* scr, int item, int lane) {
    const int nblk = N / 32, kb = item / nblk, nb = item % nblk, k0 = 64 * kb, n0 = 32 * nb;
    const float* src = W + (size_t)(k0 + (lane >> 5)) * N + n0 + (lane & 31);
    float v[32];
#pragma unroll
    for (int i = 0; i < 32; ++i) v[i] = src[(size_t)(2 * i) * N];
    const int c = lane & 7;
    f32x4 g0 = {1.f, 1.f, 1.f, 1.f}, g1 = {1.f, 1.f, 1.f, 1.f};
    if (gs) { g0 = *(const f32x4*)(gs + k0 + 8 * c); g1 = *(const f32x4*)(gs + k0 + 8 * c + 4); }
#pragma unroll
    for (int i = 0; i < 32; ++i) scr[(2 * i + (lane >> 5)) * 33 + (lane & 31)] = v[i];
    LDS_FENCE();
#pragma unroll
    for (int j = 0; j < 4; ++j) { const int n = (lane >> 3) + 8 * j; const LAS float* s = scr + (8 * c) * 33 + n;
        u32x4 o; o.x = pkbf(s[0 * 33] * g0[0], s[1 * 33] * g0[1]); o.y = pkbf(s[2 * 33] * g0[2], s[3 * 33] * g0[3]); o.z = pkbf(s[4 * 33] * g1[0], s[5 * 33] * g1[1]); o.w = pkbf(s[6 * 33] * g1[2], s[7 * 33] * g1[3]);
        *(u32x4*)(WT + (size_t)(row_off + n0 + n) * K + k0 + 8 * c) = o; }
    LDS_FENCE();
}
__device__ __forceinline__ void rows_to_bf16(const float* x, bf16r* o, float* rstd_out, int m0, int stride, int nrows, int lane) {
    f32x4 v[8];
    if (m0 < nrows) { const f32x4* xp = (const f32x4*)(x + (size_t)m0 * DM) + lane;
#pragma unroll
        for (int j = 0; j < 8; ++j) v[j] = xp[64 * j]; }
    for (int m = m0; m < nrows; m += stride) {
        f32x4 vn[8]; const int mn = m + stride;
        if (mn < nrows) { const f32x4* xp = (const f32x4*)(x + (size_t)mn * DM) + lane;
#pragma unroll
            for (int j = 0; j < 8; ++j) vn[j] = xp[64 * j]; }
        float s = 0.f;
#pragma unroll
        for (int j = 0; j < 8; ++j) s += (v[j][0] * v[j][0] + v[j][1] * v[j][1]) + (v[j][2] * v[j][2] + v[j][3] * v[j][3]);
        s = wave_sum(s);
        if (lane == 0) rstd_out[m] = 1.0f / sqrtf(s * (1.0f / DM) + EPSN);
        u32x2* op = (u32x2*)(o + (size_t)m * DM) + lane;
#pragma unroll
        for (int j = 0; j < 8; ++j) { u32x2 w; w.x = pkbf(v[j][0], v[j][1]); w.y = pkbf(v[j][2], v[j][3]); op[64 * j] = w; }
        if (mn < nrows) {
#pragma unroll
            for (int j = 0; j < 8; ++j) v[j] = vn[j]; }
    }
}

struct Sel0 { bf16r* proj;
    __device__ __forceinline__ pg8::SecInfo operator()(int cs) const {
        if (cs < 1536) return {proj, 0, 1536, 0, 0, nullptr};
        if (cs < 3072) return {proj + (size_t)NTOK * 1536, 1536, 2048, 0, 1, nullptr};
        if (cs < 3584) return {proj + (size_t)NTOK * 3584, 3072, 0, 4, 0, nullptr};
        return {proj + (size_t)NTOK * 1536 + 1536, 3584, 2048, 0, 1, nullptr}; } };
struct Sel1 { bf16r* kvb; bf16r* proj; float* qnrm; float* knrm;
    __device__ __forceinline__ pg8::SecInfo operator()(int cs) const {
        if (cs < 1536) return {kvb, 0, 0, 12, 0, knrm};
        if (cs < 3072) return {kvb + (size_t)NTOK * 1536, 1536, 0, 12, 0, nullptr};
        if (cs < 4608) return {proj, 3072, 0, 12, 0, qnrm};
        if (cs < 6144) return {proj + (size_t)NTOK * 1536, 4608, 2048, 0, 1, nullptr};
        if (cs < 6656) return {proj + (size_t)NTOK * 3584, 6144, 0, 4, 0, nullptr};
        return {proj + (size_t)NTOK * 1536 + 1536, 6656, 2048, 0, 1, nullptr}; } };
struct SelM { bf16r* mkv;
    __device__ __forceinline__ pg8::SecInfo operator()(int cs) const {
        if (cs < 512) return {mkv, 0, 0, 4, 0, nullptr};
        return {mkv + (size_t)NBATCH * NMEM * 512, 512, 0, 4, 0, nullptr}; } };

constexpr int SSM_XS = 80;
constexpr int SSM_WAVE_LDS = 128 * 36 * 4 + 32 * SSM_XS * 4;
typedef float __attribute__((may_alias)) f32_ma; typedef unsigned __attribute__((may_alias)) u32_ma;
typedef f32x4 __attribute__((may_alias)) f32x4_ma; typedef bf16x8 __attribute__((may_alias)) bf16x8_ma;
__device__ __forceinline__ int crow16(int r, int hi) { return (r & 3) + 8 * (r >> 2) + 4 * hi; }
__device__ __forceinline__ float gelu_tanh(float y) {
    const float z = 0.7978845608028654f * (y + 0.044715f * y * y * y);
    return y * __builtin_amdgcn_rcpf(1.f + __builtin_amdgcn_exp2f(-2.8853900817779268f * z));
}
struct SsmCtx {
    f32_ma* Bu2; u32_ma* Xs; const bf16r* U; bf16r* YG; size_t tokb; int g, lane, c, hi, l16, kq;
    float ar, ai; bf16x8 Bf[4]; bf16x8 Cf[4]; float dsk[4];
};
__device__ __forceinline__ void ssm_s2(const SsmCtx& X, bf16x8 Uc) {
#pragma unroll
    for (int nt = 0; nt < 4; ++nt) {
        f32x16 a = {};
        a = __builtin_amdgcn_mfma_f32_32x32x16_bf16(Uc, X.Bf[nt], a, 0, 0, 0);
#pragma unroll
        for (int r4 = 0; r4 < 4; ++r4) { f32x4 v = {a[4 * r4], a[4 * r4 + 1], a[4 * r4 + 2], a[4 * r4 + 3]}; *(f32x4_ma*)(X.Bu2 + (32 * nt + X.c) * 36 + 8 * r4 + 4 * X.hi) = v; }
    }
}
__device__ __forceinline__ void ssm_s1(const SsmCtx& X, float& xr, float& xi) {
#pragma unroll
    for (int q = 0; q < 8; ++q) {
        const f32x4 re4 = *(const f32x4_ma*)(X.Bu2 + X.lane * 36 + 4 * q), im4 = *(const f32x4_ma*)(X.Bu2 + (64 + X.lane) * 36 + 4 * q);
#pragma unroll
        for (int e = 0; e < 4; ++e) {
            const float nr = X.ar * xr - X.ai * xi + re4[e], ni = X.ar * xi + X.ai * xr + im4[e];
            xr = nr; xi = ni; X.Xs[(4 * q + e) * SSM_XS + X.lane] = pkbf(xr, xi);
        }
    }
}
__device__ __forceinline__ void ssm_s3(const SsmCtx& X, bf16r* py, u32x2 us0, u32x2 us1) {
    f32x4 y0 = {0.f, 0.f, 0.f, 0.f}, y1 = {0.f, 0.f, 0.f, 0.f};
#pragma unroll
    for (int s = 0; s < 4; ++s) {
        const bf16x8 b0 = *(const bf16x8_ma*)(X.Xs + X.l16 * SSM_XS + 16 * s + 4 * X.kq), b1 = *(const bf16x8_ma*)(X.Xs + (16 + X.l16) * SSM_XS + 16 * s + 4 * X.kq);
        y0 = __builtin_amdgcn_mfma_f32_16x16x32_bf16(X.Cf[s], b0, y0, 0, 0, 0);
        y1 = __builtin_amdgcn_mfma_f32_16x16x32_bf16(X.Cf[s], b1, y1, 0, 0, 0);
    }
    y0[0] += X.dsk[0] * pg8::bf_lo(us0.x); y0[1] += X.dsk[1] * pg8::bf_hi(us0.x); y0[2] += X.dsk[2] * pg8::bf_lo(us0.y); y0[3] += X.dsk[3] * pg8::bf_hi(us0.y);
    y1[0] += X.dsk[0] * pg8::bf_lo(us1.x); y1[1] += X.dsk[1] * pg8::bf_hi(us1.x); y1[2] += X.dsk[2] * pg8::bf_lo(us1.y); y1[3] += X.dsk[3] * pg8::bf_hi(us1.y);
    u32x2 w0, w1;
    w0.x = pkbf(gelu_tanh(y0[0]), gelu_tanh(y0[1])); w0.y = pkbf(gelu_tanh(y0[2]), gelu_tanh(y0[3]));
    w1.x = pkbf(gelu_tanh(y1[0]), gelu_tanh(y1[1])); w1.y = pkbf(gelu_tanh(y1[2]), gelu_tanh(y1[3]));
    *(u32x2*)py = w0;
    *(u32x2*)(py + 16 * 1536) = w1;
}
#define SSM_BAR() asm volatile("s_waitcnt lgkmcnt(0)\n\ts_barrier" ::: "memory")
constexpr int SSM_TASK_LDS = 128 * 36 * 4 + 2 * 32 * SSM_XS * 4;
__device__ __forceinline__ void ssm_round(const Params& P, bool active, int role, int b, int g, unsigned char* wl, int lane) {
    SsmCtx X; X.g = g; X.lane = lane; X.c = lane & 31; X.hi = lane >> 5; X.l16 = lane & 15; X.kq = lane >> 4;
    const int c = X.c, hi = X.hi, l16 = X.l16, kq = X.kq;
    X.Bu2 = (f32_ma*)wl; u32_ma* Xs0 = (u32_ma*)(wl + 128 * 36 * 4); X.Xs = Xs0;
    X.U = (const bf16r*)(P.ws + WS_PROJ); X.YG = (bf16r*)(P.ws + WS_KVB); X.tokb = (size_t)b * SEQL;
    X.ar = 0.f; X.ai = 0.f;
    const bf16r* Ua = X.U + (X.tokb + c) * 1536 + g * 16 + 8 * hi;
    const bf16r* Us = X.U + (X.tokb + l16) * 1536 + g * 16 + 4 * kq;
    constexpr int NCH = SEQL / 32; constexpr size_t CHS = (size_t)32 * 1536;
    bf16x8 U0 = {}, U1 = {}, U2 = {}; u32x2 a0 = {0u, 0u}, a1 = {0u, 0u}, b0 = {0u, 0u}, b1 = {0u, 0u}, c0 = {0u, 0u}, c1 = {0u, 0u};
    if (active) {
        const float dt = __expf(P.in[I_LSTEP][g]), lr = P.in[I_LRE][g * 64 + lane], li = P.in[I_LIM][g * 64 + lane];
        const float mag = __expf(lr * dt); float rev = li * dt * 0.15915494309189535f; rev -= floorf(rev);
        const float ar = mag * __builtin_amdgcn_cosf(rev), ai = mag * __builtin_amdgcn_sinf(rev);
        const float den = lr * lr + li * li, cr = ((ar - 1.0f) * lr + ai * li) / den, ci = (ai * lr - (ar - 1.0f) * li) / den;
        X.ar = ar; X.ai = ai;
        if (role == 1) {
#pragma unroll
            for (int nt = 0; nt < 4; ++nt) {
                const int pp = 32 * nt + c, p = pp & 63; const float crp = __shfl(cr, p), cip = __shfl(ci, p);
                const f32x4 r0 = *(const f32x4*)(P.in[I_BRE] + ((size_t)(g * 64 + p)) * 16 + 8 * hi), r1 = *(const f32x4*)(P.in[I_BRE] + ((size_t)(g * 64 + p)) * 16 + 8 * hi + 4);
                const f32x4 i0 = *(const f32x4*)(P.in[I_BIM] + ((size_t)(g * 64 + p)) * 16 + 8 * hi), i1 = *(const f32x4*)(P.in[I_BIM] + ((size_t)(g * 64 + p)) * 16 + 8 * hi + 4);
                f32x4 v0, v1;
                if (nt < 2) { v0 = crp * r0 - cip * i0; v1 = crp * r1 - cip * i1; } else { v0 = crp * i0 + cip * r0; v1 = crp * i1 + cip * r1; }
                u32x4 w; w.x = pkbf(v0[0], v0[1]); w.y = pkbf(v0[2], v0[3]); w.z = pkbf(v1[0], v1[1]); w.w = pkbf(v1[2], v1[3]);
                X.Bf[nt] = __builtin_bit_cast(bf16x8, w);
            }
#pragma unroll
            for (int s = 0; s < 4; ++s) {
                const f32x4 re = *(const f32x4*)(P.in[I_CRE] + ((size_t)(g * 16 + l16)) * 64 + 16 * s + 4 * kq), im = *(const f32x4*)(P.in[I_CIM] + ((size_t)(g * 16 + l16)) * 64 + 16 * s + 4 * kq);
                u32x4 w; w.x = pkbf(re[0], -im[0]); w.y = pkbf(re[1], -im[1]); w.z = pkbf(re[2], -im[2]); w.w = pkbf(re[3], -im[3]);
                X.Cf[s] = __builtin_bit_cast(bf16x8, w);
            }
#pragma unroll
            for (int r = 0; r < 4; ++r) X.dsk[r] = P.in[I_DSKIP][g * 16 + 4 * kq + r];
            ssm_s2(X, *(const bf16x8*)Ua);
            U1 = *(const bf16x8*)(Ua + CHS); U2 = *(const bf16x8*)(Ua + 2 * CHS);
            a0 = *(const u32x2*)Us; a1 = *(const u32x2*)(Us + 16 * 1536);
        }
    }
    if (!active) {
        for (int i = 0; i < 2 * (NCH + 1) + 1; ++i) SSM_BAR();
    } else if (role == 0) {
        float xr = 0.f, xi = 0.f; const float nai_ = -X.ai; int wsel = 0;
        for (int ch = 0; ch <= NCH; ++ch) {
            SSM_BAR();
            f32x4 re4[8], im4[8];
            if (ch < NCH) {
#pragma unroll
                for (int q = 0; q < 8; ++q) { re4[q] = *(const f32x4_ma*)(X.Bu2 + lane * 36 + 4 * q); im4[q] = *(const f32x4_ma*)(X.Bu2 + (64 + lane) * 36 + 4 * q); }
            }
            SSM_BAR();
            if (ch < NCH) {
                u32_ma* Xw = Xs0 + wsel * (32 * SSM_XS); wsel ^= 1;
#pragma unroll
                for (int q = 0; q < 8; ++q) {
#pragma unroll
                    for (int e = 0; e < 4; ++e) {
                        float t1, t2, nr, ni;
                        asm("v_fma_f32 %0, %1, %2, %3" : "=v"(t1) : "v"(nai_), "v"(xi), "v"(re4[q][e]));
                        asm("v_fma_f32 %0, %1, %2, %3" : "=v"(t2) : "v"(X.ai), "v"(xr), "v"(im4[q][e]));
                        asm("v_fma_f32 %0, %1, %2, %3" : "=v"(nr) : "v"(X.ar), "v"(xr), "v"(t1));
                        asm("v_fma_f32 %0, %1, %2, %3" : "=v"(ni) : "v"(X.ar), "v"(xi), "v"(t2));
                        xr = nr; xi = ni; Xw[(4 * q + e) * SSM_XS + lane] = pkbf(xr, xi); } }
            }
        }
        SSM_BAR();
    } else {
        const bf16r* pU = Ua + 3 * CHS; const bf16r* pS = Us + CHS; bf16r* pY = X.YG + (X.tokb + l16) * 1536 + g * 16 + 4 * kq; int rsel = 0;
#define SSM_MM(DO_S2, DO_S3, DO_LD, U_USE, U_LD, S0_USE, S1_USE, S0_LD, S1_LD) do {                                               \
            SSM_BAR(); SSM_BAR();                                                                                      \
            if (DO_LD) { U_LD = *(const bf16x8*)pU; S0_LD = *(const u32x2*)pS; S1_LD = *(const u32x2*)(pS + 16 * 1536); pU += CHS; pS += CHS; } \
            __builtin_amdgcn_sched_barrier(0);                                                                                    \
            if (DO_S2) ssm_s2(X, U_USE);                                                                                          \
            if (DO_S3) { X.Xs = Xs0 + rsel * (32 * SSM_XS); rsel ^= 1; ssm_s3(X, pY, S0_USE, S1_USE); pY += CHS; }                \
            __builtin_amdgcn_sched_barrier(0);                                                                                    \
        } while (0)
#define MM_R0(S2_, S3_, LD) SSM_MM(S2_, S3_, LD, U1, U0, c0, c1, b0, b1)
#define MM_R1(S2_, S3_, LD) SSM_MM(S2_, S3_, LD, U2, U1, a0, a1, c0, c1)
#define MM_R2(S2_, S3_, LD) SSM_MM(S2_, S3_, LD, U0, U2, b0, b1, a0, a1)
        MM_R0(true, false, true);
        _Pragma("clang loop unroll(disable)") for (int ch = 1; ch + 2 < NCH - 1; ch += 3) { MM_R1(true, true, true); MM_R2(true, true, true); MM_R0(true, true, true); }
        static_assert((NCH - 2) % 3 == 2, "steady range 1..NCH-2 = 20 triples + 2");
        MM_R1(true, true, true);
        MM_R2(true, true, true);
        MM_R0(false, true, false);
        MM_R1(false, true, false);
#undef MM_R0
#undef MM_R1
#undef MM_R2
#undef SSM_MM
        SSM_BAR();
    }
}
__device__ __forceinline__ void ssm_phase(const Params& P, unsigned char* lds, int wave, int lane) {
    const int role = (wave == 0 || wave == 2 || wave == 6) ? 0 : 1;
    const int ts = (wave == 0 || wave == 4) ? 0 : (wave == 1 || wave == 2) ? 1 : (wave == 3 || wave == 6) ? 2 : 3;
    const int G = gridDim.x, rounds = (NBATCH * NGRP + 3 * G - 1) / (3 * G);
    for (int rd = 0; rd < rounds; ++rd) {
        const int tk = (rd * G + (int)blockIdx.x) * 3 + ts; const bool active = (ts < 3) && (tk < NBATCH * NGRP);
        const int tkc = active ? tk : 0;
        ssm_round(P, active, role, tkc / NGRP, tkc % NGRP, lds + (ts < 3 ? ts : 0) * SSM_TASK_LDS, lane);
    }
}

typedef att::BlockRef<att::bf16, att::bf16> ABlk;
__device__ __forceinline__ int fox_jlo(const Params& P, int bh, int qb, char* lds) {
    const int tid = opaque_tid(), lane = tid & 63, wave = tid >> 6;
    float* red = (float*)(lds + att::LDS_BYTES);
    const float* qn = (const float*)(P.ws + SM_QNRM) + (size_t)bh * SEQL + qb * 256; const float* kn = (const float*)(P.ws + SM_KNRM) + (size_t)bh * SEQL;
    float mq = (tid < 256) ? qn[tid] : 0.f, mk = 0.f;
    for (int i = tid; i < qb * 256; i += 512) mk = fmaxf(mk, kn[i]);
#pragma unroll
    for (int o = 1; o < 64; o <<= 1) { mq = fmaxf(mq, __shfl_xor(mq, o)); mk = fmaxf(mk, __shfl_xor(mk, o)); }
    if (lane == 0) { red[wave] = mq; red[8 + wave] = mk; }
    __syncthreads();
    float Q2 = 0.f, K2 = 0.f;
#pragma unroll
    for (int w = 0; w < 8; ++w) { Q2 = fmaxf(Q2, red[w]); K2 = fmaxf(K2, red[8 + w]); }
    const float bound = 2.04f * sqrtf(Q2 * K2) * att::SCALE + 30.f;
    const float* FC = (const float*)(P.ws + SM_FCUM) + (size_t)bh * SEQL; const float c0 = FC[qb * 256];
    const bool keep = (lane >= qb * 4) || (c0 - FC[lane < 32 ? 64 * lane + 63 : 2047] >= -bound);
    const unsigned long long m = __ballot(keep);
    const int jlo = __builtin_amdgcn_readfirstlane((int)__builtin_ctzll(m));
    __syncthreads();
    return jlo;
}
__device__ __forceinline__ void fox_item(int vc, int i, int& bh, int& qb) {
    const int gq = vc >> 3, j = vc & 7, e = j * 3 + i;
    const unsigned long long T0 = 7ull | (3ull << 5) | (0ull << 10) | ((7ull | 8ull) << 15) | (4ull << 20) | ((0ull | 8ull) << 25) | ((7ull | 16ull) << 30) | (2ull << 35) | (1ull << 40) | (6ull << 45) | (5ull << 50) | ((0ull | 16ull) << 55);
    const unsigned long long T1 = (6ull | 8ull) | ((4ull | 8ull) << 5) | ((1ull | 8ull) << 10) | ((6ull | 16ull) << 15) | ((3ull | 8ull) << 20) | ((1ull | 16ull) << 25) | ((5ull | 8ull) << 30) | ((4ull | 16ull) << 35) | ((2ull | 8ull) << 40) | ((5ull | 16ull) << 45) | ((3ull | 16ull) << 50) | ((2ull | 16ull) << 55);
    const unsigned code = (unsigned)(((e < 12) ? (T0 >> (5 * e)) : (T1 >> (5 * (e - 12)))) & 31ull);
    qb = code & 7; bh = gq * 3 + (code >> 3);
}
__device__ __forceinline__ void fox_jlo3(const Params& P, int vc, char* lds) {
    const int tid = opaque_tid(), lane = tid & 63, wave = tid >> 6;
    float* red = (float*)(lds + att::LDS_BYTES);
    int bh[3], qb[3]; float mq[3], mk[3];
#pragma unroll
    for (int i = 0; i < 3; ++i) { fox_item(vc, i, bh[i], qb[i]);
        const float* qn = (const float*)(P.ws + SM_QNRM) + (size_t)bh[i] * SEQL + qb[i] * 256; const float* kn = (const float*)(P.ws + SM_KNRM) + (size_t)bh[i] * SEQL;
        mq[i] = (tid < 256) ? qn[tid] : 0.f; mk[i] = 0.f;
#pragma unroll
        for (int k = 0; k < 4; ++k) { const int idx = tid + 512 * k; if (idx < qb[i] * 256) mk[i] = fmaxf(mk[i], kn[idx]); } }
#pragma unroll
    for (int o = 1; o < 64; o <<= 1) {
#pragma unroll
        for (int i = 0; i < 3; ++i) { mq[i] = fmaxf(mq[i], __shfl_xor(mq[i], o)); mk[i] = fmaxf(mk[i], __shfl_xor(mk[i], o)); } }
    if (lane == 0) {
#pragma unroll
        for (int i = 0; i < 3; ++i) { red[32 + 16 * i + wave] = mq[i]; red[32 + 16 * i + 8 + wave] = mk[i]; } }
    __syncthreads();
#pragma unroll
    for (int i = 0; i < 3; ++i) {
        float Q2 = 0.f, K2 = 0.f;
#pragma unroll
        for (int w = 0; w < 8; ++w) { Q2 = fmaxf(Q2, red[32 + 16 * i + w]); K2 = fmaxf(K2, red[32 + 16 * i + 8 + w]); }
        const float bound = 2.04f * sqrtf(Q2 * K2) * att::SCALE + 30.f;
        const float* FC = (const float*)(P.ws + SM_FCUM) + (size_t)bh[i] * SEQL; const float c0 = FC[qb[i] * 256];
        const bool keep = (lane >= qb[i] * 4) || (c0 - FC[lane < 32 ? 64 * lane + 63 : 2047] >= -bound);
        const unsigned long long m = __ballot(keep);
        if (tid == 0) ((int*)red)[16 + i] = (int)__builtin_ctzll(m);
    }
    __syncthreads();
}
template <bool FOX, int LYR> __device__ __forceinline__ bool att_get(const Params& P, int n, ABlk& r, int& skv, char* lds) {
    constexpr int PER = FOX ? 4 : 1;
    const int G = gridDim.x, bx = blockIdx.x;
    const int slot = n / PER, i = n % PER;
    const int vb = bx + slot * G; if (vb >= 256) return false;
    const int vc = (vb & 7) * 32 + (vb >> 3);
    const att::bf16* proj = (const att::bf16*)(P.ws + WS_PROJ); att::bf16* cat = (att::bf16*)(P.ws + WS_CAT);
    if (FOX && i < 3) {
        int bh, qb; fox_item(vc, i, bh, qb); const int b = bh / 12, h = bh % 12;
        const att::bf16* kvb = (const att::bf16*)(P.ws + WS_KVB);
        r.Q = proj + ((size_t)bh * SEQL + qb * 256) * 128; r.K = kvb + (size_t)bh * SEQL * 128; r.V = kvb + (size_t)NTOK * 1536 + (size_t)bh * SEQL * 128;
        r.O = cat + ((size_t)b * SEQL + qb * 256) * 2048 + h * 128; r.G = proj + (size_t)NTOK * 1536 + ((size_t)b * SEQL + qb * 256) * 2048 + h * 128;
        r.FC = (const float*)(P.ws + SM_FCUM) + (size_t)bh * SEQL; r.P0 = qb * 256; skv = SEQL;
        r.JLO = (slot == 0) ? __builtin_amdgcn_readfirstlane(((const int*)(lds + att::LDS_BYTES))[16 + i]) : fox_jlo(P, bh, qb, lds);
    } else {
        const int b = vc >> 5, hm = (vc >> 3) & 3, qb = vc & 7;
        const att::bf16* mkv = (const att::bf16*)(P.ws + WS_MKV) + (size_t)LYR * (2 * NBATCH * NMEM * 512);
        r.Q = proj + (size_t)NTOK * 3584 + ((size_t)(b * 4 + hm) * SEQL + qb * 256) * 128;
        r.K = mkv + (size_t)(b * 4 + hm) * NMEM * 128; r.V = mkv + (size_t)NBATCH * NMEM * 512 + (size_t)(b * 4 + hm) * NMEM * 128;
        r.O = cat + ((size_t)b * SEQL + qb * 256) * 2048 + 1536 + hm * 128; r.G = proj + (size_t)NTOK * 1536 + ((size_t)b * SEQL + qb * 256) * 2048 + 1536 + hm * 128;
        r.FC = nullptr; r.P0 = 256; skv = NMEM; r.JLO = 0;
    }
    return true;
}
template <bool FOX, int LYR> __device__ __forceinline__ void att_phase(const Params& P, char* lds) {
    ABlk cur, nxt; int skv = 0, skvn = 0;
    if (FOX && (int)blockIdx.x < 256) { const int vb = blockIdx.x; fox_jlo3(P, (vb & 7) * 32 + (vb >> 3), lds); }
    if (!att_get<FOX, LYR>(P, 0, cur, skv, lds)) return;
    att::Seam<att::bf16> S;
    att::causal_swa_prime<att::bf16, att::bf16>(cur, 1 << 20, lds, S);
    for (int n = 0;; ++n) {
        const bool more = att_get<FOX, LYR>(P, n + 1, nxt, skvn, lds);
        if (!more) { nxt = cur; skvn = skv; }
        att::causal_swa_block<att::bf16, att::bf16>(cur, nxt, skv, 1 << 20, lds, S);
        if (!more) break;
        cur = nxt; skv = skvn;
    }
}

#define XB_TMO      128
#define XB_XCNT(j)  (256  + 64 * (j))
#define XB_XSUB(j)  (1280 + 64 * (j))
#define XB_XGEN(j)  (2304 + 64 * (j))
#define XB_TOP      3328
#define XB_TOPGEN   3392
#define XCD_BAR_WORDS 3456
#define XB_SPIN_CAP (1u << 18)

__device__ __forceinline__ unsigned xb_ld(unsigned* p)              { return __hip_atomic_load(p, __ATOMIC_RELAXED, __HIP_MEMORY_SCOPE_AGENT); }
__device__ __forceinline__ unsigned xb_add(unsigned* p, unsigned v) { return __hip_atomic_fetch_add(p, v, __ATOMIC_RELAXED, __HIP_MEMORY_SCOPE_AGENT); }
__device__ __forceinline__ unsigned xb_xcc_id() { return (unsigned)__builtin_amdgcn_s_getreg((3 << 11) | 20) & 0xFu; }
#define XB_SPIN(cond, bar) do { unsigned _sp = 0; while (cond) { __builtin_amdgcn_s_sleep(1); \
    if ((++_sp & 255u) == 0u) { if (xb_ld(&(bar)[XB_TMO])) break; if (_sp > XB_SPIN_CAP) { atomicAdd(&(bar)[XB_TMO], 1u); break; } } } } while (0)

struct XcdBarrier {
    unsigned* bar; unsigned x;
    volatile LAS unsigned* st;
};

__device__ __forceinline__ XcdBarrier xcd_barrier_post(unsigned* bar, volatile LAS unsigned* st) {
    XcdBarrier b; b.bar = bar; b.x = xb_xcc_id(); b.st = st;
    if (threadIdx.x == 0) (void)xb_add(&bar[XB_XCNT(b.x)], 1u);
    return b;
}
__device__ __forceinline__ void xcd_barrier_complete(unsigned* bar, unsigned x, unsigned& nloc, unsigned& nx) {
    const unsigned G = gridDim.x * gridDim.y * gridDim.z;
    unsigned sum, cnt, mine, sp = 0u;
    for (;;) {
        sum = 0u; cnt = 0u; mine = 0u;
#pragma unroll
        for (unsigned j = 0; j < 16; ++j) { const unsigned c = xb_ld(&bar[XB_XCNT(j)]); sum += c; cnt += (c > 0u) ? 1u : 0u; mine = (j == x) ? c : mine; }
        if (sum == G) break;
        __builtin_amdgcn_s_sleep(1);
        if ((++sp & 255u) == 0u) { if (xb_ld(&bar[XB_TMO])) break; if (sp > XB_SPIN_CAP) { atomicAdd(&bar[XB_TMO], 1u); break; } }
    }
    nloc = mine > 0u ? mine : 1u; nx = cnt > 0u ? cnt : 1u;
}

__device__ __forceinline__ void xcd_barrier(const XcdBarrier& b) {
    asm volatile("s_waitcnt vmcnt(0)" ::: "memory");
    __syncthreads();
    if (threadIdx.x == 0) {
        unsigned* bar = b.bar;
        __builtin_amdgcn_s_waitcnt(0);
        unsigned nloc = b.st[0], nx = b.st[1];
        if (nloc == 0u) { xcd_barrier_complete(bar, b.x, nloc, nx); b.st[0] = nloc; b.st[1] = nx; }
        const unsigned old = xb_add(&bar[XB_XSUB(b.x)], 1u);
        const unsigned gen = old / nloc;
        if (old + 1u == (gen + 1u) * nloc) {
            __builtin_amdgcn_fence(__ATOMIC_RELEASE, "agent");
            asm volatile("s_waitcnt vmcnt(0)" ::: "memory");
            const unsigned og = xb_add(&bar[XB_TOP], 1u);
            const unsigned tg = og / nx;
            if (og + 1u == (tg + 1u) * nx) xb_add(&bar[XB_TOPGEN], 1u);
            else XB_SPIN(xb_ld(&bar[XB_TOPGEN]) == tg, bar);
            __builtin_amdgcn_fence(__ATOMIC_ACQUIRE, "agent");
            xb_add(&bar[XB_XGEN(b.x)], 1u);
            asm volatile("s_waitcnt vmcnt(0)" ::: "memory");
        } else {
            XB_SPIN(xb_ld(&bar[XB_XGEN(b.x)]) == gen, bar);
            __builtin_amdgcn_fence(__ATOMIC_ACQUIRE, "agent");
            asm volatile("s_waitcnt vmcnt(0)" ::: "memory");
        }
    }
    __syncthreads();
}

#ifndef PH_MASK
#define PH_MASK 0x7ff
#endif
#define PH(k) if constexpr ((PH_MASK >> (k)) & 1)
#ifndef REP_MASK
#define REP_MASK 0
#endif
#define REP(k) for (int rep_ = 0; rep_ <= ((REP_MASK >> (k)) & 1); ++rep_)
__global__ void __launch_bounds__(512, 2) yoco_fwd(Params P) {
    extern __shared__ __attribute__((aligned(16))) unsigned char lds[];
    cg::grid_group grid = cg::this_grid();
    volatile LAS unsigned* bst = (volatile LAS unsigned*)((LAS unsigned char*)lds + (LDS_TOTAL - 64));
    if (threadIdx.x == 0) { bst[0] = 0u; bst[1] = 0u; }
    __syncthreads();
    const XcdBarrier xbar = xcd_barrier_post((unsigned*)(P.ws + WS_BAR), bst);
#define GRID_SYNC() xcd_barrier(xbar)
    const int G = gridDim.x, NGW = G * 8;
#define PHASE_IDS() const int tid = opaque_tid(), lane = tid & 63, wave = __builtin_amdgcn_readfirstlane(tid >> 6), gw = blockIdx.x * 8 + wave; (void)lane; (void)gw
    unsigned char* ws = P.ws;
    float* rstd0 = (float*)(ws + SM_RSTD0); float* rstdm = (float*)(ws + SM_RSTDM); float* rowsq0 = (float*)(ws + SM_ROWSQ0); float* rowsq1 = (float*)(ws + SM_ROWSQ1);
    float* rstd1 = (float*)(ws + SM_RSTD1); float* logf_ = (float*)(ws + SM_LOGF); float* fcum = (float*)(ws + SM_FCUM); float* wft = (float*)(ws + SM_WFT);
    bf16r* xb = (bf16r*)(ws + WS_XB); bf16r* memb = (bf16r*)(ws + WS_MEMB); bf16r* proj = (bf16r*)(ws + WS_PROJ); bf16r* kvb = (bf16r*)(ws + WS_KVB);
    bf16r* cat = (bf16r*)(ws + WS_CAT); bf16r* ob = (bf16r*)(ws + WS_OB); bf16r* mkv = (bf16r*)(ws + WS_MKV);
    LAS unsigned char* glds = (LAS unsigned char*)lds;

    REP(0) {
    PH(0) { PHASE_IDS();
        LAS float* scr = (LAS float*)((LAS unsigned char*)lds + wave * 16384);
        constexpr int I_A = 32 * 128, I_GLU = 24 * 48, I_MK = 32 * 32, I_O = 32 * 64;
        constexpr int NIT = I_A + I_GLU + 2 * I_MK + I_O;
        for (int it = gw; it < NIT; it += NGW) {
            int r = it;
            if (r < I_A) { transpose_item(P.in[I_WINA], P.in[I_PREG], 2048, 4096, (bf16r*)(ws + WS_WINA), 0, scr, r, lane); continue; } r -= I_A;
            if (r < I_GLU) { transpose_item(P.in[I_WGLU], nullptr, 1536, 1536, (bf16r*)(ws + WS_WGLU), 0, scr, r, lane); continue; } r -= I_GLU;
            if (r < I_MK) { transpose_item(P.in[I_WMKV], P.in[I_MEMG], 2048, 1024, (bf16r*)(ws + WS_WMKV0), 0, scr, r, lane); continue; } r -= I_MK;
            if (r < I_MK) { transpose_item(P.in[I_WMKV] + (size_t)2048 * 1024, P.in[I_MEMG] + 2048, 2048, 1024, (bf16r*)(ws + WS_WMKV1), 0, scr, r, lane); continue; } r -= I_MK;
            transpose_item(P.in[I_WOUT], nullptr, 2048, 2048, (bf16r*)(ws + WS_WOUT0), 0, scr, r, lane);
        }
        rows_to_bf16(P.in[I_X], xb, rstd0, gw, NGW, NTOK, lane);
        rows_to_bf16(P.in[I_MEM], memb, rstdm, gw, NGW, NBATCH * NMEM, lane);
        for (int i = blockIdx.x * 512 + tid; i < NTOK; i += G * 512) { rowsq0[i] = 0.f; rowsq1[i] = 0.f; }
        for (int i = blockIdx.x * 512 + tid; i < 2 * 96 * SEQL; i += G * 512) ((float*)(ws + SM_QNRM))[i] = 0.f;
        for (int i = blockIdx.x * 512 + tid; i < 12 * DM; i += G * 512) { const int h = i / DM, k = i % DM; wft[i] = P.in[I_KVG][k] * P.in[I_WFG][k * 12 + h]; }
    }
    if (P.ws == nullptr) grid.sync();
    GRID_SYNC();
    }
    REP(1) {
    PH(1) {
        { pg8::Gemm g{xb, (const bf16r*)(ws + WS_WINA), NTOK, 4096, DM}; pg8::StaticOrder S; S.init(NTOK, 4096, G, (int)blockIdx.x);
          pg8::EpiProj<Sel0> E{rstd0, Sel0{proj}, 11};
          pg8::gemm_phase<pg8::EpiProj<Sel0>, pg8::StaticOrder, true, true>(glds, g, S, E); }
    }
    GRID_SYNC();
    }
    REP(2) {
    PH(2) { PHASE_IDS(); ssm_phase(P, lds, wave, lane);
    __syncthreads(); }
    GRID_SYNC();
    }
    REP(3) {
    PH(3) {
        { pg8::Gemm g{kvb  , (const bf16r*)(ws + WS_WGLU), NTOK, 1536, 1536}; pg8::StaticOrder S; S.init(NTOK, 1536, G, (int)blockIdx.x);
          pg8::EpiGlu E{kvb, proj + (size_t)NTOK * 1536, P.in[I_BGLU], cat};
          pg8::gemm_phase<pg8::EpiGlu, pg8::StaticOrder, true, true>(glds, g, S, E); }
        { pg8::Gemm g{memb, (const bf16r*)(ws + WS_WMKV0), NBATCH * NMEM, 1024, DM}; pg8::StaticOrder S; S.init(NBATCH * NMEM, 1024, G, (int)((blockIdx.x + G - G / 2) % G));
          pg8::EpiProj<SelM> E{rstdm, SelM{mkv}, 8};
          pg8::gemm_phase<pg8::EpiProj<SelM>, pg8::StaticOrder, true, true>(glds, g, S, E); }
        { pg8::Gemm g{memb, (const bf16r*)(ws + WS_WMKV1), NBATCH * NMEM, 1024, DM}; pg8::StaticOrder S; S.init(NBATCH * NMEM, 1024, G, (int)((blockIdx.x + G - G / 2 - 32) % G));
          pg8::EpiProj<SelM> E{rstdm, SelM{mkv + (size_t)2 * NBATCH * NMEM * 512}, 8};
          pg8::gemm_phase<pg8::EpiProj<SelM>, pg8::StaticOrder, true, true>(glds, g, S, E); }
        if ((int)blockIdx.x >= G - G / 4) {
            PHASE_IDS();
            LAS float* scr = (LAS float*)((LAS unsigned char*)lds + wave * 16384);
            constexpr int I_B = 32 * 128, I_KV = 32 * 96, I_O = 32 * 64, NIT2 = I_B + I_KV + I_O;
            const int gw2 = ((int)blockIdx.x - (G - G / 4)) * 8 + wave, NGW2 = (G / 4) * 8;
            for (int it = gw2; it < NIT2; it += NGW2) {
                int r = it;
                if (r < I_B) { transpose_item(P.in[I_WINB], P.in[I_PREG] + 2048, 2048, 4096, (bf16r*)(ws + WS_WKVB), 3072, scr, r, lane); continue; } r -= I_B;
                if (r < I_KV) { transpose_item(P.in[I_WKV], P.in[I_KVG], 2048, 3072, (bf16r*)(ws + WS_WKVB), 0, scr, r, lane); continue; } r -= I_KV;
                transpose_item(P.in[I_WOUT] + (size_t)2048 * 2048, nullptr, 2048, 2048, (bf16r*)(ws + WS_WOUT1), 0, scr, r, lane);
            }
        }
    }
    GRID_SYNC();
    }
    REP(10) {
    PH(10) att_phase<false, 0>(P, (char*)lds);
    GRID_SYNC();
    }
    REP(4) {
    PH(4) { pg8::Gemm g{cat, (const bf16r*)(ws + WS_WOUT0), NTOK, DM, DM}; pg8::StaticOrder S; S.init(NTOK, DM, G, (int)blockIdx.x);
      pg8::EpiOut E{ob, rep_ ? rowsq0 + 65536 * 9 : rowsq0};
      pg8::gemm_phase<pg8::EpiOut, pg8::StaticOrder, true, true>(glds, g, S, E); }
    GRID_SYNC();
    }
    REP(5) {
    PH(5) { PHASE_IDS();
        float* wl = (float*)lds;
        for (int i = tid; i < 12 * DM / 4; i += 512) ((f32x4*)wl)[i] = ((const f32x4*)wft)[i];
        __syncthreads();
        const float* gp = P.in[I_POSTG];
        f32x4 gv[8];
#pragma unroll
        for (int j = 0; j < 8; ++j) gv[j] = ((const f32x4*)gp)[lane + 64 * j];
        const float bfg = (lane < 12) ? P.in[I_BFG][lane] : 0.f;
        u32x2 xv[8]; u32x2 ov[8]; float rq = 0.f;
        if (gw < NTOK) { const u32x2* xp = (const u32x2*)(xb + (size_t)gw * DM) + lane; const u32x2* op = (const u32x2*)(ob + (size_t)gw * DM) + lane; rq = rowsq0[gw];
#pragma unroll
            for (int j = 0; j < 8; ++j) { xv[j] = xp[64 * j]; ov[j] = op[64 * j]; } }
        for (int m = gw; m < NTOK; m += NGW) {
            const float rso = 1.0f / sqrtf(rq * (1.0f / DM) + EPSN);
            u32x2 xn[8]; u32x2 on[8]; float rqn = 0.f; const int mn = m + NGW;
            if (mn < NTOK) { const u32x2* xp = (const u32x2*)(xb + (size_t)mn * DM) + lane; const u32x2* op = (const u32x2*)(ob + (size_t)mn * DM) + lane; rqn = rowsq0[mn];
#pragma unroll
                for (int j = 0; j < 8; ++j) { xn[j] = xp[64 * j]; on[j] = op[64 * j]; } }
            u32x2* hb = (u32x2*)(xb + (size_t)m * DM) + lane;
            f32x4 hv[8]; float s = 0.f;
#pragma unroll
            for (int j = 0; j < 8; ++j) {
                f32x4 h; h[0] = pg8::bf_lo(xv[j].x) + pg8::bf_lo(ov[j].x) * rso * gv[j][0]; h[1] = pg8::bf_hi(xv[j].x) + pg8::bf_hi(ov[j].x) * rso * gv[j][1];
                h[2] = pg8::bf_lo(xv[j].y) + pg8::bf_lo(ov[j].y) * rso * gv[j][2]; h[3] = pg8::bf_hi(xv[j].y) + pg8::bf_hi(ov[j].y) * rso * gv[j][3];
                hv[j] = h; s += (h[0] * h[0] + h[1] * h[1]) + (h[2] * h[2] + h[3] * h[3]);
                u32x2 w; w.x = pkbf(h[0], h[1]); w.y = pkbf(h[2], h[3]); hb[64 * j] = w; }
            if (mn < NTOK) {
#pragma unroll
                for (int j = 0; j < 8; ++j) { xv[j] = xn[j]; ov[j] = on[j]; } rq = rqn; }
            s = wave_sum(s); const float rs1 = 1.0f / sqrtf(s * (1.0f / DM) + EPSN);
            if (lane == 0) rstd1[m] = rs1;
            float dh[12];
#pragma unroll
            for (int h = 0; h < 12; ++h) {
                f32x4 wa[8];
#pragma unroll
                for (int j = 0; j < 8; ++j) wa[j] = *(const f32x4*)(wl + h * DM + (lane + 64 * j) * 4);
                __builtin_amdgcn_sched_barrier(0);
                float da = 0.f;
#pragma unroll
                for (int j = 0; j < 8; ++j) da += (hv[j][0] * wa[j][0] + hv[j][1] * wa[j][1]) + (hv[j][2] * wa[j][2] + hv[j][3] * wa[j][3]);
                dh[h] = da;
                __builtin_amdgcn_sched_barrier(0);
            }
#pragma unroll
            for (int o = 1; o < 64; o <<= 1) {
#pragma unroll
                for (int h = 0; h < 12; ++h) dh[h] += __shfl_xor(dh[h], o); }
            float mine = 0.f;
#pragma unroll
            for (int h = 0; h < 12; ++h) if (lane == h) mine = dh[h];
            if (lane < 12) { const float a = mine * rs1 + bfg; const float lf = fminf(a, 0.f) - __logf(1.f + __expf(-fabsf(a)));
                const int b = m >> 11, sidx = m & 2047; logf_[((size_t)(b * 12 + lane)) * SEQL + sidx] = lf; }
        }
    }
    GRID_SYNC();
    }
    REP(6) {
    PH(6) { PHASE_IDS();
        if (wave == 0) for (int rwi = blockIdx.x; rwi < NBATCH * 12; rwi += G) {
            const float* src = logf_ + (size_t)rwi * SEQL + lane * 32; float* dst = fcum + (size_t)rwi * SEQL + lane * 32;
            float v[32]; float run = 0.f;
#pragma unroll
            for (int q = 0; q < 8; ++q) { const f32x4 t = ((const f32x4*)src)[q]; v[4 * q] = t[0]; v[4 * q + 1] = t[1]; v[4 * q + 2] = t[2]; v[4 * q + 3] = t[3]; }
#pragma unroll
            for (int e = 0; e < 32; ++e) { run += v[e]; v[e] = run; }
            float incl = run;
#pragma unroll
            for (int o = 1; o < 64; o <<= 1) { const float t = __shfl_up(incl, o); if (lane >= o) incl += t; }
            const float excl = incl - run;
#pragma unroll
            for (int q = 0; q < 8; ++q) { f32x4 t = {v[4 * q] + excl, v[4 * q + 1] + excl, v[4 * q + 2] + excl, v[4 * q + 3] + excl}; ((f32x4*)dst)[q] = t; }
        }
        pg8::Gemm g{xb, (const bf16r*)(ws + WS_WKVB), NTOK, 7168, DM}; pg8::StaticOrder S; S.init(NTOK, 7168, G, (int)blockIdx.x);
        pg8::EpiProj<Sel1> E{rstd1, Sel1{kvb, proj, (float*)(ws + SM_QNRM), (float*)(ws + SM_KNRM)}, 11};
        pg8::gemm_phase<pg8::EpiProj<Sel1>, pg8::StaticOrder, true, true>(glds, g, S, E);
    }
    GRID_SYNC();
    }
    REP(7) {
    PH(7) att_phase<true, 1>(P, (char*)lds);
    GRID_SYNC();
    }
    REP(8) {
    PH(8) { pg8::Gemm g{cat, (const bf16r*)(ws + WS_WOUT1), NTOK, DM, DM}; pg8::StaticOrder S; S.init(NTOK, DM, G, (int)blockIdx.x);
      pg8::EpiOut E{ob, rep_ ? rowsq0 + 65536 * 9 : rowsq1};
      pg8::gemm_phase<pg8::EpiOut, pg8::StaticOrder, true, true>(glds, g, S, E); }
    GRID_SYNC();
    }
    REP(9) {
    PH(9) { PHASE_IDS();
        const float* gp = P.in[I_POSTG] + DM;
        f32x4 gv[8];
#pragma unroll
        for (int j = 0; j < 8; ++j) gv[j] = ((const f32x4*)gp)[lane + 64 * j];
        u32x2 hv[8]; u32x2 ov[8]; float rq = 0.f;
        if (gw < NTOK) { const u32x2* hp = (const u32x2*)(xb + (size_t)gw * DM) + lane; const u32x2* op = (const u32x2*)(ob + (size_t)gw * DM) + lane; rq = rowsq1[gw];
#pragma unroll
            for (int j = 0; j < 8; ++j) { hv[j] = hp[64 * j]; ov[j] = op[64 * j]; } }
        for (int m = gw; m < NTOK; m += NGW) {
            const float rso = 1.0f / sqrtf(rq * (1.0f / DM) + EPSN);
            u32x2 hn[8]; u32x2 on[8]; float rqn = 0.f; const int mn = m + NGW;
            if (mn < NTOK) { const u32x2* hp2 = (const u32x2*)(xb + (size_t)mn * DM) + lane; const u32x2* op = (const u32x2*)(ob + (size_t)mn * DM) + lane; rqn = rowsq1[mn];
#pragma unroll
                for (int j = 0; j < 8; ++j) { hn[j] = hp2[64 * j]; on[j] = op[64 * j]; } }
            f32x4* hp = (f32x4*)(P.out + (size_t)m * DM) + lane;
#pragma unroll
            for (int j = 0; j < 8; ++j) { f32x4 h;
                h[0] = pg8::bf_lo(hv[j].x) + pg8::bf_lo(ov[j].x) * rso * gv[j][0]; h[1] = pg8::bf_hi(hv[j].x) + pg8::bf_hi(ov[j].x) * rso * gv[j][1];
                h[2] = pg8::bf_lo(hv[j].y) + pg8::bf_lo(ov[j].y) * rso * gv[j][2]; h[3] = pg8::bf_hi(hv[j].y) + pg8::bf_hi(ov[j].y) * rso * gv[j][3];
                hp[64 * j] = h; }
            if (mn < NTOK) {
#pragma unroll
                for (int j = 0; j < 8; ++j) { hv[j] = hn[j]; ov[j] = on[j]; } rq = rqn; }
        }
    }
    }
}

extern "C" void kernel_launch(void* const* d_in, const int* in_sizes, int n_in, void* d_out, int out_size, void* d_ws, size_t ws_size, hipStream_t stream) {
    static int grid = 0;
    if (grid == 0) {
        if (n_in != 23 || out_size != NTOK * DM || ws_size < WS_END) { fprintf(stderr, "kernel_launch: unexpected shapes: n_in %d out %d ws %zu (need %zu)\n", n_in, out_size, ws_size, (size_t)WS_END); grid = -1; return; }
        int dev = 0, cus = 0, per_cu = 0;
        (void)hipGetDevice(&dev); (void)hipDeviceGetAttribute(&cus, hipDeviceAttributeMultiprocessorCount, dev);
        if (hipFuncSetAttribute((const void*)yoco_fwd, hipFuncAttributeMaxDynamicSharedMemorySize, LDS_TOTAL) != hipSuccess) { fprintf(stderr, "kernel_launch: hipFuncSetAttribute failed\n"); grid = -1; return; }
        if (hipOccupancyMaxActiveBlocksPerMultiprocessor(&per_cu, (const void*)yoco_fwd, 512, LDS_TOTAL) != hipSuccess || per_cu < 1) { fprintf(stderr, "kernel_launch: occupancy query says %d\n", per_cu); per_cu = 1; }
        (void)hipGetLastError();
        grid = cus * (per_cu > 1 ? 1 : per_cu);
        if (grid <= 0) grid = 256;
    }
    if (grid < 0) return;
    if (hipMemsetAsync((char*)d_ws + WS_BAR, 0, 16384, stream) != hipSuccess) { fprintf(stderr, "kernel_launch: hipMemsetAsync failed\n"); return; }
    Params p{};
    for (int i = 0; i < 23; ++i) p.in[i] = (const float*)d_in[i];
    p.out = (float*)d_out; p.ws = (unsigned char*)d_ws;
    void* args[] = {&p};
    hipError_t e = hipLaunchCooperativeKernel((const void*)yoco_fwd, dim3(grid), dim3(512), args, LDS_TOTAL, stream);
    if (e != hipSuccess) fprintf(stderr, "cooperative launch failed: %s (grid %d)\n", hipGetErrorString(e), grid);
}
```

```cpp
#include <hip/hip_runtime.h>
#include <hip/hip_bf16.h>
#include <hip/hip_cooperative_groups.h>
#include <cstdio>
#include <cstdint>
namespace cg = cooperative_groups;
__device__ __forceinline__ int opaque_tid() { int t = threadIdx.x; asm volatile("" : "+v"(t)); return t; }
namespace pg8 {
#define PG8_LAS __attribute__((address_space(3)))
typedef unsigned short bf16_t;
typedef short bf16x8 __attribute__((ext_vector_type(8)));
typedef float f32x4 __attribute__((ext_vector_type(4)));
typedef unsigned u32x4 __attribute__((ext_vector_type(4)));
constexpr int BM = 256, BK = 64, HALF = 128, HTB = HALF * BK * 2  , STAGE_BYTES = 8 * HTB, NXCD = 8, WGM = 8;

__host__ __device__ __forceinline__ int lds_byte(int r, int c) { const int st = (r >> 4) * 2 + (c >> 5), rr = r & 15, cc = c & 31, ob = rr * 64 + cc * 2; return st * 1024 + (ob ^ (((ob >> 9) & 1) << 5)); }
__host__ __device__ __forceinline__ void stage_rc(int b, int& R, int& C) { const int st = b / 1024, sb = b % 1024, swz = sb ^ (((sb >> 9) & 1) << 5); R = (st >> 1) * 16 + swz / 64; C = (st & 1) * 32 + (swz % 64) / 2; }
__host__ __device__ __forceinline__ int perm32(int rho) { const int n = rho >> 4, i = rho & 15; return 8 * (i >> 2) + 4 * n + (i & 3); }

struct Unit { int pm, pn; };
struct Gemm { const bf16_t* A; const bf16_t* Bt; int M, N, K; };

struct StaticOrder {
    int nM, nN, nwg, G, c;
    __host__ __device__ void init(int M, int N, int G_, int c_) { nM = M / BM; nN = N / BM; nwg = nM * nN; G = G_; c = c_; }
    __host__ __device__ bool next(int i, Unit& u) const {
        const long L = (long)i * G + c; if (L >= nwg) return false;
        int wgid = (int)L; { const int q = nwg / NXCD, r = nwg % NXCD, xcd = wgid % NXCD, off = wgid / NXCD; wgid = (xcd < r ? xcd * (q + 1) : r * (q + 1) + (xcd - r) * q) + off; }
        const int nig = WGM * nN, gid = wgid / nig, fm = gid * WGM, gsz = (nM - fm) < WGM ? (nM - fm) : WGM;
        u.pm = fm + ((wgid % nig) % gsz); u.pn = (wgid % nig) / gsz; return true;
    }
    __device__ __forceinline__ void a_ready(const Unit&) const {}
    __device__ __forceinline__ void done(const Unit&) const {}
};

__device__ __forceinline__ unsigned cvt_pk_bf16(float lo, float hi) { unsigned r; asm volatile("v_cvt_pk_bf16_f32 %0, %1, %2" : "=v"(r) : "v"(lo), "v"(hi)); return r; }
__device__ __forceinline__ float sigmoid_f(float v) { return __builtin_amdgcn_rcpf(1.f + __builtin_amdgcn_exp2f(-1.4426950408889634f * v)); }
__device__ __forceinline__ float silu_f(float v) { return v * sigmoid_f(v); }
__device__ __forceinline__ float bf_lo(unsigned w) { return __uint_as_float(w << 16); }
__device__ __forceinline__ float bf_hi(unsigned w) { return __uint_as_float(w & 0xffff0000u); }

__device__ __forceinline__ float xfq_sum(float v) {
    { auto r = __builtin_amdgcn_permlane16_swap(__float_as_uint(v), __float_as_uint(v), false, false); v = __uint_as_float(r[0]) + __uint_as_float(r[1]); }
    { auto r = __builtin_amdgcn_permlane32_swap(__float_as_uint(v), __float_as_uint(v), false, false); v = __uint_as_float(r[0]) + __uint_as_float(r[1]); }
    return v;
}
struct SecInfo { bf16_t* dst; int start; int ld; int nh; int act; float* nrm; };
template <class Sel> struct EpiProj {
    static constexpr bool PERM = true, AFTER_DRAIN = false;
    const float* rstd; Sel sel; int lgS;
    __device__ __forceinline__ void operator()(const f32x4 (&acc)[2][2][4][2], const Unit& u, int wr, int wc, int fr, int fq) const {
        const int row0 = u.pm * BM + wr * 64 + fr, cin = wc * 32 + 8 * fq;
        float rsv[2][4];
#pragma unroll
        for (int ai = 0; ai < 2; ++ai)
#pragma unroll
            for (int m = 0; m < 4; ++m) rsv[ai][m] = rstd[row0 + ai * HALF + m * 16];
#pragma unroll
        for (int bj = 0; bj < 2; ++bj) {
            const int cs = u.pn * BM + bj * HALF; const SecInfo si = sel(cs);
#pragma unroll
            for (int ai = 0; ai < 2; ++ai)
#pragma unroll
                for (int m = 0; m < 4; ++m) {
                    const int row = row0 + ai * HALF + m * 16; const float rs = rsv[ai][m];
                    f32x4 v0 = acc[ai][bj][m][0] * rs, v1 = acc[ai][bj][m][1] * rs;
                    if (si.act) {
#pragma unroll
                        for (int e = 0; e < 4; ++e) { v0[e] = silu_f(v0[e]); v1[e] = silu_f(v1[e]); } }
                    bf16_t* p;
                    if (si.nh) { const int b = row >> lgS, s = row & ((1 << lgS) - 1); const size_t hr = (((size_t)(b * si.nh + ((cs - si.start) >> 7))) << lgS) + s; p = si.dst + hr * 128 + cin;
                        if (si.nrm) { float q = (v0[0] * v0[0] + v0[1] * v0[1]) + (v0[2] * v0[2] + v0[3] * v0[3]) + (v1[0] * v1[0] + v1[1] * v1[1]) + (v1[2] * v1[2] + v1[3] * v1[3]);
                            q = xfq_sum(q); if (fq == 0) atomicAdd(si.nrm + hr, q); } }
                    else p = si.dst + (size_t)row * si.ld + (cs - si.start) + cin;
                    u32x4 w; w.x = cvt_pk_bf16(v0[0], v0[1]); w.y = cvt_pk_bf16(v0[2], v0[3]); w.z = cvt_pk_bf16(v1[0], v1[1]); w.w = cvt_pk_bf16(v1[2], v1[3]);
                    *(u32x4*)p = w;
                }
        }
    }
};
struct EpiGlu {
    static constexpr bool PERM = true, AFTER_DRAIN = false;
    const bf16_t* yg; const bf16_t* sz; const float* bias; bf16_t* cat;
    __device__ __forceinline__ void operator()(const f32x4 (&acc)[2][2][4][2], const Unit& u, int wr, int wc, int fr, int fq) const {
        const int row0 = u.pm * BM + wr * 64 + fr, col0 = u.pn * BM + wc * 32 + 8 * fq;
#pragma unroll
        for (int bj = 0; bj < 2; ++bj) {
            const int col = col0 + bj * HALF; const f32x4 b0 = *(const f32x4*)(bias + col), b1 = *(const f32x4*)(bias + col + 4);
#pragma unroll
            for (int ai = 0; ai < 2; ++ai) {
                u32x4 yv[4], zv[4];
#pragma unroll
                for (int m = 0; m < 4; ++m) { const int row = row0 + ai * HALF + m * 16;
                    yv[m] = *(const u32x4*)(yg + (size_t)row * 1536 + col); zv[m] = *(const u32x4*)(sz + (size_t)row * 2048 + col); }
#pragma unroll
                for (int m = 0; m < 4; ++m) {
                    const int row = row0 + ai * HALF + m * 16;
                    const u32x4 y = yv[m], z = zv[m];
                    const f32x4 g0 = acc[ai][bj][m][0] + b0, g1 = acc[ai][bj][m][1] + b1;
                    float o[8];
                    o[0] = bf_lo(y.x) * bf_lo(z.x) * sigmoid_f(g0[0]); o[1] = bf_hi(y.x) * bf_hi(z.x) * sigmoid_f(g0[1]);
                    o[2] = bf_lo(y.y) * bf_lo(z.y) * sigmoid_f(g0[2]); o[3] = bf_hi(y.y) * bf_hi(z.y) * sigmoid_f(g0[3]);
                    o[4] = bf_lo(y.z) * bf_lo(z.z) * sigmoid_f(g1[0]); o[5] = bf_hi(y.z) * bf_hi(z.z) * sigmoid_f(g1[1]);
                    o[6] = bf_lo(y.w) * bf_lo(z.w) * sigmoid_f(g1[2]); o[7] = bf_hi(y.w) * bf_hi(z.w) * sigmoid_f(g1[3]);
                    u32x4 w; w.x = cvt_pk_bf16(o[0], o[1]); w.y = cvt_pk_bf16(o[2], o[3]); w.z = cvt_pk_bf16(o[4], o[5]); w.w = cvt_pk_bf16(o[6], o[7]);
                    *(u32x4*)(cat + (size_t)row * 2048 + col) = w;
                }
            }
        }
    }
};
struct EpiOut {
    static constexpr bool PERM = true, AFTER_DRAIN = false;
    bf16_t* o; float* rowsq;
    __device__ __forceinline__ void operator()(const f32x4 (&acc)[2][2][4][2], const Unit& u, int wr, int wc, int fr, int fq) const {
        const int row0 = u.pm * BM + wr * 64 + fr, col0 = u.pn * BM + wc * 32 + 8 * fq;
#pragma unroll
        for (int ai = 0; ai < 2; ++ai)
#pragma unroll
            for (int m = 0; m < 4; ++m) {
                const int row = row0 + ai * HALF + m * 16; float s = 0.f;
#pragma unroll
                for (int bj = 0; bj < 2; ++bj) {
                    const f32x4 v0 = acc[ai][bj][m][0], v1 = acc[ai][bj][m][1];
                    s += (v0[0] * v0[0] + v0[1] * v0[1]) + (v0[2] * v0[2] + v0[3] * v0[3]) + (v1[0] * v1[0] + v1[1] * v1[1]) + (v1[2] * v1[2] + v1[3] * v1[3]);
                    u32x4 w; w.x = cvt_pk_bf16(v0[0], v0[1]); w.y = cvt_pk_bf16(v0[2], v0[3]); w.z = cvt_pk_bf16(v1[0], v1[1]); w.w = cvt_pk_bf16(v1[2], v1[3]);
                    *(u32x4*)(o + (size_t)row * 2048 + col0 + bj * HALF) = w;
                }
                s = xfq_sum(s);
                if (fq == 0) atomicAdd(rowsq + row, s);
            }
    }
};

template <class Epi, class Sched, bool ALIGN_EPI = false, bool SP2 = false>
__device__ __forceinline__ void gemm_phase(PG8_LAS unsigned char* lds, const Gemm g, const Sched& S, const Epi& E) {
    const int tid = opaque_tid(), wid = __builtin_amdgcn_readfirstlane(tid >> 6), lane = tid & 63, wr = wid >> 2, wc = wid & 3, fr = lane & 15, fq = lane >> 4;
    const int K = g.K, nt = K / BK;
    unsigned voffA[2], voffB[2];
#pragma unroll
    for (int i = 0; i < 2; ++i) { int R, C; stage_rc(tid * 16 + i * 8192, R, C); const int Rb = Epi::PERM ? ((R & ~31) + perm32(R & 31)) : R;
        voffA[i] = (unsigned)(R * K + C) * 2u; voffB[i] = (unsigned)(Rb * K + C) * 2u; }
    const size_t kstep = (size_t)(BK * 2);
    const size_t hstep = (size_t)HALF * K * 2;
    const size_t tstep = 2 * hstep;
    const unsigned ldsw = (unsigned)wid * 1024u;
    const int aoff = lds_byte(wr * 64 + fr, fq * 8), boff = lds_byte(wc * 32 + fr, fq * 8);
#define PG8_SA(b, h) (((b) * 2 + (h)) * HTB)
#define PG8_SB(b, h) ((4 + (b) * 2 + (h)) * HTB)
#define PG8_STAGE(bufoff, gbase, voff) do { _Pragma("unroll") for (int _i = 0; _i < 2; ++_i) \
        __builtin_amdgcn_global_load_lds((const unsigned*)((const char*)(gbase) + (voff)[_i]), (PG8_LAS unsigned*)(lds + (bufoff) + ldsw + _i * 8192), 16, 0, 0); } while (0)
#define PG8_LDA(dst, b, h) do { _Pragma("unroll") for (int m = 0; m < 4; ++m) _Pragma("unroll") for (int k = 0; k < 2; ++k) dst[m][k] = *(const PG8_LAS bf16x8*)(lds + PG8_SA(b, h) + aoff + m * 2048 + k * 1024); } while (0)
#define PG8_LDB(dst, b, h) do { _Pragma("unroll") for (int n = 0; n < 2; ++n) _Pragma("unroll") for (int k = 0; k < 2; ++k) dst[n][k] = *(const PG8_LAS bf16x8*)(lds + PG8_SB(b, h) + boff + n * 2048 + k * 1024); } while (0)
#define PG8_MMA(ai, bj, At, Bt) do { __builtin_amdgcn_s_setprio(1); _Pragma("unroll") for (int m = 0; m < 4; ++m) _Pragma("unroll") for (int n = 0; n < 2; ++n) _Pragma("unroll") for (int k = 0; k < 2; ++k) \
        acc[ai][bj][m][n] = __builtin_amdgcn_mfma_f32_16x16x32_bf16(Bt[n][k], At[m][k], acc[ai][bj][m][n], 0, 0, 0); __builtin_amdgcn_s_setprio(0); } while (0)
#define PG8_WAIT_V(n) asm volatile("s_waitcnt vmcnt(" #n ")" ::: "memory")
#define PG8_WAIT_L(n) asm volatile("s_waitcnt lgkmcnt(" #n ")" ::: "memory")
#define PG8_BAR __builtin_amdgcn_s_barrier()
#define PG8_SCHED __builtin_amdgcn_sched_barrier(0)
    Unit cur, nxt; int ui = 0;
    if (!S.next(0, cur)) return;
    f32x4 acc[2][2][4][2];
#pragma unroll
    for (int a = 0; a < 2; ++a)
#pragma unroll
        for (int b = 0; b < 2; ++b)
#pragma unroll
            for (int m = 0; m < 4; ++m)
#pragma unroll
                for (int n = 0; n < 2; ++n) acc[a][b][m][n] = (f32x4){0.f, 0.f, 0.f, 0.f};
    bf16x8 At[4][2], B0[2][2], B1[2][2];
    const char* cA = (const char*)g.A + (size_t)cur.pm * tstep; const char* cB = (const char*)g.Bt + (size_t)cur.pn * tstep;
    S.a_ready(cur);
    if constexpr (SP2) {
        PG8_STAGE(PG8_SB(0, 0), cB, voffB); PG8_STAGE(PG8_SB(0, 1), cB + hstep, voffB); PG8_STAGE(PG8_SA(0, 0), cA, voffA); PG8_STAGE(PG8_SA(0, 1), cA + hstep, voffA);
        if (wr == 1) PG8_BAR;
        PG8_WAIT_V(2); PG8_BAR;
        PG8_STAGE(PG8_SB(1, 0), cB + kstep, voffB); PG8_STAGE(PG8_SA(1, 0), cA + kstep, voffA); PG8_STAGE(PG8_SB(1, 1), cB + hstep + kstep, voffB);
        PG8_WAIT_V(6); PG8_BAR;
    } else {
        PG8_STAGE(PG8_SB(0, 0), cB, voffB); PG8_STAGE(PG8_SA(0, 0), cA, voffA); PG8_STAGE(PG8_SB(0, 1), cB + hstep, voffB); PG8_STAGE(PG8_SA(0, 1), cA + hstep, voffA);
        if (wr == 1) PG8_BAR;
        PG8_WAIT_V(4); PG8_BAR;
        PG8_STAGE(PG8_SB(1, 0), cB + kstep, voffB); PG8_STAGE(PG8_SA(1, 0), cA + kstep, voffA); PG8_STAGE(PG8_SB(1, 1), cB + hstep + kstep, voffB);
        PG8_WAIT_V(6); PG8_BAR;
    }
    for (;;) {
        const bool has_next = S.next(ui + 1, nxt);
        const char* nA = has_next ? (const char*)g.A + (size_t)nxt.pm * tstep : cA; const char* nB = has_next ? (const char*)g.Bt + (size_t)nxt.pn * tstep : cB;
        for (int t = 0; t < nt; t += 2) {
            const bool last = (t == nt - 2);
            const char* a1 = cA + (size_t)(t + 1) * kstep;
            const char* a2 = last ? nA : cA + (size_t)(t + 2) * kstep; const char* b2 = last ? nB : cB + (size_t)(t + 2) * kstep;
            const char* a3 = a2 + kstep; const char* b3 = b2 + kstep;
            if (last && has_next) S.a_ready(nxt);
            if constexpr (SP2) {
            PG8_LDB(B0, 0, 0); PG8_LDB(B1, 0, 1); PG8_SCHED; PG8_LDA(At, 0, 0); PG8_STAGE(PG8_SA(1, 1), a1 + hstep, voffA);
            PG8_WAIT_V(8); PG8_WAIT_L(0); PG8_BAR; PG8_MMA(0, 0, At, B0); PG8_MMA(0, 1, At, B1); PG8_BAR; PG8_SCHED;
            PG8_LDA(At, 0, 1); PG8_STAGE(PG8_SB(0, 0), b2, voffB); PG8_STAGE(PG8_SB(0, 1), b2 + hstep, voffB); PG8_STAGE(PG8_SA(0, 0), a2, voffA);
            PG8_WAIT_V(8); PG8_WAIT_L(0); PG8_BAR; PG8_MMA(1, 0, At, B0); PG8_MMA(1, 1, At, B1); PG8_BAR; PG8_SCHED;
            PG8_LDB(B0, 1, 0); PG8_LDB(B1, 1, 1); PG8_SCHED; PG8_LDA(At, 1, 0); PG8_STAGE(PG8_SA(0, 1), a2 + hstep, voffA);
            PG8_WAIT_V(8); PG8_WAIT_L(0); PG8_BAR; PG8_MMA(0, 0, At, B0); PG8_MMA(0, 1, At, B1); PG8_BAR; PG8_SCHED;
            PG8_LDA(At, 1, 1); PG8_STAGE(PG8_SB(1, 0), b3, voffB); PG8_STAGE(PG8_SB(1, 1), b3 + hstep, voffB); PG8_STAGE(PG8_SA(1, 0), a3, voffA);
            PG8_WAIT_V(8); PG8_WAIT_L(0); PG8_BAR; PG8_MMA(1, 0, At, B0); PG8_MMA(1, 1, At, B1); PG8_BAR; PG8_SCHED;
            } else {
            PG8_LDB(B0, 0, 0); PG8_SCHED; PG8_LDA(At, 0, 0); PG8_STAGE(PG8_SA(1, 1), a1 + hstep, voffA);
            PG8_WAIT_L(8); PG8_BAR; PG8_WAIT_L(0); PG8_MMA(0, 0, At, B0); PG8_BAR; PG8_SCHED;
            PG8_LDB(B1, 0, 1); PG8_STAGE(PG8_SB(0, 0), b2, voffB);
            PG8_BAR; PG8_WAIT_L(0); PG8_MMA(0, 1, At, B1); PG8_BAR;
            PG8_LDA(At, 0, 1); PG8_STAGE(PG8_SA(0, 0), a2, voffA);
            PG8_BAR; PG8_WAIT_L(0); PG8_MMA(1, 0, At, B0); PG8_BAR; PG8_SCHED;
            PG8_STAGE(PG8_SB(0, 1), b2 + hstep, voffB);
            PG8_WAIT_V(6); PG8_BAR; PG8_MMA(1, 1, At, B1); PG8_BAR;
            PG8_LDB(B0, 1, 0); PG8_SCHED; PG8_LDA(At, 1, 0); PG8_STAGE(PG8_SA(0, 1), a2 + hstep, voffA);
            PG8_WAIT_L(8); PG8_BAR; PG8_WAIT_L(0); PG8_MMA(0, 0, At, B0); PG8_BAR; PG8_SCHED;
            PG8_LDB(B1, 1, 1); PG8_STAGE(PG8_SB(1, 0), b3, voffB);
            PG8_BAR; PG8_WAIT_L(0); PG8_MMA(0, 1, At, B1); PG8_BAR;
            PG8_LDA(At, 1, 1); PG8_STAGE(PG8_SA(1, 0), a3, voffA);
            PG8_BAR; PG8_WAIT_L(0); PG8_MMA(1, 0, At, B0); PG8_BAR; PG8_SCHED;
            PG8_STAGE(PG8_SB(1, 1), b3 + hstep, voffB);
            PG8_WAIT_V(6); PG8_BAR; PG8_MMA(1, 1, At, B1); PG8_BAR;
            }
        }
        if constexpr (ALIGN_EPI) { if (wr == 0) PG8_BAR; }
        if constexpr (!Epi::AFTER_DRAIN) { E(acc, cur, wr, wc, fr, fq); S.done(cur); }
        if (!has_next) break;
#pragma unroll
        for (int a = 0; a < 2; ++a)
#pragma unroll
            for (int b = 0; b < 2; ++b)
#pragma unroll
                for (int m = 0; m < 4; ++m)
#pragma unroll
                    for (int n = 0; n < 2; ++n) acc[a][b][m][n] = (f32x4){0.f, 0.f, 0.f, 0.f};
        cur = nxt; cA = nA; cB = nB; ++ui;
        if constexpr (ALIGN_EPI) { if (wr == 1) PG8_BAR; }
    }
    PG8_WAIT_V(0);
    if constexpr (!ALIGN_EPI) { if (wr == 0) PG8_BAR; }
    PG8_BAR;
    if constexpr (Epi::AFTER_DRAIN) { E.fused(acc, cur, wr, wc, fr, fq, lds, wid, lane); S.done(cur); }
#undef PG8_SA
#undef PG8_SB
#undef PG8_STAGE
#undef PG8_LDA
#undef PG8_LDB
#undef PG8_MMA
#undef PG8_WAIT_V
#undef PG8_WAIT_L
#undef PG8_BAR
#undef PG8_SCHED
}
}
namespace att {
constexpr int D = 128; constexpr bool WSKIP = false; constexpr float THR = 8.f;
constexpr float SCALE = 0.08838834764831845f;
constexpr int NW = 8, QBLK = 32, KVBLK = 64, QB = NW * QBLK;
constexpr int SHM_V = KVBLK * D * 2, SHM_K = KVBLK * D * 2;
constexpr int FB_OFF = 2 * SHM_V + 2 * SHM_K + NW * 64 * 4;
constexpr int QL_OFF = FB_OFF + 2048 * 4;
constexpr int LDS_BYTES = QL_OFF + NW * QBLK * D * 2;
constexpr int LDO = 2048; constexpr float INV_SCALE = 11.313708498984761f;

using bf16 = __hip_bfloat16;
typedef short bf16x8 __attribute__((ext_vector_type(8)));
typedef short s16x4 __attribute__((ext_vector_type(4)));
typedef float f32x16 __attribute__((ext_vector_type(16)));
typedef float f32x4 __attribute__((ext_vector_type(4)));
typedef unsigned u32x4 __attribute__((ext_vector_type(4)));
template <class A, class Bt> struct same_t { static constexpr bool v = false; };
template <class A> struct same_t<A, A> { static constexpr bool v = true; };

#define KSWZ(row, colB) ((row) * 256 + ((colB) ^ (((row) & 7) << 4)))
#define SBAR() __builtin_amdgcn_sched_barrier(0)
__device__ __forceinline__ int v_st(int k, int c) { const int kk = (k & ~0xC) | ((k & 4) << 1) | ((k & 8) >> 1); return ((kk >> 3) * 4 + (c >> 5)) * 512 + ((kk & 7) * 32 + (c & 31)) * 2; }
__device__ __forceinline__ int v_rd_base(int lane) { return ((lane & 3) << 3) | (((lane >> 2) & 3) << 6) | (((lane >> 4) & 1) << 5) | (((lane >> 5) & 1) << 8); }
constexpr int v_rd_off(int d0, int ks, int half) { return d0 * 512 + ks * 4096 + half * 2048; }
__device__ __forceinline__ int crow(int r, int hi) { return (r & 3) + 8 * (r >> 2) + 4 * hi; }
__device__ __forceinline__ unsigned cvtpk(float lo, float hi) {
    unsigned r; asm volatile("v_cvt_pk_bf16_f32 %0, %1, %2" : "=v"(r) : "v"(lo), "v"(hi)); return r;
}
__device__ __forceinline__ bf16x8 pack8(f32x4 a, f32x4 b) {
    u32x4 w = {cvtpk(a[0], a[1]), cvtpk(a[2], a[3]), cvtpk(b[0], b[1]), cvtpk(b[2], b[3])};
    return *reinterpret_cast<bf16x8*>(&w);
}
template <class T> __device__ __forceinline__ bf16x8 load8(const T* p) {
    if constexpr (same_t<T, float>::v) { return pack8(*(const f32x4*)p, *(const f32x4*)(p + 4)); }
    else { return *reinterpret_cast<const bf16x8*>(p); }
}
__device__ __forceinline__ void mask_tile(f32x16& p0, f32x16& p1, int dq, unsigned W) {
    const float NEG = -__builtin_inff();
#pragma unroll
    for (int r = 0; r < 16; ++r) {
        const int c = (r & 3) + 8 * (r >> 2);
        if ((unsigned)(dq - c) >= W) p0[r] = NEG;
        if ((unsigned)(dq - c - 32) >= W) p1[r] = NEG;
    }
}
__device__ __forceinline__ void partialSM(f32x16& p0, f32x16& p1, float& m_reg, float& mn, float& alpha) {
    float pmax = p0[0]; for (int r = 1; r < 16; ++r) pmax = fmaxf(pmax, p0[r]); for (int r = 0; r < 16; ++r) pmax = fmaxf(pmax, p1[r]);
    { auto rr = __builtin_amdgcn_permlane32_swap(__float_as_uint(pmax), __float_as_uint(pmax), false, false);
      pmax = fmaxf(__uint_as_float(rr[0]), __uint_as_float(rr[1])); }
    constexpr float C2 = 1.4426950408889634f * SCALE;
    if (__builtin_expect(__all((pmax - m_reg) * SCALE <= THR), 1)) { mn = m_reg; alpha = 1.f; }
    else { mn = fmaxf(m_reg, pmax); alpha = __builtin_amdgcn_exp2f((m_reg - mn) * C2); m_reg = mn; }
    const float mnL = -mn * C2;
    for (int r = 0; r < 16; ++r) p0[r] = fmaf(p0[r], C2, mnL); for (int r = 0; r < 16; ++r) p1[r] = fmaf(p1[r], C2, mnL);
    for (int r = 0; r < 16; ++r) p0[r] = __builtin_amdgcn_exp2f(p0[r]);
}
__device__ __forceinline__ void finishSM(f32x16& p0, f32x16& p1, float alpha, float& l_reg, bf16x8& pa0, bf16x8& pa1, bf16x8& pa2, bf16x8& pa3) {
    for (int r = 0; r < 16; ++r) p1[r] = __builtin_amdgcn_exp2f(p1[r]);
    float ps = 0; for (int r = 0; r < 16; ++r) ps += p0[r]; for (int r = 0; r < 16; ++r) ps += p1[r];
    { auto rr = __builtin_amdgcn_permlane32_swap(__float_as_uint(ps), __float_as_uint(ps), false, false);
      ps = __uint_as_float(rr[0]) + __uint_as_float(rr[1]); }
    l_reg = l_reg * alpha + ps;
#define PK4(P, B_, OUT) do { unsigned a0 = cvtpk(P[B_+0], P[B_+1]), a1 = cvtpk(P[B_+2], P[B_+3]);                          \
        unsigned b0 = cvtpk(P[B_+4], P[B_+5]), b1 = cvtpk(P[B_+6], P[B_+7]);                                             \
        auto r0 = __builtin_amdgcn_permlane32_swap(a0, b0, false, false); auto r1 = __builtin_amdgcn_permlane32_swap(a1, b1, false, false); \
        u32x4 w = {r0[0], r1[0], r0[1], r1[1]}; OUT = *reinterpret_cast<bf16x8*>(&w); } while (0)
    PK4(p0, 0, pa0); PK4(p0, 8, pa1); PK4(p1, 0, pa2); PK4(p1, 8, pa3);
#undef PK4
}
template <int KB, bool SK>
__device__ __forceinline__ void qkt(f32x16& p0, f32x16& p1, const char* K_lds, int r32, int hi, const char* q_w, bool act, const float* fbt) {
    if (SK && !act) { const float NEG = -__builtin_inff();
#pragma unroll
        for (int r = 0; r < 16; ++r) { p0[r] = NEG; p1[r] = NEG; } return; }
    {
#pragma unroll
        for (int r4 = 0; r4 < 4; ++r4) { const f32x4 a = *(const f32x4*)(fbt + 8 * r4 + 4 * hi), b = *(const f32x4*)(fbt + 32 + 8 * r4 + 4 * hi);
            p0[4 * r4] = a[0]; p0[4 * r4 + 1] = a[1]; p0[4 * r4 + 2] = a[2]; p0[4 * r4 + 3] = a[3];
            p1[4 * r4] = b[0]; p1[4 * r4 + 1] = b[1]; p1[4 * r4 + 2] = b[2]; p1[4 * r4 + 3] = b[3]; }
    }
    const char* kb[4]; const char* qb[4];
#pragma unroll
    for (int dd = 0; dd < 4; ++dd) { kb[dd] = K_lds + KB * SHM_K + KSWZ(r32, (dd * 16 + hi * 8) * 2); qb[dd] = q_w + KSWZ(r32, (dd * 16 + hi * 8) * 2); }
    bf16x8 b0 = *reinterpret_cast<const bf16x8*>(kb[0]), b1 = *reinterpret_cast<const bf16x8*>(kb[0] + 32 * 256), qf = *reinterpret_cast<const bf16x8*>(qb[0]);
#pragma unroll
    for (int d0 = 0; d0 < 8; ++d0) {
        bf16x8 b0n = b0, b1n = b1, qfn = qf;
        if (d0 < 7) { const char* a = kb[(d0 + 1) & 3] + ((d0 + 1) >> 2) * 128;
            b0n = *reinterpret_cast<const bf16x8*>(a); b1n = *reinterpret_cast<const bf16x8*>(a + 32 * 256);
            qfn = *reinterpret_cast<const bf16x8*>(qb[(d0 + 1) & 3] + ((d0 + 1) >> 2) * 128); }
        __builtin_amdgcn_sched_barrier(0);
        p0 = __builtin_amdgcn_mfma_f32_32x32x16_bf16(b0, qf, p0, 0, 0, 0);
        p1 = __builtin_amdgcn_mfma_f32_32x32x16_bf16(b1, qf, p1, 0, 0, 0);
        __builtin_amdgcn_sched_barrier(0);
        b0 = b0n; b1 = b1n; qf = qfn; }
}
template <int VB, bool SK>
__device__ __forceinline__ void pv_tile(f32x16* o, int vb0, bf16x8 pa0, bf16x8 pa1, bf16x8 pa2, bf16x8 pa3, bool act) {
    if (SK && !act) return;
#define TRRD(dst, off) asm volatile("ds_read_b64_tr_b16 %0, %1 offset:%2" : "=&v"(dst) : "v"(vb0), "i"(off) : "memory")
#define PV_D0(d0) do { s16x4 l0, l1, l2, l3, h0, h1, h2, h3; constexpr int b_ = VB * SHM_V + v_rd_off(d0, 0, 0);     \
        TRRD(l0, b_); TRRD(h0, b_ + 2048); TRRD(l1, b_ + 4096); TRRD(h1, b_ + 6144); TRRD(l2, b_ + 8192); TRRD(h2, b_ + 10240); TRRD(l3, b_ + 12288); TRRD(h3, b_ + 14336); \
        asm volatile("s_waitcnt lgkmcnt(0)" ::: "memory"); SBAR();                 \
        o[d0] = __builtin_amdgcn_mfma_f32_32x32x16_bf16(pa0, (bf16x8){l0[0], l0[1], l0[2], l0[3], h0[0], h0[1], h0[2], h0[3]}, o[d0], 0, 0, 0);   \
        o[d0] = __builtin_amdgcn_mfma_f32_32x32x16_bf16(pa1, (bf16x8){l1[0], l1[1], l1[2], l1[3], h1[0], h1[1], h1[2], h1[3]}, o[d0], 0, 0, 0);   \
        o[d0] = __builtin_amdgcn_mfma_f32_32x32x16_bf16(pa2, (bf16x8){l2[0], l2[1], l2[2], l2[3], h2[0], h2[1], h2[2], h2[3]}, o[d0], 0, 0, 0);   \
        o[d0] = __builtin_amdgcn_mfma_f32_32x32x16_bf16(pa3, (bf16x8){l3[0], l3[1], l3[2], l3[3], h3[0], h3[1], h3[2], h3[3]}, o[d0], 0, 0, 0); } while (0)
    PV_D0(0); PV_D0(1); PV_D0(2); PV_D0(3);
#undef PV_D0
#undef TRRD
}

template <class TIn, class TOut> struct BlockRef { const TIn* Q; const TIn* K; const TIn* V; TOut* O; const float* FC; const TIn* G; int P0; int JLO; };
template <class TIn> struct Seam {
    bf16x8 qr[8];
    bf16x8 st_v0, st_v1, st_k0, st_k1; f32x4 sf0, sf1, sf2, sf3;
    f32x4 tq[16];
};
__device__ __forceinline__ int swa_jlo(int P0, int W) { const int lowk = P0 - W + 1; return lowk > 0 ? lowk / KVBLK : 0; }
#define ROW(p, k0, rr) ((p) + (size_t)((k0) + (rr)) * D + sc)
#define VMW() asm volatile("s_waitcnt vmcnt(0)" ::: "memory")
#define VMWN(n) asm volatile("s_waitcnt vmcnt(%0)" :: "i"(n) : "memory")
#define SLOAD_H(Kp, Vp, k0) do { S.st_v0 = load8<TIn>(ROW(Vp, k0, sr)); S.st_v1 = load8<TIn>(ROW(Vp, k0, 32 + sr));              \
                         S.st_k0 = load8<TIn>(ROW(Kp, k0, sr)); S.st_k1 = load8<TIn>(ROW(Kp, k0, 32 + sr)); } while (0)
#define SWRITE_HK(bf) do { *(bf16x8*)(K_lds + (bf) * SHM_K + kws) = S.st_k0; *(bf16x8*)(K_lds + (bf) * SHM_K + kws + 32 * 256) = S.st_k1; } while (0)
#define SWRITE_HV(bf) do { *(bf16x8*)(V_lds + (bf) * SHM_V + vst0) = S.st_v0; *(bf16x8*)(V_lds + (bf) * SHM_V + vst1) = S.st_v1; } while (0)
#define SWRITE_H(bf) do { SWRITE_HV(bf); SWRITE_HK(bf); } while (0)
#define SLOAD_F(p, k0) do { S.sf0 = *(const f32x4*)ROW(p, k0, sr); S.sf1 = *(const f32x4*)(ROW(p, k0, sr) + 4);                \
                            S.sf2 = *(const f32x4*)ROW(p, k0, 32 + sr); S.sf3 = *(const f32x4*)(ROW(p, k0, 32 + sr) + 4); } while (0)
#define SWRITE_KF(bf) do { *(bf16x8*)(K_lds + (bf) * SHM_K + kws) = pack8(S.sf0, S.sf1); *(bf16x8*)(K_lds + (bf) * SHM_K + kws + 32 * 256) = pack8(S.sf2, S.sf3); } while (0)
#define SWRITE_VF(bf) do { *(bf16x8*)(V_lds + (bf) * SHM_V + vst0) = pack8(S.sf0, S.sf1); *(bf16x8*)(V_lds + (bf) * SHM_V + vst1) = pack8(S.sf2, S.sf3); } while (0)
template <class TIn, class TOut>
__device__ __forceinline__ void causal_swa_prime(const BlockRef<TIn, TOut>& cur, int W, char* lds, Seam<TIn>& S) {
    constexpr bool F32 = same_t<TIn, float>::v;
    const int tid = opaque_tid(), wid = __builtin_amdgcn_readfirstlane(tid >> 6), lane = tid & 63, r32 = lane & 31, hi = lane >> 5;
    const int sr = tid >> 4, sc = (tid & 15) * 8, kws = KSWZ(sr, sc * 2); char* K_lds = lds + 2 * SHM_V;
    const int kb0 = cur.JLO * KVBLK;
    for (int d0 = 0; d0 < 8; ++d0) S.qr[d0] = load8<TIn>(cur.Q + (size_t)(wid * QBLK + r32) * D + d0 * 16 + hi * 8);
    { char* q_w = lds + QL_OFF + wid * (QBLK * D * 2);
      for (int d0 = 0; d0 < 8; ++d0) *reinterpret_cast<bf16x8*>(q_w + KSWZ(r32, (d0 * 16 + hi * 8) * 2)) = S.qr[d0]; }
    if constexpr (F32) { SLOAD_F((const float*)cur.K, kb0); VMW(); SWRITE_KF(0); SBAR(); SLOAD_F((const float*)cur.V, kb0); }
    else { SLOAD_H(cur.K, cur.V, kb0); VMW(); SWRITE_HK(0); }
    __syncthreads();
}
template <class TIn, class TOut>
__device__ __forceinline__ void causal_swa_block(const BlockRef<TIn, TOut>& cur, const BlockRef<TIn, TOut>& nxt, int skv, int W, char* lds, Seam<TIn>& S) {
    constexpr bool F32 = same_t<TIn, float>::v;
    const int tid = opaque_tid(), wid = __builtin_amdgcn_readfirstlane(tid >> 6), lane = tid & 63, r32 = lane & 31, hi = lane >> 5;
    const int j_lo = cur.JLO;
    int j_hi = (cur.P0 + QB - 1) / KVBLK + 1; if (j_hi > skv / KVBLK) j_hi = skv / KVBLK;
    const int NT = j_hi - j_lo;
    const int kbn = nxt.JLO * KVBLK;
    const int qlo = cur.P0 + wid * QBLK, qm = qlo + r32 - 4 * hi;
    char* V_lds = lds; char* K_lds = lds + 2 * SHM_V;
    float* ws = (float*)(lds + 2 * SHM_V + 2 * SHM_K) + wid * 64; float* li_l = ws, * al_l = ws + 32;
    float m_reg = -1e30f, l_reg = 0; f32x16 o[4] = {};
    const int sr = tid >> 4, sc = (tid & 15) * 8, vst0 = v_st(sr, sc), vst1 = v_st(32 + sr, sc), kws = KSWZ(sr, sc * 2);
    const int vb0 = (int)(uintptr_t)V_lds + v_rd_base(lane);
    const TIn* Kh = cur.K; const TIn* Vh = cur.V;
    char* q_w = lds + QL_OFF + wid * (QBLK * D * 2);
    float* fb = (float*)(lds + FB_OFF);
    { const int nk = j_hi * KVBLK; const float* FCp = cur.FC; const float c0 = FCp ? FCp[cur.P0] : 0.f;
#pragma unroll
      for (int k = 0; k < 4; ++k) { const int i = tid + 64 * NW * k;
          if (i < nk) { float v = 0.f; if (FCp) v = (c0 - FCp[i]) * INV_SCALE; fb[i] = v; } }
      __syncthreads(); }
#define RESC(a) do { if (__any((a) < 1.f)) { if (hi == 0) al_l[r32] = (a); asm volatile("s_waitcnt lgkmcnt(0)" ::: "memory");              \
                     for (int d_ = 0; d_ < 4; ++d_) for (int r = 0; r < 16; ++r) o[d_][r] *= al_l[crow(r, hi)]; } } while (0)
#define KBASE(t) ((j_lo + (t)) * KVBLK)
#define ACT(t) (KBASE(t) <= qlo + QBLK - 1 && KBASE(t) + KVBLK - 1 >= qlo - W + 1)
#define MASKT(P0_, P1_, t) do { const int kb_ = KBASE(t); if ((!SK || ACT(t)) && (kb_ + KVBLK - 1 > qlo || kb_ <= qlo + QBLK - 1 - W)) mask_tile(P0_, P1_, qm - kb_, (unsigned)W); } while (0)
    constexpr int NQL = F32 ? 16 : 8;
    constexpr bool SK = WSKIP && !F32;
#define SEAM_K0() do { VMWN(NQL); if constexpr (F32) { SWRITE_KF(0); SBAR(); SLOAD_F((const float*)nxt.V, kbn); } else { SWRITE_HK(0); } SBAR(); } while (0)
    f32x16 pA0, pA1, pB0, pB1; float mnA, mnB, alA, alB; bf16x8 pa0, pa1, pa2, pa3;
    if constexpr (F32) { VMW(); SWRITE_VF(0); SBAR(); } else { SWRITE_HV(0); SBAR(); }
    if (NT > 1) { if constexpr (F32) SLOAD_F((const float*)Kh, KBASE(1)); else SLOAD_H(Kh, Vh, KBASE(1)); }
    SBAR(); qkt<0, SK>(pA0, pA1, K_lds, r32, hi, q_w, ACT(0), fb + KBASE(0));
    if constexpr (F32) { if (NT > 1) { VMW(); SWRITE_KF(1); SBAR(); SLOAD_F((const float*)Vh, KBASE(1)); } }
    MASKT(pA0, pA1, 0); partialSM(pA0, pA1, m_reg, mnA, alA);
    if (NT > 1) { VMW(); if constexpr (F32) { SWRITE_VF(1); SBAR(); if (NT > 2) SLOAD_F((const float*)Kh, KBASE(2)); } else SWRITE_H(1); }
    __syncthreads();
#define HALF_STEP(PX0, PX1, mnX, alX, PY0, PY1, alY, t, KB, VB, SB) do {                                                      \
        SBAR(); qkt<KB, SK>(PX0, PX1, K_lds, r32, hi, q_w, ACT(t), fb + KBASE(t));                                             \
        finishSM(PY0, PY1, alY, l_reg, pa0, pa1, pa2, pa3); SBAR();                                                           \
        if ((t) + 1 < NT) { if constexpr (F32) { VMW(); SWRITE_KF(SB); SBAR(); SLOAD_F((const float*)Vh, KBASE((t) + 1)); }  \
                            else { SLOAD_H(Kh, Vh, KBASE((t) + 1)); } SBAR(); }                                               \
        pv_tile<VB, SK>(o, vb0, pa0, pa1, pa2, pa3, ACT((t) - 1)); MASKT(PX0, PX1, (t)); partialSM(PX0, PX1, m_reg, mnX, alX);                                        \
        __syncthreads();                                                                                                      \
        if ((t) + 1 < NT) { VMW(); if constexpr (F32) { SWRITE_VF(SB); SBAR(); if ((t) + 2 < NT) SLOAD_F((const float*)Kh, KBASE((t) + 2)); } \
                            else { SWRITE_H(SB); } }                                                                          \
        RESC(alX); __syncthreads(); } while (0)
    for (int t = 1; t + 1 < NT; t += 2) {
        HALF_STEP(pB0, pB1, mnB, alB, pA0, pA1, alA, t, 1, 0, 0);
        HALF_STEP(pA0, pA1, mnA, alA, pB0, pB1, alB, t + 1, 0, 1, 1);
    }
    const bool even = (NT & 1) == 0;
    if (even) { SBAR(); qkt<1, SK>(pB0, pB1, K_lds, r32, hi, q_w, ACT(NT - 1), fb + KBASE(NT - 1)); SBAR(); }
#define QROW(e) (nxt.Q + (size_t)(wid * QBLK + r32) * D + ((e) >> 1) * 16 + hi * 8 + ((e) & 1) * 4)
    if constexpr (F32) { SLOAD_F((const float*)nxt.K, kbn); SBAR();
#pragma unroll
        for (int e = 0; e < 8; ++e) S.tq[e] = *(const f32x4*)QROW(e); }
    else { SLOAD_H(nxt.K, nxt.V, kbn); SBAR();
#pragma unroll
        for (int d0 = 0; d0 < 8; ++d0) S.qr[d0] = load8<TIn>(nxt.Q + (size_t)(wid * QBLK + r32) * D + d0 * 16 + hi * 8); }
    SBAR();
    finishSM(pA0, pA1, alA, l_reg, pa0, pa1, pa2, pa3); SBAR();
    if constexpr (F32) {
#pragma unroll
        for (int e = 8; e < 16; ++e) S.tq[e] = *(const f32x4*)QROW(e); SBAR(); }
#undef QROW
    pv_tile<0, SK>(o, vb0, pa0, pa1, pa2, pa3, ACT(even ? NT - 2 : NT - 1));
    if (even) { MASKT(pB0, pB1, NT - 1); partialSM(pB0, pB1, m_reg, mnB, alB); __syncthreads(); RESC(alB);
        finishSM(pB0, pB1, alB, l_reg, pa0, pa1, pa2, pa3); SBAR(); pv_tile<1, SK>(o, vb0, pa0, pa1, pa2, pa3, ACT(NT - 1)); }
    SBAR(); SEAM_K0();
    if (hi == 0) li_l[r32] = l_reg; asm volatile("s_waitcnt lgkmcnt(0)" ::: "memory");
    float rli[16];
#pragma unroll
    for (int r = 0; r < 16; ++r) rli[r] = __builtin_amdgcn_rcpf(li_l[crow(r, hi)]);
    {
        unsigned short* ost = (unsigned short*)q_w;
        {
            const bool odd = (r32 & 1) != 0; unsigned short* ob_ = ost + (odd ? 32 : 0) + (r32 & ~1);
#pragma unroll
            for (int r = 0; r < 16; ++r) { const int orow = crow(r, hi);
#pragma unroll
                for (int dp = 0; dp < 4; dp += 2) { const float e0 = o[dp][r] * rli[r], e1 = o[dp + 1][r] * rli[r];
                    const float snd = odd ? e0 : e1;
                    const float rcv = __int_as_float(__builtin_amdgcn_update_dpp(0, __float_as_int(snd), 0xB1, 0xF, 0xF, true));
                    const float lo = odd ? rcv : e0, hi_ = odd ? e1 : rcv;
                    *(unsigned*)(ob_ + orow * 128 + dp * 32) = cvtpk(lo, hi_); } }
        }
        asm volatile("s_waitcnt lgkmcnt(0)" ::: "memory");
        const unsigned short* Gw = (const unsigned short*)cur.G + (size_t)(wid * QBLK) * LDO; TOut* Ow = cur.O + (size_t)(wid * QBLK) * LDO;
        const int ck = lane & 15, rq = lane >> 4;
        u32x4 gq[8];
#pragma unroll
        for (int i = 0; i < 8; ++i) gq[i] = *(const u32x4*)(Gw + (size_t)(4 * i + rq) * LDO + ck * 8);
#pragma unroll
        for (int i = 0; i < 8; ++i) { const u32x4 ov = *(const u32x4*)(ost + (4 * i + rq) * 128 + ck * 8); const u32x4 g = gq[i]; u32x4 w;
#define GMUL(a_, b_) cvtpk(__uint_as_float((a_) << 16) * __uint_as_float((b_) << 16), __uint_as_float((a_) & 0xffff0000u) * __uint_as_float((b_) & 0xffff0000u))
            w.x = GMUL(ov.x, g.x); w.y = GMUL(ov.y, g.y); w.z = GMUL(ov.z, g.z); w.w = GMUL(ov.w, g.w);
#undef GMUL
            *(u32x4*)(Ow + (size_t)(4 * i + rq) * LDO + ck * 8) = w; }
        asm volatile("s_waitcnt lgkmcnt(0)" ::: "memory");
    }
    if constexpr (F32) {
#pragma unroll
        for (int d0 = 0; d0 < 8; ++d0) S.qr[d0] = pack8(S.tq[2 * d0], S.tq[2 * d0 + 1]); }
#pragma unroll
    for (int d0 = 0; d0 < 8; ++d0) *reinterpret_cast<bf16x8*>(q_w + KSWZ(r32, (d0 * 16 + hi * 8) * 2)) = S.qr[d0];
    __syncthreads();
#undef RESC
#undef KBASE
#undef ACT
#undef MASKT
#undef SEAM_K0
#undef HALF_STEP
}
#undef ROW
#undef VMW
#undef VMWN
#undef SLOAD_H
#undef SWRITE_HK
#undef SWRITE_HV
#undef SWRITE_H
#undef SLOAD_F
#undef SWRITE_KF
#undef SWRITE_VF


#undef KSWZ
#undef SBAR
}
#define LAS __attribute__((address_space(3)))
typedef unsigned short bf16r;
typedef float f32x4 __attribute__((ext_vector_type(4)));
typedef float f32x16 __attribute__((ext_vector_type(16)));
typedef short bf16x8 __attribute__((ext_vector_type(8)));
typedef unsigned u32x4 __attribute__((ext_vector_type(4)));
typedef unsigned u32x2 __attribute__((ext_vector_type(2)));

constexpr int NTOK = 16384, DM = 2048, SEQL = 2048, NBATCH = 8, NMEM = 256, MAINW = 1536, MEMW = 512, NGRP = 96;
constexpr float EPSN = 1e-6f;
constexpr size_t MiB = (size_t)1 << 20;
constexpr size_t SM_RSTD0 = 0, SM_RSTDM = 64 * 1024, SM_ROWSQ0 = 128 * 1024, SM_ROWSQ1 = 192 * 1024, SM_RSTD1 = 256 * 1024,
                 SM_LOGF = 320 * 1024, SM_FCUM = 1152 * 1024, SM_WFT = 1984 * 1024, SM_QNRM = 2560 * 1024, SM_KNRM = 3328 * 1024;
constexpr size_t WS_WINA = 4 * MiB, WS_WKVB = 20 * MiB, WS_WGLU = 48 * MiB, WS_WMKV0 = 53 * MiB, WS_WMKV1 = 57 * MiB, WS_WOUT0 = 61 * MiB, WS_WOUT1 = 69 * MiB,
                 WS_XB = 77 * MiB, WS_MEMB = 141 * MiB, WS_MKV = 149 * MiB, WS_PROJ = 157 * MiB, WS_KVB = 285 * MiB, WS_CAT = 381 * MiB, WS_OB = 445 * MiB, WS_BAR = 509 * MiB, WS_END = 509 * MiB + 65536;
constexpr int LDS_TOTAL = 147456;

struct Params { const float* in[23]; float* out; unsigned char* ws; };
enum { I_X = 0, I_MEM, I_PREG, I_POSTG, I_WINA, I_LRE, I_LIM, I_LSTEP, I_BRE, I_BIM, I_CRE, I_CIM, I_DSKIP, I_WGLU, I_BGLU, I_KVG, I_WKV, I_WFG, I_BFG, I_WINB, I_MEMG, I_WMKV, I_WOUT };

__device__ __forceinline__ float wave_sum(float v) {
#pragma unroll
    for (int o = 1; o < 64; o <<= 1) v += __shfl_xor(v, o);
    return v;
}
__device__ __forceinline__ unsigned pkbf(float lo, float hi) { return pg8::cvt_pk_bf16(lo, hi); }
#define LDS_FENCE() asm volatile("s_waitcnt lgkmcnt(0)" ::: "memory")

__device__ __forceinline__ void transpose_item(const float* W, const float* gs, int K, int N, bf16r* WT, int row_off, LAS float* scr, int item, int lane) {
    const int nblk = N / 32, kb = item / nblk, nb = item % nblk, k0 = 64 * kb, n0 = 32 * nb;
    const float* src = W + (size_t)(k0 + (lane >> 5)) * N + n0 + (lane & 31);
    float v[32];
#pragma unroll
    for (int i = 0; i < 32; ++i) v[i] = src[(size_t)(2 * i) * N];
    const int c = lane & 7;
    f32x4 g0 = {1.f, 1.f, 1.f, 1.f}, g1 = {1.f, 1.f, 1.f, 1.f};
    if (gs) { g0 = *(const f32x4*)(gs + k0 + 8 * c); g1 = *(const f32x4*)(gs + k0 + 8 * c + 4); }
#pragma unroll
    for (int i = 0; i < 32; ++i) scr[(2 * i + (lane >> 5)) * 33 + (lane & 31)] = v[i];
    LDS_FENCE();
#pragma unroll
    for (int j = 0; j < 4; ++j) { const int n = (lane >> 3) + 8 * j; const LAS float* s = scr + (8 * c) * 33 + n;
        u32x4 o; o.x = pkbf(s[0 * 33] * g0[0], s[1 * 33] * g0[1]); o.y = pkbf(s[2 * 33] * g0[2], s[3 * 33] * g0[3]); o.z = pkbf(s[4 * 33] * g1[0], s[5 * 33] * g1[1]); o.w = pkbf(s[6 * 33] * g1[2], s[7 * 33] * g1[3]);
        *(u32x4*)(WT + (size_t)(row_off + n0 + n) * K + k0 + 8 * c) = o; }
    LDS_FENCE();
}
__device__ __forceinline__ void rows_to_bf16(const float* x, bf16r* o, float* rstd_out, int m0, int stride, int nrows, int lane) {
    f32x4 v[8];
    if (m0 < nrows) { const f32x4* xp = (const f32x4*)(x + (size_t)m0 * DM) + lane;
#pragma unroll
        for (int j = 0; j < 8; ++j) v[j] = xp[64 * j]; }
    for (int m = m0; m < nrows; m += stride) {
        f32x4 vn[8]; const int mn = m + stride;
        if (mn < nrows) { const f32x4* xp = (const f32x4*)(x + (size_t)mn * DM) + lane;
#pragma unroll
            for (int j = 0; j < 8; ++j) vn[j] = xp[64 * j]; }
        float s = 0.f;
#pragma unroll
        for (int j = 0; j < 8; ++j) s += (v[j][0] * v[j][0] + v[j][1] * v[j][1]) + (v[j][2] * v[j][2] + v[j][3] * v[j][3]);
        s = wave_sum(s);
        if (lane == 0) rstd_out[m] = 1.0f / sqrtf(s * (1.0f / DM) + EPSN);
        u32x2* op = (u32x2*)(o + (size_t)m * DM) + lane;
#pragma unroll
        for (int j = 0; j < 8; ++j) { u32x2 w; w.x = pkbf(v[j][0], v[j][1]); w.y = pkbf(v[j][2], v[j][3]); op[64 * j] = w; }
        if (mn < nrows) {
#pragma unroll
            for (int j = 0; j < 8; ++j) v[j] = vn[j]; }
    }
}

struct Sel0 { bf16r* proj;
    __device__ __forceinline__ pg8::SecInfo operator()(int cs) const {
        if (cs < 1536) return {proj, 0, 1536, 0, 0, nullptr};
        if (cs < 3072) return {proj + (size_t)NTOK * 1536, 1536, 2048, 0, 1, nullptr};
        if (cs < 3584) return {proj + (size_t)NTOK * 3584, 3072, 0, 4, 0, nullptr};
        return {proj + (size_t)NTOK * 1536 + 1536, 3584, 2048, 0, 1, nullptr}; } };
struct Sel1 { bf16r* kvb; bf16r* proj; float* qnrm; float* knrm;
    __device__ __forceinline__ pg8::SecInfo operator()(int cs) const {
        if (cs < 1536) return {kvb, 0, 0, 12, 0, knrm};
        if (cs < 3072) return {kvb + (size_t)NTOK * 1536, 1536, 0, 12, 0, nullptr};
        if (cs < 4608) return {proj, 3072, 0, 12, 0, qnrm};
        if (cs < 6144) return {proj + (size_t)NTOK * 1536, 4608, 2048, 0, 1, nullptr};
        if (cs < 6656) return {proj + (size_t)NTOK * 3584, 6144, 0, 4, 0, nullptr};
        return {proj + (size_t)NTOK * 1536 + 1536, 6656, 2048, 0, 1, nullptr}; } };
struct SelM { bf16r* mkv;
    __device__ __forceinline__ pg8::SecInfo operator()(int cs) const {
        if (cs < 512) return {mkv, 0, 0, 4, 0, nullptr};
        return {mkv + (size_t)NBATCH * NMEM * 512, 512, 0, 4, 0, nullptr}; } };

constexpr int SSM_XS = 80;
constexpr int SSM_WAVE_LDS = 128 * 36 * 4 + 32 * SSM_XS * 4;
typedef float __attribute__((may_alias)) f32_ma; typedef unsigned __attribute__((may_alias)) u32_ma;
typedef f32x4 __attribute__((may_alias)) f32x4_ma; typedef bf16x8 __attribute__((may_alias)) bf16x8_ma;
__device__ __forceinline__ int crow16(int r, int hi) { return (r & 3) + 8 * (r >> 2) + 4 * hi; }
__device__ __forceinline__ float gelu_tanh(float y) {
    const float z = 0.7978845608028654f * (y + 0.044715f * y * y * y);
    return y * __builtin_amdgcn_rcpf(1.f + __builtin_amdgcn_exp2f(-2.8853900817779268f * z));
}
struct SsmCtx {
    f32_ma* Bu2; u32_ma* Xs; const bf16r* U; bf16r* YG; size_t tokb; int g, lane, c, hi, l16, kq;
    float ar, ai; bf16x8 Bf[4]; bf16x8 Cf[4]; float dsk[4];
};
__device__ __forceinline__ void ssm_s2(const SsmCtx& X, bf16x8 Uc) {
#pragma unroll
    for (int nt = 0; nt < 4; ++nt) {
        f32x16 a = {};
        a = __builtin_amdgcn_mfma_f32_32x32x16_bf16(Uc, X.Bf[nt], a, 0, 0, 0);
#pragma unroll
        for (int r4 = 0; r4 < 4; ++r4) { f32x4 v = {a[4 * r4], a[4 * r4 + 1], a[4 * r4 + 2], a[4 * r4 + 3]}; *(f32x4_ma*)(X.Bu2 + (32 * nt + X.c) * 36 + 8 * r4 + 4 * X.hi) = v; }
    }
}
__device__ __forceinline__ void ssm_s1(const SsmCtx& X, float& xr, float& xi) {
#pragma unroll
    for (int q = 0; q < 8; ++q) {
        const f32x4 re4 = *(const f32x4_ma*)(X.Bu2 + X.lane * 36 + 4 * q), im4 = *(const f32x4_ma*)(X.Bu2 + (64 + X.lane) * 36 + 4 * q);
#pragma unroll
        for (int e = 0; e < 4; ++e) {
            const float nr = X.ar * xr - X.ai * xi + re4[e], ni = X.ar * xi + X.ai * xr + im4[e];
            xr = nr; xi = ni; X.Xs[(4 * q + e) * SSM_XS + X.lane] = pkbf(xr, xi);
        }
    }
}
__device__ __forceinline__ void ssm_s3(const SsmCtx& X, bf16r* py, u32x2 us0, u32x2 us1) {
    f32x4 y0 = {0.f, 0.f, 0.f, 0.f}, y1 = {0.f, 0.f, 0.f, 0.f};
#pragma unroll
    for (int s = 0; s < 4; ++s) {
        const bf16x8 b0 = *(const bf16x8_ma*)(X.Xs + X.l16 * SSM_XS + 16 * s + 4 * X.kq), b1 = *(const bf16x8_ma*)(X.Xs + (16 + X.l16) * SSM_XS + 16 * s + 4 * X.kq);
        y0 = __builtin_amdgcn_mfma_f32_16x16x32_bf16(X.Cf[s], b0, y0, 0, 0, 0);
        y1 = __builtin_amdgcn_mfma_f32_16x16x32_bf16(X.Cf[s], b1, y1, 0, 0, 0);
    }
    y0[0] += X.dsk[0] * pg8::bf_lo(us0.x); y0[1] += X.dsk[1] * pg8::bf_hi(us0.x); y0[2] += X.dsk[2] * pg8::bf_lo(us0.y); y0[3] += X.dsk[3] * pg8::bf_hi(us0.y);
    y1[0] += X.dsk[0] * pg8::bf_lo(us1.x); y1[1] += X.dsk[1] * pg8::bf_hi(us1.x); y1[2] += X.dsk[2] * pg8::bf_lo(us1.y); y1[3] += X.dsk[3] * pg8::bf_hi(us1.y);
    u32x2 w0, w1;
    w0.x = pkbf(gelu_tanh(y0[0]), gelu_tanh(y0[1])); w0.y = pkbf(gelu_tanh(y0[2]), gelu_tanh(y0[3]));
    w1.x = pkbf(gelu_tanh(y1[0]), gelu_tanh(y1[1])); w1.y = pkbf(gelu_tanh(y1[2]), gelu_tanh(y1[3]));
    *(u32x2*)py = w0;
    *(u32x2*)(py + 16 * 1536) = w1;
}
#define SSM_BAR() asm volatile("s_waitcnt lgkmcnt(0)\n\ts_barrier" ::: "memory")
constexpr int SSM_TASK_LDS = 128 * 36 * 4 + 2 * 32 * SSM_XS * 4;
__device__ __forceinline__ void ssm_round(const Params& P, bool active, int role, int b, int g, unsigned char* wl, int lane) {
    SsmCtx X; X.g = g; X.lane = lane; X.c = lane & 31; X.hi = lane >> 5; X.l16 = lane & 15; X.kq = lane >> 4;
    const int c = X.c, hi = X.hi, l16 = X.l16, kq = X.kq;
    X.Bu2 = (f32_ma*)wl; u32_ma* Xs0 = (u32_ma*)(wl + 128 * 36 * 4); X.Xs = Xs0;
    X.U = (const bf16r*)(P.ws + WS_PROJ); X.YG = (bf16r*)(P.ws + WS_KVB); X.tokb = (size_t)b * SEQL;
    X.ar = 0.f; X.ai = 0.f;
    const bf16r* Ua = X.U + (X.tokb + c) * 1536 + g * 16 + 8 * hi;
    const bf16r* Us = X.U + (X.tokb + l16) * 1536 + g * 16 + 4 * kq;
    constexpr int NCH = SEQL / 32; constexpr size_t CHS = (size_t)32 * 1536;
    bf16x8 U0 = {}, U1 = {}, U2 = {}; u32x2 a0 = {0u, 0u}, a1 = {0u, 0u}, b0 = {0u, 0u}, b1 = {0u, 0u}, c0 = {0u, 0u}, c1 = {0u, 0u};
    if (active) {
        const float dt = __expf(P.in[I_LSTEP][g]), lr = P.in[I_LRE][g * 64 + lane], li = P.in[I_LIM][g * 64 + lane];
        const float mag = __expf(lr * dt); float rev = li * dt * 0.15915494309189535f; rev -= floorf(rev);
        const float ar = mag * __builtin_amdgcn_cosf(rev), ai = mag * __builtin_amdgcn_sinf(rev);
        const float den = lr * lr + li * li, cr = ((ar - 1.0f) * lr + ai * li) / den, ci = (ai * lr - (ar - 1.0f) * li) / den;
        X.ar = ar; X.ai = ai;
        if (role == 1) {
#pragma unroll
            for (int nt = 0; nt < 4; ++nt) {
                const int pp = 32 * nt + c, p = pp & 63; const float crp = __shfl(cr, p), cip = __shfl(ci, p);
                const f32x4 r0 = *(const f32x4*)(P.in[I_BRE] + ((size_t)(g * 64 + p)) * 16 + 8 * hi), r1 = *(const f32x4*)(P.in[I_BRE] + ((size_t)(g * 64 + p)) * 16 + 8 * hi + 4);
                const f32x4 i0 = *(const f32x4*)(P.in[I_BIM] + ((size_t)(g * 64 + p)) * 16 + 8 * hi), i1 = *(const f32x4*)(P.in[I_BIM] + ((size_t)(g * 64 + p)) * 16 + 8 * hi + 4);
                f32x4 v0, v1;
                if (nt < 2) { v0 = crp * r0 - cip * i0; v1 = crp * r1 - cip * i1; } else { v0 = crp * i0 + cip * r0; v1 = crp * i1 + cip * r1; }
                u32x4 w; w.x = pkbf(v0[0], v0[1]); w.y = pkbf(v0[2], v0[3]); w.z = pkbf(v1[0], v1[1]); w.w = pkbf(v1[2], v1[3]);
                X.Bf[nt] = __builtin_bit_cast(bf16x8, w);
            }
#pragma unroll
            for (int s = 0; s < 4; ++s) {
                const f32x4 re = *(const f32x4*)(P.in[I_CRE] + ((size_t)(g * 16 + l16)) * 64 + 16 * s + 4 * kq), im = *(const f32x4*)(P.in[I_CIM] + ((size_t)(g * 16 + l16)) * 64 + 16 * s + 4 * kq);
                u32x4 w; w.x = pkbf(re[0], -im[0]); w.y = pkbf(re[1], -im[1]); w.z = pkbf(re[2], -im[2]); w.w = pkbf(re[3], -im[3]);
                X.Cf[s] = __builtin_bit_cast(bf16x8, w);
            }
#pragma unroll
            for (int r = 0; r < 4; ++r) X.dsk[r] = P.in[I_DSKIP][g * 16 + 4 * kq + r];
            ssm_s2(X, *(const bf16x8*)Ua);
            U1 = *(const bf16x8*)(Ua + CHS); U2 = *(const bf16x8*)(Ua + 2 * CHS);
            a0 = *(const u32x2*)Us; a1 = *(const u32x2*)(Us + 16 * 1536);
        }
    }
    if (!active) {
        for (int i = 0; i < 2 * (NCH + 1) + 1; ++i) SSM_BAR();
    } else if (role == 0) {
        float xr = 0.f, xi = 0.f; const float nai_ = -X.ai; int wsel = 0;
        for (int ch = 0; ch <= NCH; ++ch) {
            SSM_BAR();
            f32x4 re4[8], im4[8];
            if (ch < NCH) {
#pragma unroll
                for (int q = 0; q < 8; ++q) { re4[q] = *(const f32x4_ma*)(X.Bu2 + lane * 36 + 4 * q); im4[q] = *(const f32x4_ma*)(X.Bu2 + (64 + lane) * 36 + 4 * q); }
            }
            SSM_BAR();
            if (ch < NCH) {
                u32_ma* Xw = Xs0 + wsel * (32 * SSM_XS); wsel ^= 1;
#pragma unroll
                for (int q = 0; q < 8; ++q) {
#pragma unroll
                    for (int e = 0; e < 4; ++e) {
                        float t1, t2, nr, ni;
                        asm("v_fma_f32 %0, %1, %2, %3" : "=v"(t1) : "v"(nai_), "v"(xi), "v"(re4[q][e]));
                        asm("v_fma_f32 %0, %1, %2, %3" : "=v"(t2) : "v"(X.ai), "v"(xr), "v"(im4[q][e]));
                        asm("v_fma_f32 %0, %1, %2, %3" : "=v"(nr) : "v"(X.ar), "v"(xr), "v"(t1));
                        asm("v_fma_f32 %0, %1, %2, %3" : "=v"(ni) : "v"(X.ar), "v"(xi), "v"(t2));
                        xr = nr; xi = ni; Xw[(4 * q + e) * SSM_XS + lane] = pkbf(xr, xi); } }
            }
        }
        SSM_BAR();
    } else {
        const bf16r* pU = Ua + 3 * CHS; const bf16r* pS = Us + CHS; bf16r* pY = X.YG + (X.tokb + l16) * 1536 + g * 16 + 4 * kq; int rsel = 0;
#define SSM_MM(DO_S2, DO_S3, DO_LD, U_USE, U_LD, S0_USE, S1_USE, S0_LD, S1_LD) do {                                               \
            SSM_BAR(); SSM_BAR();                                                                                      \
            if (DO_LD) { U_LD = *(const bf16x8*)pU; S0_LD = *(const u32x2*)pS; S1_LD = *(const u32x2*)(pS + 16 * 1536); pU += CHS; pS += CHS; } \
            __builtin_amdgcn_sched_barrier(0);                                                                                    \
            if (DO_S2) ssm_s2(X, U_USE);                                                                                          \
            if (DO_S3) { X.Xs = Xs0 + rsel * (32 * SSM_XS); rsel ^= 1; ssm_s3(X, pY, S0_USE, S1_USE); pY += CHS; }                \
            __builtin_amdgcn_sched_barrier(0);                                                                                    \
        } while (0)
#define MM_R0(S2_, S3_, LD) SSM_MM(S2_, S3_, LD, U1, U0, c0, c1, b0, b1)
#define MM_R1(S2_, S3_, LD) SSM_MM(S2_, S3_, LD, U2, U1, a0, a1, c0, c1)
#define MM_R2(S2_, S3_, LD) SSM_MM(S2_, S3_, LD, U0, U2, b0, b1, a0, a1)
        MM_R0(true, false, true);
        _Pragma("clang loop unroll(disable)") for (int ch = 1; ch + 2 < NCH - 1; ch += 3) { MM_R1(true, true, true); MM_R2(true, true, true); MM_R0(true, true, true); }
        static_assert((NCH - 2) % 3 == 2, "steady range 1..NCH-2 = 20 triples + 2");
        MM_R1(true, true, true);
        MM_R2(true, true, true);
        MM_R0(false, true, false);
        MM_R1(false, true, false);
#undef MM_R0
#undef MM_R1
#undef MM_R2
#undef SSM_MM
        SSM_BAR();
    }
}
__device__ __forceinline__ void ssm_phase(const Params& P, unsigned char* lds, int wave, int lane) {
    const int role = (wave == 0 || wave == 2 || wave == 6) ? 0 : 1;
    const int ts = (wave == 0 || wave == 4) ? 0 : (wave == 1 || wave == 2) ? 1 : (wave == 3 || wave == 6) ? 2 : 3;
    const int G = gridDim.x, rounds = (NBATCH * NGRP + 3 * G - 1) / (3 * G);
    for (int rd = 0; rd < rounds; ++rd) {
        const int tk = (rd * G + (int)blockIdx.x) * 3 + ts; const bool active = (ts < 3) && (tk < NBATCH * NGRP);
        const int tkc = active ? tk : 0;
        ssm_round(P, active, role, tkc / NGRP, tkc % NGRP, lds + (ts < 3 ? ts : 0) * SSM_TASK_LDS, lane);
    }
}

typedef att::BlockRef<att::bf16, att::bf16> ABlk;
__device__ __forceinline__ int fox_jlo(const Params& P, int bh, int qb, char* lds) {
    const int tid = opaque_tid(), lane = tid & 63, wave = tid >> 6;
    float* red = (float*)(lds + att::LDS_BYTES);
    const float* qn = (const float*)(P.ws + SM_QNRM) + (size_t)bh * SEQL + qb * 256; const float* kn = (const float*)(P.ws + SM_KNRM) + (size_t)bh * SEQL;
    float mq = (tid < 256) ? qn[tid] : 0.f, mk = 0.f;
    for (int i = tid; i < qb * 256; i += 512) mk = fmaxf(mk, kn[i]);
#pragma unroll
    for (int o = 1; o < 64; o <<= 1) { mq = fmaxf(mq, __shfl_xor(mq, o)); mk = fmaxf(mk, __shfl_xor(mk, o)); }
    if (lane == 0) { red[wave] = mq; red[8 + wave] = mk; }
    __syncthreads();
    float Q2 = 0.f, K2 = 0.f;
#pragma unroll
    for (int w = 0; w < 8; ++w) { Q2 = fmaxf(Q2, red[w]); K2 = fmaxf(K2, red[8 + w]); }
    const float bound = 2.04f * sqrtf(Q2 * K2) * att::SCALE + 30.f;
    const float* FC = (const float*)(P.ws + SM_FCUM) + (size_t)bh * SEQL; const float c0 = FC[qb * 256];
    const bool keep = (lane >= qb * 4) || (c0 - FC[lane < 32 ? 64 * lane + 63 : 2047] >= -bound);
    const unsigned long long m = __ballot(keep);
    const int jlo = __builtin_amdgcn_readfirstlane((int)__builtin_ctzll(m));
    __syncthreads();
    return jlo;
}
__device__ __forceinline__ void fox_item(int vc, int i, int& bh, int& qb) {
    const int gq = vc >> 3, j = vc & 7, e = j * 3 + i;
    const unsigned long long T0 = 7ull | (3ull << 5) | (0ull << 10) | ((7ull | 8ull) << 15) | (4ull << 20) | ((0ull | 8ull) << 25) | ((7ull | 16ull) << 30) | (2ull << 35) | (1ull << 40) | (6ull << 45) | (5ull << 50) | ((0ull | 16ull) << 55);
    const unsigned long long T1 = (6ull | 8ull) | ((4ull | 8ull) << 5) | ((1ull | 8ull) << 10) | ((6ull | 16ull) << 15) | ((3ull | 8ull) << 20) | ((1ull | 16ull) << 25) | ((5ull | 8ull) << 30) | ((4ull | 16ull) << 35) | ((2ull | 8ull) << 40) | ((5ull | 16ull) << 45) | ((3ull | 16ull) << 50) | ((2ull | 16ull) << 55);
    const unsigned code = (unsigned)(((e < 12) ? (T0 >> (5 * e)) : (T1 >> (5 * (e - 12)))) & 31ull);
    qb = code & 7; bh = gq * 3 + (code >> 3);
}
__device__ __forceinline__ void fox_jlo3(const Params& P, int vc, char* lds) {
    const int tid = opaque_tid(), lane = tid & 63, wave = tid >> 6;
    float* red = (float*)(lds + att::LDS_BYTES);
    int bh[3], qb[3]; float mq[3], mk[3];
#pragma unroll
    for (int i = 0; i < 3; ++i) { fox_item(vc, i, bh[i], qb[i]);
        const float* qn = (const float*)(P.ws + SM_QNRM) + (size_t)bh[i] * SEQL + qb[i] * 256; const float* kn = (const float*)(P.ws + SM_KNRM) + (size_t)bh[i] * SEQL;
        mq[i] = (tid < 256) ? qn[tid] : 0.f; mk[i] = 0.f;
#pragma unroll
        for (int k = 0; k < 4; ++k) { const int idx = tid + 512 * k; if (idx < qb[i] * 256) mk[i] = fmaxf(mk[i], kn[idx]); } }
#pragma unroll
    for (int o = 1; o < 64; o <<= 1) {
#pragma unroll
        for (int i = 0; i < 3; ++i) { mq[i] = fmaxf(mq[i], __shfl_xor(mq[i], o)); mk[i] = fmaxf(mk[i], __shfl_xor(mk[i], o)); } }
    if (lane == 0) {
#pragma unroll
        for (int i = 0; i < 3; ++i) { red[32 + 16 * i + wave] = mq[i]; red[32 + 16 * i + 8 + wave] = mk[i]; } }
    __syncthreads();
#pragma unroll
    for (int i = 0; i < 3; ++i) {
        float Q2 = 0.f, K2 = 0.f;
#pragma unroll
        for (int w = 0; w < 8; ++w) { Q2 = fmaxf(Q2, red[32 + 16 * i + w]); K2 = fmaxf(K2, red[32 + 16 * i + 8 + w]); }
        const float bound = 2.04f * sqrtf(Q2 * K2) * att::SCALE + 30.f;
        const float* FC = (const float*)(P.ws + SM_FCUM) + (size_t)bh[i] * SEQL; const float c0 = FC[qb[i] * 256];
        const bool keep = (lane >= qb[i] * 4) || (c0 - FC[lane < 32 ? 64 * lane + 63 : 2047] >= -bound);
        const unsigned long long m = __ballot(keep);
        if (tid == 0) ((int*)red)[16 + i] = (int)__builtin_ctzll(m);
    }
    __syncthreads();
}
template <bool FOX, int LYR> __device__ __forceinline__ bool att_get(const Params& P, int n, ABlk& r, int& skv, char* lds) {
    constexpr int PER = FOX ? 4 : 1;
    const int G = gridDim.x, bx = blockIdx.x;
    const int slot = n / PER, i = n % PER;
    const int vb = bx + slot * G; if (vb >= 256) return false;
    const int vc = (vb & 7) * 32 + (vb >> 3);
    const att::bf16* proj = (const att::bf16*)(P.ws + WS_PROJ); att::bf16* cat = (att::bf16*)(P.ws + WS_CAT);
    if (FOX && i < 3) {
        int bh, qb; fox_item(vc, i, bh, qb); const int b = bh / 12, h = bh % 12;
        const att::bf16* kvb = (const att::bf16*)(P.ws + WS_KVB);
        r.Q = proj + ((size_t)bh * SEQL + qb * 256) * 128; r.K = kvb + (size_t)bh * SEQL * 128; r.V = kvb + (size_t)NTOK * 1536 + (size_t)bh * SEQL * 128;
        r.O = cat + ((size_t)b * SEQL + qb * 256) * 2048 + h * 128; r.G = proj + (size_t)NTOK * 1536 + ((size_t)b * SEQL + qb * 256) * 2048 + h * 128;
        r.FC = (const float*)(P.ws + SM_FCUM) + (size_t)bh * SEQL; r.P0 = qb * 256; skv = SEQL;
        r.JLO = (slot == 0) ? __builtin_amdgcn_readfirstlane(((const int*)(lds + att::LDS_BYTES))[16 + i]) : fox_jlo(P, bh, qb, lds);
    } else {
        const int b = vc >> 5, hm = (vc >> 3) & 3, qb = vc & 7;
        const att::bf16* mkv = (const att::bf16*)(P.ws + WS_MKV) + (size_t)LYR * (2 * NBATCH * NMEM * 512);
        r.Q = proj + (size_t)NTOK * 3584 + ((size_t)(b * 4 + hm) * SEQL + qb * 256) * 128;
        r.K = mkv + (size_t)(b * 4 + hm) * NMEM * 128; r.V = mkv + (size_t)NBATCH * NMEM * 512 + (size_t)(b * 4 + hm) * NMEM * 128;
        r.O = cat + ((size_t)b * SEQL + qb * 256) * 2048 + 1536 + hm * 128; r.G = proj + (size_t)NTOK * 1536 + ((size_t)b * SEQL + qb * 256) * 2048 + 1536 + hm * 128;
        r.FC = nullptr; r.P0 = 256; skv = NMEM; r.JLO = 0;
    }
    return true;
}
template <bool FOX, int LYR> __device__ __forceinline__ void att_phase(const Params& P, char* lds) {
    ABlk cur, nxt; int skv = 0, skvn = 0;
    if (FOX && (int)blockIdx.x < 256) { const int vb = blockIdx.x; fox_jlo3(P, (vb & 7) * 32 + (vb >> 3), lds); }
    if (!att_get<FOX, LYR>(P, 0, cur, skv, lds)) return;
    att::Seam<att::bf16> S;
    att::causal_swa_prime<att::bf16, att::bf16>(cur, 1 << 20, lds, S);
    for (int n = 0;; ++n) {
        const bool more = att_get<FOX, LYR>(P, n + 1, nxt, skvn, lds);
        if (!more) { nxt = cur; skvn = skv; }
        att::causal_swa_block<att::bf16, att::bf16>(cur, nxt, skv, 1 << 20, lds, S);
        if (!more) break;
        cur = nxt; skv = skvn;
    }
}

#define XB_TMO      128
#define XB_XCNT(j)  (256  + 64 * (j))
#define XB_XSUB(j)  (1280 + 64 * (j))
#define XB_XGEN(j)  (2304 + 64 * (j))
#define XB_TOP      3328
#define XB_TOPGEN   3392
#define XCD_BAR_WORDS 3456
#define XB_SPIN_CAP (1u << 18)

__device__ __forceinline__ unsigned xb_ld(unsigned* p)              { return __hip_atomic_load(p, __ATOMIC_RELAXED, __HIP_MEMORY_SCOPE_AGENT); }
__device__ __forceinline__ unsigned xb_add(unsigned* p, unsigned v) { return __hip_atomic_fetch_add(p, v, __ATOMIC_RELAXED, __HIP_MEMORY_SCOPE_AGENT); }
__device__ __forceinline__ unsigned xb_xcc_id() { return (unsigned)__builtin_amdgcn_s_getreg((3 << 11) | 20) & 0xFu; }
#define XB_SPIN(cond, bar) do { unsigned _sp = 0; while (cond) { __builtin_amdgcn_s_sleep(1); \
    if ((++_sp & 255u) == 0u) { if (xb_ld(&(bar)[XB_TMO])) break; if (_sp > XB_SPIN_CAP) { atomicAdd(&(bar)[XB_TMO], 1u); break; } } } } while (0)

struct XcdBarrier {
    unsigned* bar; unsigned x;
    volatile LAS unsigned* st;
};

__device__ __forceinline__ XcdBarrier xcd_barrier_post(unsigned* bar, volatile LAS unsigned* st) {
    XcdBarrier b; b.bar = bar; b.x = xb_xcc_id(); b.st = st;
    if (threadIdx.x == 0) (void)xb_add(&bar[XB_XCNT(b.x)], 1u);
    return b;
}
__device__ __forceinline__ void xcd_barrier_complete(unsigned* bar, unsigned x, unsigned& nloc, unsigned& nx) {
    const unsigned G = gridDim.x * gridDim.y * gridDim.z;
    unsigned sum, cnt, mine, sp = 0u;
    for (;;) {
        sum = 0u; cnt = 0u; mine = 0u;
#pragma unroll
        for (unsigned j = 0; j < 16; ++j) { const unsigned c = xb_ld(&bar[XB_XCNT(j)]); sum += c; cnt += (c > 0u) ? 1u : 0u; mine = (j == x) ? c : mine; }
        if (sum == G) break;
        __builtin_amdgcn_s_sleep(1);
        if ((++sp & 255u) == 0u) { if (xb_ld(&bar[XB_TMO])) break; if (sp > XB_SPIN_CAP) { atomicAdd(&bar[XB_TMO], 1u); break; } }
    }
    nloc = mine > 0u ? mine : 1u; nx = cnt > 0u ? cnt : 1u;
}

__device__ __forceinline__ void xcd_barrier(const XcdBarrier& b) {
    asm volatile("s_waitcnt vmcnt(0)" ::: "memory");
    __syncthreads();
    if (threadIdx.x == 0) {
        unsigned* bar = b.bar;
        __builtin_amdgcn_s_waitcnt(0);
        unsigned nloc = b.st[0], nx = b.st[1];
        if (nloc == 0u) { xcd_barrier_complete(bar, b.x, nloc, nx); b.st[0] = nloc; b.st[1] = nx; }
        const unsigned old = xb_add(&bar[XB_XSUB(b.x)], 1u);
        const unsigned gen = old / nloc;
        if (old + 1u == (gen + 1u) * nloc) {
            __builtin_amdgcn_fence(__ATOMIC_RELEASE, "agent");
            asm volatile("s_waitcnt vmcnt(0)" ::: "memory");
            const unsigned og = xb_add(&bar[XB_TOP], 1u);
            const unsigned tg = og / nx;
            if (og + 1u == (tg + 1u) * nx) xb_add(&bar[XB_TOPGEN], 1u);
            else XB_SPIN(xb_ld(&bar[XB_TOPGEN]) == tg, bar);
            __builtin_amdgcn_fence(__ATOMIC_ACQUIRE, "agent");
            xb_add(&bar[XB_XGEN(b.x)], 1u);
            asm volatile("s_waitcnt vmcnt(0)" ::: "memory");
        } else {
            XB_SPIN(xb_ld(&bar[XB_XGEN(b.x)]) == gen, bar);
            __builtin_amdgcn_fence(__ATOMIC_ACQUIRE, "agent");
            asm volatile("s_waitcnt vmcnt(0)" ::: "memory");
        }
    }
    __syncthreads();
}

#ifndef PH_MASK
#define PH_MASK 0x7ff
#endif
#define PH(k) if constexpr ((PH_MASK >> (k)) & 1)
#ifndef REP_MASK
#define REP_MASK 0
#endif
#define REP(k) for (int rep_ = 0; rep_ <= ((REP_MASK >> (k)) & 1); ++rep_)
__global__ void __launch_bounds__(512, 2) yoco_fwd(Params P) {
    extern __shared__ __attribute__((aligned(16))) unsigned char lds[];
    cg::grid_group grid = cg::this_grid();
    volatile LAS unsigned* bst = (volatile LAS unsigned*)((LAS unsigned char*)lds + (LDS_TOTAL - 64));
    if (threadIdx.x == 0) { bst[0] = 0u; bst[1] = 0u; }
    __syncthreads();
    const XcdBarrier xbar = xcd_barrier_post((unsigned*)(P.ws + WS_BAR), bst);
#define GRID_SYNC() xcd_barrier(xbar)
    const int G = gridDim.x, NGW = G * 8;
#define PHASE_IDS() const int tid = opaque_tid(), lane = tid & 63, wave = __builtin_amdgcn_readfirstlane(tid >> 6), gw = blockIdx.x * 8 + wave; (void)lane; (void)gw
    unsigned char* ws = P.ws;
    float* rstd0 = (float*)(ws + SM_RSTD0); float* rstdm = (float*)(ws + SM_RSTDM); float* rowsq0 = (float*)(ws + SM_ROWSQ0); float* rowsq1 = (float*)(ws + SM_ROWSQ1);
    float* rstd1 = (float*)(ws + SM_RSTD1); float* logf_ = (float*)(ws + SM_LOGF); float* fcum = (float*)(ws + SM_FCUM); float* wft = (float*)(ws + SM_WFT);
    bf16r* xb = (bf16r*)(ws + WS_XB); bf16r* memb = (bf16r*)(ws + WS_MEMB); bf16r* proj = (bf16r*)(ws + WS_PROJ); bf16r* kvb = (bf16r*)(ws + WS_KVB);
    bf16r* cat = (bf16r*)(ws + WS_CAT); bf16r* ob = (bf16r*)(ws + WS_OB); bf16r* mkv = (bf16r*)(ws + WS_MKV);
    LAS unsigned char* glds = (LAS unsigned char*)lds;

    REP(0) {
    PH(0) { PHASE_IDS();
        LAS float* scr = (LAS float*)((LAS unsigned char*)lds + wave * 16384);
        constexpr int I_A = 32 * 128, I_GLU = 24 * 48, I_MK = 32 * 32, I_O = 32 * 64;
        constexpr int NIT = I_A + I_GLU + 2 * I_MK + I_O;
        for (int it = gw; it < NIT; it += NGW) {
            int r = it;
            if (r < I_A) { transpose_item(P.in[I_WINA], P.in[I_PREG], 2048, 4096, (bf16r*)(ws + WS_WINA), 0, scr, r, lane); continue; } r -= I_A;
            if (r < I_GLU) { transpose_item(P.in[I_WGLU], nullptr, 1536, 1536, (bf16r*)(ws + WS_WGLU), 0, scr, r, lane); continue; } r -= I_GLU;
            if (r < I_MK) { transpose_item(P.in[I_WMKV], P.in[I_MEMG], 2048, 1024, (bf16r*)(ws + WS_WMKV0), 0, scr, r, lane); continue; } r -= I_MK;
            if (r < I_MK) { transpose_item(P.in[I_WMKV] + (size_t)2048 * 1024, P.in[I_MEMG] + 2048, 2048, 1024, (bf16r*)(ws + WS_WMKV1), 0, scr, r, lane); continue; } r -= I_MK;
            transpose_item(P.in[I_WOUT], nullptr, 2048, 2048, (bf16r*)(ws + WS_WOUT0), 0, scr, r, lane);
        }
        rows_to_bf16(P.in[I_X], xb, rstd0, gw, NGW, NTOK, lane);
        rows_to_bf16(P.in[I_MEM], memb, rstdm, gw, NGW, NBATCH * NMEM, lane);
        for (int i = blockIdx.x * 512 + tid; i < NTOK; i += G * 512) { rowsq0[i] = 0.f; rowsq1[i] = 0.f; }
        for (int i = blockIdx.x * 512 + tid; i < 2 * 96 * SEQL; i += G * 512) ((float*)(ws + SM_QNRM))[i] = 0.f;
        for (int i = blockIdx.x * 512 + tid; i < 12 * DM; i += G * 512) { const int h = i / DM, k = i % DM; wft[i] = P.in[I_KVG][k] * P.in[I_WFG][k * 12 + h]; }
    }
    if (P.ws == nullptr) grid.sync();
    GRID_SYNC();
    }
    REP(1) {
    PH(1) {
        { pg8::Gemm g{xb, (const bf16r*)(ws + WS_WINA), NTOK, 4096, DM}; pg8::StaticOrder S; S.init(NTOK, 4096, G, (int)blockIdx.x);
          pg8::EpiProj<Sel0> E{rstd0, Sel0{proj}, 11};
          pg8::gemm_phase<pg8::EpiProj<Sel0>, pg8::StaticOrder, true, true>(glds, g, S, E); }
    }
    GRID_SYNC();
    }
    REP(2) {
    PH(2) { PHASE_IDS(); ssm_phase(P, lds, wave, lane);
    __syncthreads(); }
    GRID_SYNC();
    }
    REP(3) {
    PH(3) {
        { pg8::Gemm g{kvb  , (const bf16r*)(ws + WS_WGLU), NTOK, 1536, 1536}; pg8::StaticOrder S; S.init(NTOK, 1536, G, (int)blockIdx.x);
          pg8::EpiGlu E{kvb, proj + (size_t)NTOK * 1536, P.in[I_BGLU], cat};
          pg8::gemm_phase<pg8::EpiGlu, pg8::StaticOrder, true, true>(glds, g, S, E); }
        { pg8::Gemm g{memb, (const bf16r*)(ws + WS_WMKV0), NBATCH * NMEM, 1024, DM}; pg8::StaticOrder S; S.init(NBATCH * NMEM, 1024, G, (int)((blockIdx.x + G - G / 2) % G));
          pg8::EpiProj<SelM> E{rstdm, SelM{mkv}, 8};
          pg8::gemm_phase<pg8::EpiProj<SelM>, pg8::StaticOrder, true, true>(glds, g, S, E); }
        { pg8::Gemm g{memb, (const bf16r*)(ws + WS_WMKV1), NBATCH * NMEM, 1024, DM}; pg8::StaticOrder S; S.init(NBATCH * NMEM, 1024, G, (int)((blockIdx.x + G - G / 2 - 32) % G));
          pg8::EpiProj<SelM> E{rstdm, SelM{mkv + (size_t)2 * NBATCH * NMEM * 512}, 8};
          pg8::gemm_phase<pg8::EpiProj<SelM>, pg8::StaticOrder, true, true>(glds, g, S, E); }
        if ((int)blockIdx.x >= G - G / 4) {
            PHASE_IDS();
            LAS float* scr = (LAS float*)((LAS unsigned char*)lds + wave * 16384);
            constexpr int I_B = 32 * 128, I_KV = 32 * 96, I_O = 32 * 64, NIT2 = I_B + I_KV + I_O;
            const int gw2 = ((int)blockIdx.x - (G - G / 4)) * 8 + wave, NGW2 = (G / 4) * 8;
            for (int it = gw2; it < NIT2; it += NGW2) {
                int r = it;
                if (r < I_B) { transpose_item(P.in[I_WINB], P.in[I_PREG] + 2048, 2048, 4096, (bf16r*)(ws + WS_WKVB), 3072, scr, r, lane); continue; } r -= I_B;
                if (r < I_KV) { transpose_item(P.in[I_WKV], P.in[I_KVG], 2048, 3072, (bf16r*)(ws + WS_WKVB), 0, scr, r, lane); continue; } r -= I_KV;
                transpose_item(P.in[I_WOUT] + (size_t)2048 * 2048, nullptr, 2048, 2048, (bf16r*)(ws + WS_WOUT1), 0, scr, r, lane);
            }
        }
    }
    GRID_SYNC();
    }
    REP(10) {
    PH(10) att_phase<false, 0>(P, (char*)lds);
    GRID_SYNC();
    }
    REP(4) {
    PH(4) { pg8::Gemm g{cat, (const bf16r*)(ws + WS_WOUT0), NTOK, DM, DM}; pg8::StaticOrder S; S.init(NTOK, DM, G, (int)blockIdx.x);
      pg8::EpiOut E{ob, rep_ ? rowsq0 + 65536 * 9 : rowsq0};
      pg8::gemm_phase<pg8::EpiOut, pg8::StaticOrder, true, true>(glds, g, S, E); }
    GRID_SYNC();
    }
    REP(5) {
    PH(5) { PHASE_IDS();
        float* wl = (float*)lds;
        for (int i = tid; i < 12 * DM / 4; i += 512) ((f32x4*)wl)[i] = ((const f32x4*)wft)[i];
        __syncthreads();
        const float* gp = P.in[I_POSTG];
        f32x4 gv[8];
#pragma unroll
        for (int j = 0; j < 8; ++j) gv[j] = ((const f32x4*)gp)[lane + 64 * j];
        const float bfg = (lane < 12) ? P.in[I_BFG][lane] : 0.f;
        u32x2 xv[8]; u32x2 ov[8]; float rq = 0.f;
        if (gw < NTOK) { const u32x2* xp = (const u32x2*)(xb + (size_t)gw * DM) + lane; const u32x2* op = (const u32x2*)(ob + (size_t)gw * DM) + lane; rq = rowsq0[gw];
#pragma unroll
            for (int j = 0; j < 8; ++j) { xv[j] = xp[64 * j]; ov[j] = op[64 * j]; } }
        for (int m = gw; m < NTOK; m += NGW) {
            const float rso = 1.0f / sqrtf(rq * (1.0f / DM) + EPSN);
            u32x2 xn[8]; u32x2 on[8]; float rqn = 0.f; const int mn = m + NGW;
            if (mn < NTOK) { const u32x2* xp = (const u32x2*)(xb + (size_t)mn * DM) + lane; const u32x2* op = (const u32x2*)(ob + (size_t)mn * DM) + lane; rqn = rowsq0[mn];
#pragma unroll
                for (int j = 0; j < 8; ++j) { xn[j] = xp[64 * j]; on[j] = op[64 * j]; } }
            u32x2* hb = (u32x2*)(xb + (size_t)m * DM) + lane;
            f32x4 hv[8]; float s = 0.f;
#pragma unroll
            for (int j = 0; j < 8; ++j) {
                f32x4 h; h[0] = pg8::bf_lo(xv[j].x) + pg8::bf_lo(ov[j].x) * rso * gv[j][0]; h[1] = pg8::bf_hi(xv[j].x) + pg8::bf_hi(ov[j].x) * rso * gv[j][1];
                h[2] = pg8::bf_lo(xv[j].y) + pg8::bf_lo(ov[j].y) * rso * gv[j][2]; h[3] = pg8::bf_hi(xv[j].y) + pg8::bf_hi(ov[j].y) * rso * gv[j][3];
                hv[j] = h; s += (h[0] * h[0] + h[1] * h[1]) + (h[2] * h[2] + h[3] * h[3]);
                u32x2 w; w.x = pkbf(h[0], h[1]); w.y = pkbf(h[2], h[3]); hb[64 * j] = w; }
            if (mn < NTOK) {
#pragma unroll
                for (int j = 0; j < 8; ++j) { xv[j] = xn[j]; ov[j] = on[j]; } rq = rqn; }
            s = wave_sum(s); const float rs1 = 1.0f / sqrtf(s * (1.0f / DM) + EPSN);
            if (lane == 0) rstd1[m] = rs1;
            float dh[12];
#pragma unroll
            for (int h = 0; h < 12; ++h) {
                f32x4 wa[8];
#pragma unroll
                for (int j = 0; j < 8; ++j) wa[j] = *(const f32x4*)(wl + h * DM + (lane + 64 * j) * 4);
                __builtin_amdgcn_sched_barrier(0);
                float da = 0.f;
#pragma unroll
                for (int j = 0; j < 8; ++j) da += (hv[j][0] * wa[j][0] + hv[j][1] * wa[j][1]) + (hv[j][2] * wa[j][2] + hv[j][3] * wa[j][3]);
                dh[h] = da;
                __builtin_amdgcn_sched_barrier(0);
            }
#pragma unroll
            for (int o = 1; o < 64; o <<= 1) {
#pragma unroll
                for (int h = 0; h < 12; ++h) dh[h] += __shfl_xor(dh[h], o); }
            float mine = 0.f;
#pragma unroll
            for (int h = 0; h < 12; ++h) if (lane == h) mine = dh[h];
            if (lane < 12) { const float a = mine * rs1 + bfg; const float lf = fminf(a, 0.f) - __logf(1.f + __expf(-fabsf(a)));
                const int b = m >> 11, sidx = m & 2047; logf_[((size_t)(b * 12 + lane)) * SEQL + sidx] = lf; }
        }
    }
    GRID_SYNC();
    }
    REP(6) {
    PH(6) { PHASE_IDS();
        if (wave == 0) for (int rwi = blockIdx.x; rwi < NBATCH * 12; rwi += G) {
            const float* src = logf_ + (size_t)rwi * SEQL + lane * 32; float* dst = fcum + (size_t)rwi * SEQL + lane * 32;
            float v[32]; float run = 0.f;
#pragma unroll
            for (int q = 0; q < 8; ++q) { const f32x4 t = ((const f32x4*)src)[q]; v[4 * q] = t[0]; v[4 * q + 1] = t[1]; v[4 * q + 2] = t[2]; v[4 * q + 3] = t[3]; }
#pragma unroll
            for (int e = 0; e < 32; ++e) { run += v[e]; v[e] = run; }
            float incl = run;
#pragma unroll
            for (int o = 1; o < 64; o <<= 1) { const float t = __shfl_up(incl, o); if (lane >= o) incl += t; }
            const float excl = incl - run;
#pragma unroll
            for (int q = 0; q < 8; ++q) { f32x4 t = {v[4 * q] + excl, v[4 * q + 1] + excl, v[4 * q + 2] + excl, v[4 * q + 3] + excl}; ((f32x4*)dst)[q] = t; }
        }
        pg8::Gemm g{xb, (const bf16r*)(ws + WS_WKVB), NTOK, 7168, DM}; pg8::StaticOrder S; S.init(NTOK, 7168, G, (int)blockIdx.x);
        pg8::EpiProj<Sel1> E{rstd1, Sel1{kvb, proj, (float*)(ws + SM_QNRM), (float*)(ws + SM_KNRM)}, 11};
        pg8::gemm_phase<pg8::EpiProj<Sel1>, pg8::StaticOrder, true, true>(glds, g, S, E);
    }
    GRID_SYNC();
    }
    REP(7) {
    PH(7) att_phase<true, 1>(P, (char*)lds);
    GRID_SYNC();
    }
    REP(8) {
    PH(8) { pg8::Gemm g{cat, (const bf16r*)(ws + WS_WOUT1), NTOK, DM, DM}; pg8::StaticOrder S; S.init(NTOK, DM, G, (int)blockIdx.x);
      pg8::EpiOut E{ob, rep_ ? rowsq0 + 65536 * 9 : rowsq1};
      pg8::gemm_phase<pg8::EpiOut, pg8::StaticOrder, true, true>(glds, g, S, E); }
    GRID_SYNC();
    }
    REP(9) {
    PH(9) { PHASE_IDS();
        const float* gp = P.in[I_POSTG] + DM;
        f32x4 gv[8];
#pragma unroll
        for (int j = 0; j < 8; ++j) gv[j] = ((const f32x4*)gp)[lane + 64 * j];
        u32x2 hv[8]; u32x2 ov[8]; float rq = 0.f;
        if (gw < NTOK) { const u32x2* hp = (const u32x2*)(xb + (size_t)gw * DM) + lane; const u32x2* op = (const u32x2*)(ob + (size_t)gw * DM) + lane; rq = rowsq1[gw];
#pragma unroll
            for (int j = 0; j < 8; ++j) { hv[j] = hp[64 * j]; ov[j] = op[64 * j]; } }
        for (int m = gw; m < NTOK; m += NGW) {
            const float rso = 1.0f / sqrtf(rq * (1.0f / DM) + EPSN);
            u32x2 hn[8]; u32x2 on[8]; float rqn = 0.f; const int mn = m + NGW;
            if (mn < NTOK) { const u32x2* hp2 = (const u32x2*)(xb + (size_t)mn * DM) + lane; const u32x2* op = (const u32x2*)(ob + (size_t)mn * DM) + lane; rqn = rowsq1[mn];
#pragma unroll
                for (int j = 0; j < 8; ++j) { hn[j] = hp2[64 * j]; on[j] = op[64 * j]; } }
            f32x4* hp = (f32x4*)(P.out + (size_t)m * DM) + lane;
#pragma unroll
            for (int j = 0; j < 8; ++j) { f32x4 h;
                h[0] = pg8::bf_lo(hv[j].x) + pg8::bf_lo(ov[j].x) * rso * gv[j][0]; h[1] = pg8::bf_hi(hv[j].x) + pg8::bf_hi(ov[j].x) * rso * gv[j][1];
                h[2] = pg8::bf_lo(hv[j].y) + pg8::bf_lo(ov[j].y) * rso * gv[j][2]; h[3] = pg8::bf_hi(hv[j].y) + pg8::bf_hi(ov[j].y) * rso * gv[j][3];
                hp[64 * j] = h; }
            if (mn < NTOK) {
#pragma unroll
                for (int j = 0; j < 8; ++j) { hv[j] = hn[j]; ov[j] = on[j]; } rq = rqn; }
        }
    }
    }
}

extern "C" void kernel_launch(void* const* d_in, const int* in_sizes, int n_in, void* d_out, int out_size, void* d_ws, size_t ws_size, hipStream_t stream) {
    static int grid = 0;
    if (grid == 0) {
        if (n_in != 23 || out_size != NTOK * DM || ws_size < WS_END) { fprintf(stderr, "kernel_launch: unexpected shapes: n_in %d out %d ws %zu (need %zu)\n", n_in, out_size, ws_size, (size_t)WS_END); grid = -1; return; }
        int dev = 0, cus = 0, per_cu = 0;
        (void)hipGetDevice(&dev); (void)hipDeviceGetAttribute(&cus, hipDeviceAttributeMultiprocessorCount, dev);
        if (hipFuncSetAttribute((const void*)yoco_fwd, hipFuncAttributeMaxDynamicSharedMemorySize, LDS_TOTAL) != hipSuccess) { fprintf(stderr, "kernel_launch: hipFuncSetAttribute failed\n"); grid = -1; return; }
        if (hipOccupancyMaxActiveBlocksPerMultiprocessor(&per_cu, (const void*)yoco_fwd, 512, LDS_TOTAL) != hipSuccess || per_cu < 1) { fprintf(stderr, "kernel_launch: occupancy query says %d\n", per_cu); per_cu = 1; }
        (void)hipGetLastError();
        grid = cus * (per_cu > 1 ? 1 : per_cu);
        if (grid <= 0) grid = 256;
    }
    if (grid < 0) return;
    if (hipMemsetAsync((char*)d_ws + WS_BAR, 0, 16384, stream) != hipSuccess) { fprintf(stderr, "kernel_launch: hipMemsetAsync failed\n"); return; }
    Params p{};
    for (int i = 0; i < 23; ++i) p.in[i] = (const float*)d_in[i];
    p.out = (float*)d_out; p.ws = (unsigned char*)d_ws;
    void* args[] = {&p};
    hipError_t e = hipLaunchCooperativeKernel((const void*)yoco_fwd, dim3(grid), dim3(512), args, LDS_TOTAL, stream);
    if (e != hipSuccess) fprintf(stderr, "cooperative launch failed: %s (grid %d)\n", hipGetErrorString(e), grid);
}
```

```cpp
#include <hip/hip_runtime.h>
#include <hip/hip_bf16.h>
#include <hip/hip_cooperative_groups.h>
#include <cstdio>
#include <cstdint>
namespace cg = cooperative_groups;
__device__ __forceinline__ int opaque_tid() { int t = threadIdx.x; asm volatile("" : "+v"(t)); return t; }
namespace pg8 {
#define PG8_LAS __attribute__((address_space(3)))
typedef unsigned short bf16_t;
typedef short bf16x8 __attribute__((ext_vector_type(8)));
typedef float f32x4 __attribute__((ext_vector_type(4)));
typedef unsigned u32x4 __attribute__((ext_vector_type(4)));
constexpr int BM = 256, BK = 64, HALF = 128, HTB = HALF * BK * 2  , STAGE_BYTES = 8 * HTB, NXCD = 8, WGM = 8;

__host__ __device__ __forceinline__ int lds_byte(int r, int c) { const int st = (r >> 4) * 2 + (c >> 5), rr = r & 15, cc = c & 31, ob = rr * 64 + cc * 2; return st * 1024 + (ob ^ (((ob >> 9) & 1) << 5)); }
__host__ __device__ __forceinline__ void stage_rc(int b, int& R, int& C) { const int st = b / 1024, sb = b % 1024, swz = sb ^ (((sb >> 9) & 1) << 5); R = (st >> 1) * 16 + swz / 64; C = (st & 1) * 32 + (swz % 64) / 2; }
__host__ __device__ __forceinline__ int perm32(int rho) { const int n = rho >> 4, i = rho & 15; return 8 * (i >> 2) + 4 * n + (i & 3); }

struct Unit { int pm, pn; };
struct Gemm { const bf16_t* A; const bf16_t* Bt; int M, N, K; };

struct StaticOrder {
    int nM, nN, nwg, G, c;
    __host__ __device__ void init(int M, int N, int G_, int c_) { nM = M / BM; nN = N / BM; nwg = nM * nN; G = G_; c = c_; }
    __host__ __device__ bool next(int i, Unit& u) const {
        const long L = (long)i * G + c; if (L >= nwg) return false;
        int wgid = (int)L; { const int q = nwg / NXCD, r = nwg % NXCD, xcd = wgid % NXCD, off = wgid / NXCD; wgid = (xcd < r ? xcd * (q + 1) : r * (q + 1) + (xcd - r) * q) + off; }
        const int nig = WGM * nN, gid = wgid / nig, fm = gid * WGM, gsz = (nM - fm) < WGM ? (nM - fm) : WGM;
        u.pm = fm + ((wgid % nig) % gsz); u.pn = (wgid % nig) / gsz; return true;
    }
    __device__ __forceinline__ void a_ready(const Unit&) const {}
    __device__ __forceinline__ void done(const Unit&) const {}
};

__device__ __forceinline__ unsigned cvt_pk_bf16(float lo, float hi) { unsigned r; asm volatile("v_cvt_pk_bf16_f32 %0, %1, %2" : "=v"(r) : "v"(lo), "v"(hi)); return r; }
__device__ __forceinline__ float sigmoid_f(float v) { return __builtin_amdgcn_rcpf(1.f + __builtin_amdgcn_exp2f(-1.4426950408889634f * v)); }
__device__ __forceinline__ float silu_f(float v) { return v * sigmoid_f(v); }
__device__ __forceinline__ float bf_lo(unsigned w) { return __uint_as_float(w << 16); }
__device__ __forceinline__ float bf_hi(unsigned w) { return __uint_as_float(w & 0xffff0000u); }

__device__ __forceinline__ float xfq_sum(float v) {
    { auto r = __builtin_amdgcn_permlane16_swap(__float_as_uint(v), __float_as_uint(v), false, false); v = __uint_as_float(r[0]) + __uint_as_float(r[1]); }
    { auto r = __builtin_amdgcn_permlane32_swap(__float_as_uint(v), __float_as_uint(v), false, false); v = __uint_as_float(r[0]) + __uint_as_float(r[1]); }
    return v;
}
struct SecInfo { bf16_t* dst; int start; int ld; int nh; int act; float* nrm; };
template <class Sel> struct EpiProj {
    static constexpr bool PERM = true, AFTER_DRAIN = false;
    const float* rstd; Sel sel; int lgS;
    __device__ __forceinline__ void operator()(const f32x4 (&acc)[2][2][4][2], const Unit& u, int wr, int wc, int fr, int fq) const {
        const int row0 = u.pm * BM + wr * 64 + fr, cin = wc * 32 + 8 * fq;
        float rsv[2][4];
#pragma unroll
        for (int ai = 0; ai < 2; ++ai)
#pragma unroll
            for (int m = 0; m < 4; ++m) rsv[ai][m] = rstd[row0 + ai * HALF + m * 16];
#pragma unroll
        for (int bj = 0; bj < 2; ++bj) {
            const int cs = u.pn * BM + bj * HALF; const SecInfo si = sel(cs);
#pragma unroll
            for (int ai = 0; ai < 2; ++ai)
#pragma unroll
                for (int m = 0; m < 4; ++m) {
                    const int row = row0 + ai * HALF + m * 16; const float rs = rsv[ai][m];
                    f32x4 v0 = acc[ai][bj][m][0] * rs, v1 = acc[ai][bj][m][1] * rs;
                    if (si.act) {
#pragma unroll
                        for (int e = 0; e < 4; ++e) { v0[e] = silu_f(v0[e]); v1[e] = silu_f(v1[e]); } }
                    bf16_t* p;
                    if (si.nh) { const int b = row >> lgS, s = row & ((1 << lgS) - 1); const size_t hr = (((size_t)(b * si.nh + ((cs - si.start) >> 7))) << lgS) + s; p = si.dst + hr * 128 + cin;
                        if (si.nrm) { float q = (v0[0] * v0[0] + v0[1] * v0[1]) + (v0[2] * v0[2] + v0[3] * v0[3]) + (v1[0] * v1[0] + v1[1] * v1[1]) + (v1[2] * v1[2] + v1[3] * v1[3]);
                            q = xfq_sum(q); if (fq == 0) atomicAdd(si.nrm + hr, q); } }
                    else p = si.dst + (size_t)row * si.ld + (cs - si.start) + cin;
                    u32x4 w; w.x = cvt_pk_bf16(v0[0], v0[1]); w.y = cvt_pk_bf16(v0[2], v0[3]); w.z = cvt_pk_bf16(v1[0], v1[1]); w.w = cvt_pk_bf16(v1[2], v1[3]);
                    *(u32x4*)p = w;
                }
        }
    }
};
struct EpiGlu {
    static constexpr bool PERM = true, AFTER_DRAIN = false;
    const bf16_t* yg; const bf16_t* sz; const float* bias; bf16_t* cat;
    __device__ __forceinline__ void operator()(const f32x4 (&acc)[2][2][4][2], const Unit& u, int wr, int wc, int fr, int fq) const {
        const int row0 = u.pm * BM + wr * 64 + fr, col0 = u.pn * BM + wc * 32 + 8 * fq;
#pragma unroll
        for (int bj = 0; bj < 2; ++bj) {
            const int col = col0 + bj * HALF; const f32x4 b0 = *(const f32x4*)(bias + col), b1 = *(const f32x4*)(bias + col + 4);
#pragma unroll
            for (int ai = 0; ai < 2; ++ai) {
                u32x4 yv[4], zv[4];
#pragma unroll
                for (int m = 0; m < 4; ++m) { const int row = row0 + ai * HALF + m * 16;
                    yv[m] = *(const u32x4*)(yg + (size_t)row * 1536 + col); zv[m] = *(const u32x4*)(sz + (size_t)row * 2048 + col); }
#pragma unroll
                for (int m = 0; m < 4; ++m) {
                    const int row = row0 + ai * HALF + m * 16;
                    const u32x4 y = yv[m], z = zv[m];
                    const f32x4 g0 = acc[ai][bj][m][0] + b0, g1 = acc[ai][bj][m][1] + b1;
                    float o[8];
                    o[0] = bf_lo(y.x) * bf_lo(z.x) * sigmoid_f(g0[0]); o[1] = bf_hi(y.x) * bf_hi(z.x) * sigmoid_f(g0[1]);
                    o[2] = bf_lo(y.y) * bf_lo(z.y) * sigmoid_f(g0[2]); o[3] = bf_hi(y.y) * bf_hi(z.y) * sigmoid_f(g0[3]);
                    o[4] = bf_lo(y.z) * bf_lo(z.z) * sigmoid_f(g1[0]); o[5] = bf_hi(y.z) * bf_hi(z.z) * sigmoid_f(g1[1]);
                    o[6] = bf_lo(y.w) * bf_lo(z.w) * sigmoid_f(g1[2]); o[7] = bf_hi(y.w) * bf_hi(z.w) * sigmoid_f(g1[3]);
                    u32x4 w; w.x = cvt_pk_bf16(o[0], o[1]); w.y = cvt_pk_bf16(o[2], o[3]); w.z = cvt_pk_bf16(o[4], o[5]); w.w = cvt_pk_bf16(o[6], o[7]);
                    *(u32x4*)(cat + (size_t)row * 2048 + col) = w;
                }
            }
        }
    }
};
struct EpiOut {
    static constexpr bool PERM = true, AFTER_DRAIN = false;
    bf16_t* o; float* rowsq;
    __device__ __forceinline__ void operator()(const f32x4 (&acc)[2][2][4][2], const Unit& u, int wr, int wc, int fr, int fq) const {
        const int row0 = u.pm * BM + wr * 64 + fr, col0 = u.pn * BM + wc * 32 + 8 * fq;
#pragma unroll
        for (int ai = 0; ai < 2; ++ai)
#pragma unroll
            for (int m = 0; m < 4; ++m) {
                const int row = row0 + ai * HALF + m * 16; float s = 0.f;
#pragma unroll
                for (int bj = 0; bj < 2; ++bj) {
                    const f32x4 v0 = acc[ai][bj][m][0], v1 = acc[ai][bj][m][1];
                    s += (v0[0] * v0[0] + v0[1] * v0[1]) + (v0[2] * v0[2] + v0[3] * v0[3]) + (v1[0] * v1[0] + v1[1] * v1[1]) + (v1[2] * v1[2] + v1[3] * v1[3]);
                    u32x4 w; w.x = cvt_pk_bf16(v0[0], v0[1]); w.y = cvt_pk_bf16(v0[2], v0[3]); w.z = cvt_pk_bf16(v1[0], v1[1]); w.w = cvt_pk_bf16(v1[2], v1[3]);
                    *(u32x4*)(o + (size_t)row * 2048 + col0 + bj * HALF) = w;
                }
                s = xfq_sum(s);
                if (fq == 0) atomicAdd(rowsq + row, s);
            }
    }
};

template <class Epi, class Sched, bool ALIGN_EPI = false, bool SP2 = false>
__device__ __forceinline__ void gemm_phase(PG8_LAS unsigned char* lds, const Gemm g, const Sched& S, const Epi& E) {
    const int tid = opaque_tid(), wid = __builtin_amdgcn_readfirstlane(tid >> 6), lane = tid & 63, wr = wid >> 2, wc = wid & 3, fr = lane & 15, fq = lane >> 4;
    const int K = g.K, nt = K / BK;
    unsigned voffA[2], voffB[2];
#pragma unroll
    for (int i = 0; i < 2; ++i) { int R, C; stage_rc(tid * 16 + i * 8192, R, C); const int Rb = Epi::PERM ? ((R & ~31) + perm32(R & 31)) : R;
        voffA[i] = (unsigned)(R * K + C) * 2u; voffB[i] = (unsigned)(Rb * K + C) * 2u; }
    const size_t kstep = (size_t)(BK * 2);
    const size_t hstep = (size_t)HALF * K * 2;
    const size_t tstep = 2 * hstep;
    const unsigned ldsw = (unsigned)wid * 1024u;
    const int aoff = lds_byte(wr * 64 + fr, fq * 8), boff = lds_byte(wc * 32 + fr, fq * 8);
#define PG8_SA(b, h) (((b) * 2 + (h)) * HTB)
#define PG8_SB(b, h) ((4 + (b) * 2 + (h)) * HTB)
#define PG8_STAGE(bufoff, gbase, voff) do { _Pragma("unroll") for (int _i = 0; _i < 2; ++_i) \
        __builtin_amdgcn_global_load_lds((const unsigned*)((const char*)(gbase) + (voff)[_i]), (PG8_LAS unsigned*)(lds + (bufoff) + ldsw + _i * 8192), 16, 0, 0); } while (0)
#define PG8_LDA(dst, b, h) do { _Pragma("unroll") for (int m = 0; m < 4; ++m) _Pragma("unroll") for (int k = 0; k < 2; ++k) dst[m][k] = *(const PG8_LAS bf16x8*)(lds + PG8_SA(b, h) + aoff + m * 2048 + k * 1024); } while (0)
#define PG8_LDB(dst, b, h) do { _Pragma("unroll") for (int n = 0; n < 2; ++n) _Pragma("unroll") for (int k = 0; k < 2; ++k) dst[n][k] = *(const PG8_LAS bf16x8*)(lds + PG8_SB(b, h) + boff + n * 2048 + k * 1024); } while (0)
#define PG8_MMA(ai, bj, At, Bt) do { __builtin_amdgcn_s_setprio(1); _Pragma("unroll") for (int m = 0; m < 4; ++m) _Pragma("unroll") for (int n = 0; n < 2; ++n) _Pragma("unroll") for (int k = 0; k < 2; ++k) \
        acc[ai][bj][m][n] = __builtin_amdgcn_mfma_f32_16x16x32_bf16(Bt[n][k], At[m][k], acc[ai][bj][m][n], 0, 0, 0); __builtin_amdgcn_s_setprio(0); } while (0)
#define PG8_WAIT_V(n) asm volatile("s_waitcnt vmcnt(" #n ")" ::: "memory")
#define PG8_WAIT_L(n) asm volatile("s_waitcnt lgkmcnt(" #n ")" ::: "memory")
#define PG8_BAR __builtin_amdgcn_s_barrier()
#define PG8_SCHED __builtin_amdgcn_sched_barrier(0)
    Unit cur, nxt; int ui = 0;
    if (!S.next(0, cur)) return;
    f32x4 acc[2][2][4][2];
#pragma unroll
    for (int a = 0; a < 2; ++a)
#pragma unroll
        for (int b = 0; b < 2; ++b)
#pragma unroll
            for (int m = 0; m < 4; ++m)
#pragma unroll
                for (int n = 0; n < 2; ++n) acc[a][b][m][n] = (f32x4){0.f, 0.f, 0.f, 0.f};
    bf16x8 At[4][2], B0[2][2], B1[2][2];
    const char* cA = (const char*)g.A + (size_t)cur.pm * tstep; const char* cB = (const char*)g.Bt + (size_t)cur.pn * tstep;
    S.a_ready(cur);
    if constexpr (SP2) {
        PG8_STAGE(PG8_SB(0, 0), cB, voffB); PG8_STAGE(PG8_SB(0, 1), cB + hstep, voffB); PG8_STAGE(PG8_SA(0, 0), cA, voffA); PG8_STAGE(PG8_SA(0, 1), cA + hstep, voffA);
        if (wr == 1) PG8_BAR;
        PG8_WAIT_V(2); PG8_BAR;
        PG8_STAGE(PG8_SB(1, 0), cB + kstep, voffB); PG8_STAGE(PG8_SA(1, 0), cA + kstep, voffA); PG8_STAGE(PG8_SB(1, 1), cB + hstep + kstep, voffB);
        PG8_WAIT_V(6); PG8_BAR;
    } else {
        PG8_STAGE(PG8_SB(0, 0), cB, voffB); PG8_STAGE(PG8_SA(0, 0), cA, voffA); PG8_STAGE(PG8_SB(0, 1), cB + hstep, voffB); PG8_STAGE(PG8_SA(0, 1), cA + hstep, voffA);
        if (wr == 1) PG8_BAR;
        PG8_WAIT_V(4); PG8_BAR;
        PG8_STAGE(PG8_SB(1, 0), cB + kstep, voffB); PG8_STAGE(PG8_SA(1, 0), cA + kstep, voffA); PG8_STAGE(PG8_SB(1, 1), cB + hstep + kstep, voffB);
        PG8_WAIT_V(6); PG8_BAR;
    }
    for (;;) {
        const bool has_next = S.next(ui + 1, nxt);
        const char* nA = has_next ? (const char*)g.A + (size_t)nxt.pm * tstep : cA; const char* nB = has_next ? (const char*)g.Bt + (size_t)nxt.pn * tstep : cB;
        for (int t = 0; t < nt; t += 2) {
            const bool last = (t == nt - 2);
            const char* a1 = cA + (size_t)(t + 1) * kstep;
            const char* a2 = last ? nA : cA + (size_t)(t + 2) * kstep; const char* b2 = last ? nB : cB + (size_t)(t + 2) * kstep;
            const char* a3 = a2 + kstep; const char* b3 = b2 + kstep;
            if (last && has_next) S.a_ready(nxt);
            if constexpr (SP2) {
            PG8_LDB(B0, 0, 0); PG8_LDB(B1, 0, 1); PG8_SCHED; PG8_LDA(At, 0, 0); PG8_STAGE(PG8_SA(1, 1), a1 + hstep, voffA);
            PG8_WAIT_V(8); PG8_WAIT_L(0); PG8_BAR; PG8_MMA(0, 0, At, B0); PG8_MMA(0, 1, At, B1); PG8_BAR; PG8_SCHED;
            PG8_LDA(At, 0, 1); PG8_STAGE(PG8_SB(0, 0), b2, voffB); PG8_STAGE(PG8_SB(0, 1), b2 + hstep, voffB); PG8_STAGE(PG8_SA(0, 0), a2, voffA);
            PG8_WAIT_V(8); PG8_WAIT_L(0); PG8_BAR; PG8_MMA(1, 0, At, B0); PG8_MMA(1, 1, At, B1); PG8_BAR; PG8_SCHED;
            PG8_LDB(B0, 1, 0); PG8_LDB(B1, 1, 1); PG8_SCHED; PG8_LDA(At, 1, 0); PG8_STAGE(PG8_SA(0, 1), a2 + hstep, voffA);
            PG8_WAIT_V(8); PG8_WAIT_L(0); PG8_BAR; PG8_MMA(0, 0, At, B0); PG8_MMA(0, 1, At, B1); PG8_BAR; PG8_SCHED;
            PG8_LDA(At, 1, 1); PG8_STAGE(PG8_SB(1, 0), b3, voffB); PG8_STAGE(PG8_SB(1, 1), b3 + hstep, voffB); PG8_STAGE(PG8_SA(1, 0), a3, voffA);
            PG8_WAIT_V(8); PG8_WAIT_L(0); PG8_BAR; PG8_MMA(1, 0, At, B0); PG8_MMA(1, 1, At, B1); PG8_BAR; PG8_SCHED;
            } else {
            PG8_LDB(B0, 0, 0); PG8_SCHED; PG8_LDA(At, 0, 0); PG8_STAGE(PG8_SA(1, 1), a1 + hstep, voffA);
            PG8_WAIT_L(8); PG8_BAR; PG8_WAIT_L(0); PG8_MMA(0, 0, At, B0); PG8_BAR; PG8_SCHED;
            PG8_LDB(B1, 0, 1); PG8_STAGE(PG8_SB(0, 0), b2, voffB);
            PG8_BAR; PG8_WAIT_L(0); PG8_MMA(0, 1, At, B1); PG8_BAR;
            PG8_LDA(At, 0, 1); PG8_STAGE(PG8_SA(0, 0), a2, voffA);
            PG8_BAR; PG8_WAIT_L(0); PG8_MMA(1, 0, At, B0); PG8_BAR; PG8_SCHED;
            PG8_STAGE(PG8_SB(0, 1), b2 + hstep, voffB);
            PG8_WAIT_V(6); PG8_BAR; PG8_MMA(1, 1, At, B1); PG8_BAR;
            PG8_LDB(B0, 1, 0); PG8_SCHED; PG8_LDA(At, 1, 0); PG8_STAGE(PG8_SA(0, 1), a2 + hstep, voffA);
            PG8_WAIT_L(8); PG8_BAR; PG8_WAIT_L(0); PG8_MMA(0, 0, At, B0); PG8_BAR; PG8_SCHED;
            PG8_LDB(B1, 1, 1); PG8_STAGE(PG8_SB(1, 0), b3, voffB);
            PG8_BAR; PG8_WAIT_L(0); PG8_MMA(0, 1, At, B1); PG8_BAR;
            PG8_LDA(At, 1, 1); PG8_STAGE(PG8_SA(1, 0), a3, voffA);
            PG8_BAR; PG8_WAIT_L(0); PG8_MMA(1, 0, At, B0); PG8_BAR; PG8_SCHED;
            PG8_STAGE(PG8_SB(1, 1), b3 + hstep, voffB);
            PG8_WAIT_V(6); PG8_BAR; PG8_MMA(1, 1, At, B1); PG8_BAR;
            }
        }
        if constexpr (ALIGN_EPI) { if (wr == 0) PG8_BAR; }
        if constexpr (!Epi::AFTER_DRAIN) { E(acc, cur, wr, wc, fr, fq); S.done(cur); }
        if (!has_next) break;
#pragma unroll
        for (int a = 0; a < 2; ++a)
#pragma unroll
            for (int b = 0; b < 2; ++b)
#pragma unroll
                for (int m = 0; m < 4; ++m)
#pragma unroll
                    for (int n = 0; n < 2; ++n) acc[a][b][m][n] = (f32x4){0.f, 0.f, 0.f, 0.f};
        cur = nxt; cA = nA; cB = nB; ++ui;
        if constexpr (ALIGN_EPI) { if (wr == 1) PG8_BAR; }
    }
    PG8_WAIT_V(0);
    if constexpr (!ALIGN_EPI) { if (wr == 0) PG8_BAR; }
    PG8_BAR;
    if constexpr (Epi::AFTER_DRAIN) { E.fused(acc, cur, wr, wc, fr, fq, lds, wid, lane); S.done(cur); }
#undef PG8_SA
#undef PG8_SB
#undef PG8_STAGE
#undef PG8_LDA
#undef PG8_LDB
#undef PG8_MMA
#undef PG8_WAIT_V
#undef PG8_WAIT_L
#undef PG8_BAR
#undef PG8_SCHED
}
}
namespace att {
constexpr int D = 128; constexpr bool WSKIP = false; constexpr float THR = 8.f;
constexpr float SCALE = 0.08838834764831845f;
constexpr int NW = 8, QBLK = 32, KVBLK = 64, QB = NW * QBLK;
constexpr int SHM_V = KVBLK * D * 2, SHM_K = KVBLK * D * 2;
constexpr int FB_OFF = 2 * SHM_V + 2 * SHM_K + NW * 64 * 4;
constexpr int QL_OFF = FB_OFF + 2048 * 4;
constexpr int LDS_BYTES = QL_OFF + NW * QBLK * D * 2;
constexpr int LDO = 2048; constexpr float INV_SCALE = 11.313708498984761f;

using bf16 = __hip_bfloat16;
typedef short bf16x8 __attribute__((ext_vector_type(8)));
typedef short s16x4 __attribute__((ext_vector_type(4)));
typedef float f32x16 __attribute__((ext_vector_type(16)));
typedef float f32x4 __attribute__((ext_vector_type(4)));
typedef unsigned u32x4 __attribute__((ext_vector_type(4)));
template <class A, class Bt> struct same_t { static constexpr bool v = false; };
template <class A> struct same_t<A, A> { static constexpr bool v = true; };

#define KSWZ(row, colB) ((row) * 256 + ((colB) ^ (((row) & 7) << 4)))
#define SBAR() __builtin_amdgcn_sched_barrier(0)
__device__ __forceinline__ int v_st(int k, int c) { const int kk = (k & ~0xC) | ((k & 4) << 1) | ((k & 8) >> 1); return ((kk >> 3) * 4 + (c >> 5)) * 512 + ((kk & 7) * 32 + (c & 31)) * 2; }
__device__ __forceinline__ int v_rd_base(int lane) { return ((lane & 3) << 3) | (((lane >> 2) & 3) << 6) | (((lane >> 4) & 1) << 5) | (((lane >> 5) & 1) << 8); }
constexpr int v_rd_off(int d0, int ks, int half) { return d0 * 512 + ks * 4096 + half * 2048; }
__device__ __forceinline__ int crow(int r, int hi) { return (r & 3) + 8 * (r >> 2) + 4 * hi; }
__device__ __forceinline__ unsigned cvtpk(float lo, float hi) {
    unsigned r; asm volatile("v_cvt_pk_bf16_f32 %0, %1, %2" : "=v"(r) : "v"(lo), "v"(hi)); return r;
}
__device__ __forceinline__ bf16x8 pack8(f32x4 a, f32x4 b) {
    u32x4 w = {cvtpk(a[0], a[1]), cvtpk(a[2], a[3]), cvtpk(b[0], b[1]), cvtpk(b[2], b[3])};
    return *reinterpret_cast<bf16x8*>(&w);
}
template <class T> __device__ __forceinline__ bf16x8 load8(const T* p) {
    if constexpr (same_t<T, float>::v) { return pack8(*(const f32x4*)p, *(const f32x4*)(p + 4)); }
    else { return *reinterpret_cast<const bf16x8*>(p); }
}
__device__ __forceinline__ void mask_tile(f32x16& p0, f32x16& p1, int dq, unsigned W) {
    const float NEG = -__builtin_inff();
#pragma unroll
    for (int r = 0; r < 16; ++r) {
        const int c = (r & 3) + 8 * (r >> 2);
        if ((unsigned)(dq - c) >= W) p0[r] = NEG;
        if ((unsigned)(dq - c - 32) >= W) p1[r] = NEG;
    }
}
__device__ __forceinline__ void partialSM(f32x16& p0, f32x16& p1, float& m_reg, float& mn, float& alpha) {
    float pmax = p0[0]; for (int r = 1; r < 16; ++r) pmax = fmaxf(pmax, p0[r]); for (int r = 0; r < 16; ++r) pmax = fmaxf(pmax, p1[r]);
    { auto rr = __builtin_amdgcn_permlane32_swap(__float_as_uint(pmax), __float_as_uint(pmax), false, false);
      pmax = fmaxf(__uint_as_float(rr[0]), __uint_as_float(rr[1])); }
    constexpr float C2 = 1.4426950408889634f * SCALE;
    if (__builtin_expect(__all((pmax - m_reg) * SCALE <= THR), 1)) { mn = m_reg; alpha = 1.f; }
    else { mn = fmaxf(m_reg, pmax); alpha = __builtin_amdgcn_exp2f((m_reg - mn) * C2); m_reg = mn; }
    const float mnL = -mn * C2;
    for (int r = 0; r < 16; ++r) p0[r] = fmaf(p0[r], C2, mnL); for (int r = 0; r < 16; ++r) p1[r] = fmaf(p1[r], C2, mnL);
    for (int r = 0; r < 16; ++r) p0[r] = __builtin_amdgcn_exp2f(p0[r]);
}
__device__ __forceinline__ void finishSM(f32x16& p0, f32x16& p1, float alpha, float& l_reg, bf16x8& pa0, bf16x8& pa1, bf16x8& pa2, bf16x8& pa3) {
    for (int r = 0; r < 16; ++r) p1[r] = __builtin_amdgcn_exp2f(p1[r]);
    float ps = 0; for (int r = 0; r < 16; ++r) ps += p0[r]; for (int r = 0; r < 16; ++r) ps += p1[r];
    { auto rr = __builtin_amdgcn_permlane32_swap(__float_as_uint(ps), __float_as_uint(ps), false, false);
      ps = __uint_as_float(rr[0]) + __uint_as_float(rr[1]); }
    l_reg = l_reg * alpha + ps;
#define PK4(P, B_, OUT) do { unsigned a0 = cvtpk(P[B_+0], P[B_+1]), a1 = cvtpk(P[B_+2], P[B_+3]);                          \
        unsigned b0 = cvtpk(P[B_+4], P[B_+5]), b1 = cvtpk(P[B_+6], P[B_+7]);                                             \
        auto r0 = __builtin_amdgcn_permlane32_swap(a0, b0, false, false); auto r1 = __builtin_amdgcn_permlane32_swap(a1, b1, false, false); \
        u32x4 w = {r0[0], r1[0], r0[1], r1[1]}; OUT = *reinterpret_cast<bf16x8*>(&w); } while (0)
    PK4(p0, 0, pa0); PK4(p0, 8, pa1); PK4(p1, 0, pa2); PK4(p1, 8, pa3);
#undef PK4
}
template <int KB, bool SK>
__device__ __forceinline__ void qkt(f32x16& p0, f32x16& p1, const char* K_lds, int r32, int hi, const char* q_w, bool act, const float* fbt) {
    if (SK && !act) { const float NEG = -__builtin_inff();
#pragma unroll
        for (int r = 0; r < 16; ++r) { p0[r] = NEG; p1[r] = NEG; } return; }
    {
#pragma unroll
        for (int r4 = 0; r4 < 4; ++r4) { const f32x4 a = *(const f32x4*)(fbt + 8 * r4 + 4 * hi), b = *(const f32x4*)(fbt + 32 + 8 * r4 + 4 * hi);
            p0[4 * r4] = a[0]; p0[4 * r4 + 1] = a[1]; p0[4 * r4 + 2] = a[2]; p0[4 * r4 + 3] = a[3];
            p1[4 * r4] = b[0]; p1[4 * r4 + 1] = b[1]; p1[4 * r4 + 2] = b[2]; p1[4 * r4 + 3] = b[3]; }
    }
    const char* kb[4]; const char* qb[4];
#pragma unroll
    for (int dd = 0; dd < 4; ++dd) { kb[dd] = K_lds + KB * SHM_K + KSWZ(r32, (dd * 16 + hi * 8) * 2); qb[dd] = q_w + KSWZ(r32, (dd * 16 + hi * 8) * 2); }
    bf16x8 b0 = *reinterpret_cast<const bf16x8*>(kb[0]), b1 = *reinterpret_cast<const bf16x8*>(kb[0] + 32 * 256), qf = *reinterpret_cast<const bf16x8*>(qb[0]);
#pragma unroll
    for (int d0 = 0; d0 < 8; ++d0) {
        bf16x8 b0n = b0, b1n = b1, qfn = qf;
        if (d0 < 7) { const char* a = kb[(d0 + 1) & 3] + ((d0 + 1) >> 2) * 128;
            b0n = *reinterpret_cast<const bf16x8*>(a); b1n = *reinterpret_cast<const bf16x8*>(a + 32 * 256);
            qfn = *reinterpret_cast<const bf16x8*>(qb[(d0 + 1) & 3] + ((d0 + 1) >> 2) * 128); }
        __builtin_amdgcn_sched_barrier(0);
        p0 = __builtin_amdgcn_mfma_f32_32x32x16_bf16(b0, qf, p0, 0, 0, 0);
        p1 = __builtin_amdgcn_mfma_f32_32x32x16_bf16(b1, qf, p1, 0, 0, 0);
        __builtin_amdgcn_sched_barrier(0);
        b0 = b0n; b1 = b1n; qf = qfn; }
}
template <int VB, bool SK>
__device__ __forceinline__ void pv_tile(f32x16* o, int vb0, bf16x8 pa0, bf16x8 pa1, bf16x8 pa2, bf16x8 pa3, bool act) {
    if (SK && !act) return;
#define TRRD(dst, off) asm volatile("ds_read_b64_tr_b16 %0, %1 offset:%2" : "=&v"(dst) : "v"(vb0), "i"(off) : "memory")
#define PV_D0(d0) do { s16x4 l0, l1, l2, l3, h0, h1, h2, h3; constexpr int b_ = VB * SHM_V + v_rd_off(d0, 0, 0);     \
        TRRD(l0, b_); TRRD(h0, b_ + 2048); TRRD(l1, b_ + 4096); TRRD(h1, b_ + 6144); TRRD(l2, b_ + 8192); TRRD(h2, b_ + 10240); TRRD(l3, b_ + 12288); TRRD(h3, b_ + 14336); \
        asm volatile("s_waitcnt lgkmcnt(0)" ::: "memory"); SBAR();                 \
        o[d0] = __builtin_amdgcn_mfma_f32_32x32x16_bf16(pa0, (bf16x8){l0[0], l0[1], l0[2], l0[3], h0[0], h0[1], h0[2], h0[3]}, o[d0], 0, 0, 0);   \
        o[d0] = __builtin_amdgcn_mfma_f32_32x32x16_bf16(pa1, (bf16x8){l1[0], l1[1], l1[2], l1[3], h1[0], h1[1], h1[2], h1[3]}, o[d0], 0, 0, 0);   \
        o[d0] = __builtin_amdgcn_mfma_f32_32x32x16_bf16(pa2, (bf16x8){l2[0], l2[1], l2[2], l2[3], h2[0], h2[1], h2[2], h2[3]}, o[d0], 0, 0, 0);   \
        o[d0] = __builtin_amdgcn_mfma_f32_32x32x16_bf16(pa3, (bf16x8){l3[0], l3[1], l3[2], l3[3], h3[0], h3[1], h3[2], h3[3]}, o[d0], 0, 0, 0); } while (0)
    PV_D0(0); PV_D0(1); PV_D0(2); PV_D0(3);
#undef PV_D0
#undef TRRD
}

template <class TIn, class TOut> struct BlockRef { const TIn* Q; const TIn* K; const TIn* V; TOut* O; const float* FC; const TIn* G; int P0; int JLO; };
template <class TIn> struct Seam {
    bf16x8 qr[8];
    bf16x8 st_v0, st_v1, st_k0, st_k1; f32x4 sf0, sf1, sf2, sf3;
    f32x4 tq[16];
};
__device__ __forceinline__ int swa_jlo(int P0, int W) { const int lowk = P0 - W + 1; return lowk > 0 ? lowk / KVBLK : 0; }
#define ROW(p, k0, rr) ((p) + (size_t)((k0) + (rr)) * D + sc)
#define VMW() asm volatile("s_waitcnt vmcnt(0)" ::: "memory")
#define VMWN(n) asm volatile("s_waitcnt vmcnt(%0)" :: "i"(n) : "memory")
#define SLOAD_H(Kp, Vp, k0) do { S.st_v0 = load8<TIn>(ROW(Vp, k0, sr)); S.st_v1 = load8<TIn>(ROW(Vp, k0, 32 + sr));              \
                         S.st_k0 = load8<TIn>(ROW(Kp, k0, sr)); S.st_k1 = load8<TIn>(ROW(Kp, k0, 32 + sr)); } while (0)
#define SWRITE_HK(bf) do { *(bf16x8*)(K_lds + (bf) * SHM_K + kws) = S.st_k0; *(bf16x8*)(K_lds + (bf) * SHM_K + kws + 32 * 256) = S.st_k1; } while (0)
#define SWRITE_HV(bf) do { *(bf16x8*)(V_lds + (bf) * SHM_V + vst0) = S.st_v0; *(bf16x8*)(V_lds + (bf) * SHM_V + vst1) = S.st_v1; } while (0)
#define SWRITE_H(bf) do { SWRITE_HV(bf); SWRITE_HK(bf); } while (0)
#define SLOAD_F(p, k0) do { S.sf0 = *(const f32x4*)ROW(p, k0, sr); S.sf1 = *(const f32x4*)(ROW(p, k0, sr) + 4);                \
                            S.sf2 = *(const f32x4*)ROW(p, k0, 32 + sr); S.sf3 = *(const f32x4*)(ROW(p, k0, 32 + sr) + 4); } while (0)
#define SWRITE_KF(bf) do { *(bf16x8*)(K_lds + (bf) * SHM_K + kws) = pack8(S.sf0, S.sf1); *(bf16x8*)(K_lds + (bf) * SHM_K + kws + 32 * 256) = pack8(S.sf2, S.sf3); } while (0)
#define SWRITE_VF(bf) do { *(bf16x8*)(V_lds + (bf) * SHM_V + vst0) = pack8(S.sf0, S.sf1); *(bf16x8*)(V_lds + (bf) * SHM_V + vst1) = pack8(S.sf2, S.sf3); } while (0)
template <class TIn, class TOut>
__device__ __forceinline__ void causal_swa_prime(const BlockRef<TIn, TOut>& cur, int W, char* lds, Seam<TIn>& S) {
    constexpr bool F32 = same_t<TIn, float>::v;
    const int tid = opaque_tid(), wid = __builtin_amdgcn_readfirstlane(tid >> 6), lane = tid & 63, r32 = lane & 31, hi = lane >> 5;
    const int sr = tid >> 4, sc = (tid & 15) * 8, kws = KSWZ(sr, sc * 2); char* K_lds = lds + 2 * SHM_V;
    const int kb0 = cur.JLO * KVBLK;
    for (int d0 = 0; d0 < 8; ++d0) S.qr[d0] = load8<TIn>(cur.Q + (size_t)(wid * QBLK + r32) * D + d0 * 16 + hi * 8);
    { char* q_w = lds + QL_OFF + wid * (QBLK * D * 2);
      for (int d0 = 0; d0 < 8; ++d0) *reinterpret_cast<bf16x8*>(q_w + KSWZ(r32, (d0 * 16 + hi * 8) * 2)) = S.qr[d0]; }
    if constexpr (F32) { SLOAD_F((const float*)cur.K, kb0); VMW(); SWRITE_KF(0); SBAR(); SLOAD_F((const float*)cur.V, kb0); }
    else { SLOAD_H(cur.K, cur.V, kb0); VMW(); SWRITE_HK(0); }
    __syncthreads();
}
template <class TIn, class TOut>
__device__ __forceinline__ void causal_swa_block(const BlockRef<TIn, TOut>& cur, const BlockRef<TIn, TOut>& nxt, int skv, int W, char* lds, Seam<TIn>& S) {
    constexpr bool F32 = same_t<TIn, float>::v;
    const int tid = opaque_tid(), wid = __builtin_amdgcn_readfirstlane(tid >> 6), lane = tid & 63, r32 = lane & 31, hi = lane >> 5;
    const int j_lo = cur.JLO;
    int j_hi = (cur.P0 + QB - 1) / KVBLK + 1; if (j_hi > skv / KVBLK) j_hi = skv / KVBLK;
    const int NT = j_hi - j_lo;
    const int kbn = nxt.JLO * KVBLK;
    const int qlo = cur.P0 + wid * QBLK, qm = qlo + r32 - 4 * hi;
    char* V_lds = lds; char* K_lds = lds + 2 * SHM_V;
    float* ws = (float*)(lds + 2 * SHM_V + 2 * SHM_K) + wid * 64; float* li_l = ws, * al_l = ws + 32;
    float m_reg = -1e30f, l_reg = 0; f32x16 o[4] = {};
    const int sr = tid >> 4, sc = (tid & 15) * 8, vst0 = v_st(sr, sc), vst1 = v_st(32 + sr, sc), kws = KSWZ(sr, sc * 2);
    const int vb0 = (int)(uintptr_t)V_lds + v_rd_base(lane);
    const TIn* Kh = cur.K; const TIn* Vh = cur.V;
    char* q_w = lds + QL_OFF + wid * (QBLK * D * 2);
    float* fb = (float*)(lds + FB_OFF);
    { const int nk = j_hi * KVBLK; const float* FCp = cur.FC; const float c0 = FCp ? FCp[cur.P0] : 0.f;
#pragma unroll
      for (int k = 0; k < 4; ++k) { const int i = tid + 64 * NW * k;
          if (i < nk) { float v = 0.f; if (FCp) v = (c0 - FCp[i]) * INV_SCALE; fb[i] = v; } }
      __syncthreads(); }
#define RESC(a) do { if (__any((a) < 1.f)) { if (hi == 0) al_l[r32] = (a); asm volatile("s_waitcnt lgkmcnt(0)" ::: "memory");              \
                     for (int d_ = 0; d_ < 4; ++d_) for (int r = 0; r < 16; ++r) o[d_][r] *= al_l[crow(r, hi)]; } } while (0)
#define KBASE(t) ((j_lo + (t)) * KVBLK)
#define ACT(t) (KBASE(t) <= qlo + QBLK - 1 && KBASE(t) + KVBLK - 1 >= qlo - W + 1)
#define MASKT(P0_, P1_, t) do { const int kb_ = KBASE(t); if ((!SK || ACT(t)) && (kb_ + KVBLK - 1 > qlo || kb_ <= qlo + QBLK - 1 - W)) mask_tile(P0_, P1_, qm - kb_, (unsigned)W); } while (0)
    constexpr int NQL = F32 ? 16 : 8;
    constexpr bool SK = WSKIP && !F32;
#define SEAM_K0() do { VMWN(NQL); if constexpr (F32) { SWRITE_KF(0); SBAR(); SLOAD_F((const float*)nxt.V, kbn); } else { SWRITE_HK(0); } SBAR(); } while (0)
    f32x16 pA0, pA1, pB0, pB1; float mnA, mnB, alA, alB; bf16x8 pa0, pa1, pa2, pa3;
    if constexpr (F32) { VMW(); SWRITE_VF(0); SBAR(); } else { SWRITE_HV(0); SBAR(); }
    if (NT > 1) { if constexpr (F32) SLOAD_F((const float*)Kh, KBASE(1)); else SLOAD_H(Kh, Vh, KBASE(1)); }
    SBAR(); qkt<0, SK>(pA0, pA1, K_lds, r32, hi, q_w, ACT(0), fb + KBASE(0));
    if constexpr (F32) { if (NT > 1) { VMW(); SWRITE_KF(1); SBAR(); SLOAD_F((const float*)Vh, KBASE(1)); } }
    MASKT(pA0, pA1, 0); partialSM(pA0, pA1, m_reg, mnA, alA);
    if (NT > 1) { VMW(); if constexpr (F32) { SWRITE_VF(1); SBAR(); if (NT > 2) SLOAD_F((const float*)Kh, KBASE(2)); } else SWRITE_H(1); }
    __syncthreads();
#define HALF_STEP(PX0, PX1, mnX, alX, PY0, PY1, alY, t, KB, VB, SB) do {                                                      \
        SBAR(); qkt<KB, SK>(PX0, PX1, K_lds, r32, hi, q_w, ACT(t), fb + KBASE(t));                                             \
        finishSM(PY0, PY1, alY, l_reg, pa0, pa1, pa2, pa3); SBAR();                                                           \
        if ((t) + 1 < NT) { if constexpr (F32) { VMW(); SWRITE_KF(SB); SBAR(); SLOAD_F((const float*)Vh, KBASE((t) + 1)); }  \
                            else { SLOAD_H(Kh, Vh, KBASE((t) + 1)); } SBAR(); }                                               \
        pv_tile<VB, SK>(o, vb0, pa0, pa1, pa2, pa3, ACT((t) - 1)); MASKT(PX0, PX1, (t)); partialSM(PX0, PX1, m_reg, mnX, alX);                                        \
        __syncthreads();                                                                                                      \
        if ((t) + 1 < NT) { VMW(); if constexpr (F32) { SWRITE_VF(SB); SBAR(); if ((t) + 2 < NT) SLOAD_F((const float*)Kh, KBASE((t) + 2)); } \
                            else { SWRITE_H(SB); } }                                                                          \
        RESC(alX); __syncthreads(); } while (0)
    for (int t = 1; t + 1 < NT; t += 2) {
        HALF_STEP(pB0, pB1, mnB, alB, pA0, pA1, alA, t, 1, 0, 0);
        HALF_STEP(pA0, pA1, mnA, alA, pB0, pB1, alB, t + 1, 0, 1, 1);
    }
    const bool even = (NT & 1) == 0;
    if (even) { SBAR(); qkt<1, SK>(pB0, pB1, K_lds, r32, hi, q_w, ACT(NT - 1), fb + KBASE(NT - 1)); SBAR(); }
#define QROW(e) (nxt.Q + (size_t)(wid * QBLK + r32) * D + ((e) >> 1) * 16 + hi * 8 + ((e) & 1) * 4)
    if constexpr (F32) { SLOAD_F((const float*)nxt.K, kbn); SBAR();
#pragma unroll
        for (int e = 0; e < 8; ++e) S.tq[e] = *(const f32x4*)QROW(e); }
    else { SLOAD_H(nxt.K, nxt.V, kbn); SBAR();
#pragma unroll
        for (int d0 = 0; d0 < 8; ++d0) S.qr[d0] = load8<TIn>(nxt.Q + (size_t)(wid * QBLK + r32) * D + d0 * 16 + hi * 8); }
    SBAR();
    finishSM(pA0, pA1, alA, l_reg, pa0, pa1, pa2, pa3); SBAR();
    if constexpr (F32) {
#pragma unroll
        for (int e = 8; e < 16; ++e) S.tq[e] = *(const f32x4*)QROW(e); SBAR(); }
#undef QROW
    pv_tile<0, SK>(o, vb0, pa0, pa1, pa2, pa3, ACT(even ? NT - 2 : NT - 1));
    if (even) { MASKT(pB0, pB1, NT - 1); partialSM(pB0, pB1, m_reg, mnB, alB); __syncthreads(); RESC(alB);
        finishSM(pB0, pB1, alB, l_reg, pa0, pa1, pa2, pa3); SBAR(); pv_tile<1, SK>(o, vb0, pa0, pa1, pa2, pa3, ACT(NT - 1)); }
    SBAR(); SEAM_K0();
    if (hi == 0) li_l[r32] = l_reg; asm volatile("s_waitcnt lgkmcnt(0)" ::: "memory");
    float rli[16];
#pragma unroll
    for (int r = 0; r < 16; ++r) rli[r] = __builtin_amdgcn_rcpf(li_l[crow(r, hi)]);
    {
        unsigned short* ost = (unsigned short*)q_w;
        {
            const bool odd = (r32 & 1) != 0; unsigned short* ob_ = ost + (odd ? 32 : 0) + (r32 & ~1);
#pragma unroll
            for (int r = 0; r < 16; ++r) { const int orow = crow(r, hi);
#pragma unroll
                for (int dp = 0; dp < 4; dp += 2) { const float e0 = o[dp][r] * rli[r], e1 = o[dp + 1][r] * rli[r];
                    const float snd = odd ? e0 : e1;
                    const float rcv = __int_as_float(__builtin_amdgcn_update_dpp(0, __float_as_int(snd), 0xB1, 0xF, 0xF, true));
                    const float lo = odd ? rcv : e0, hi_ = odd ? e1 : rcv;
                    *(unsigned*)(ob_ + orow * 128 + dp * 32) = cvtpk(lo, hi_); } }
        }
        asm volatile("s_waitcnt lgkmcnt(0)" ::: "memory");
        const unsigned short* Gw = (const unsigned short*)cur.G + (size_t)(wid * QBLK) * LDO; TOut* Ow = cur.O + (size_t)(wid * QBLK) * LDO;
        const int ck = lane & 15, rq = lane >> 4;
        u32x4 gq[8];
#pragma unroll
        for (int i = 0; i < 8; ++i) gq[i] = *(const u32x4*)(Gw + (size_t)(4 * i + rq) * LDO + ck * 8);
#pragma unroll
        for (int i = 0; i < 8; ++i) { const u32x4 ov = *(const u32x4*)(ost + (4 * i + rq) * 128 + ck * 8); const u32x4 g = gq[i]; u32x4 w;
#define GMUL(a_, b_) cvtpk(__uint_as_float((a_) << 16) * __uint_as_float((b_) << 16), __uint_as_float((a_) & 0xffff0000u) * __uint_as_float((b_) & 0xffff0000u))
            w.x = GMUL(ov.x, g.x); w.y = GMUL(ov.y, g.y); w.z = GMUL(ov.z, g.z); w.w = GMUL(ov.w, g.w);
#undef GMUL
            *(u32x4*)(Ow + (size_t)(4 * i + rq) * LDO + ck * 8) = w; }
        asm volatile("s_waitcnt lgkmcnt(0)" ::: "memory");
    }
    if constexpr (F32) {
#pragma unroll
        for (int d0 = 0; d0 < 8; ++d0) S.qr[d0] = pack8(S.tq[2 * d0], S.tq[2 * d0 + 1]); }
#pragma unroll
    for (int d0 = 0; d0 < 8; ++d0) *reinterpret_cast<bf16x8*>(q_w + KSWZ(r32, (d0 * 16 + hi * 8) * 2)) = S.qr[d0];
    __syncthreads();
#undef RESC
#undef KBASE
#undef ACT
#undef MASKT
#undef SEAM_K0
#undef HALF_STEP
}
#undef ROW
#undef VMW
#undef VMWN
#undef SLOAD_H
#undef SWRITE_HK
#undef SWRITE_HV
#undef SWRITE_H
#undef SLOAD_F
#undef SWRITE_KF
#undef SWRITE_VF


#undef KSWZ
#undef SBAR
}
#define LAS __attribute__((address_space(3)))
typedef unsigned short bf16r;
typedef float f32x4 __attribute__((ext_vector_type(4)));
typedef float f32x16 __attribute__((ext_vector_type(16)));
typedef short bf16x8 __attribute__((ext_vector_type(8)));
typedef unsigned u32x4 __attribute__((ext_vector_type(4)));
typedef unsigned u32x2 __attribute__((ext_vector_type(2)));

constexpr int NTOK = 16384, DM = 2048, SEQL = 2048, NBATCH = 8, NMEM = 256, MAINW = 1536, MEMW = 512, NGRP = 96;
constexpr float EPSN = 1e-6f;
constexpr size_t MiB = (size_t)1 << 20;
constexpr size_t SM_RSTD0 = 0, SM_RSTDM = 64 * 1024, SM_ROWSQ0 = 128 * 1024, SM_ROWSQ1 = 192 * 1024, SM_RSTD1 = 256 * 1024,
                 SM_LOGF = 320 * 1024, SM_FCUM = 1152 * 1024, SM_WFT = 1984 * 1024, SM_QNRM = 2560 * 1024, SM_KNRM = 3328 * 1024;
constexpr size_t WS_WINA = 4 * MiB, WS_WKVB = 20 * MiB, WS_WGLU = 48 * MiB, WS_WMKV0 = 53 * MiB, WS_WMKV1 = 57 * MiB, WS_WOUT0 = 61 * MiB, WS_WOUT1 = 69 * MiB,
                 WS_XB = 77 * MiB, WS_MEMB = 141 * MiB, WS_MKV = 149 * MiB, WS_PROJ = 157 * MiB, WS_KVB = 285 * MiB, WS_CAT = 381 * MiB, WS_OB = 445 * MiB, WS_BAR = 509 * MiB, WS_END = 509 * MiB + 65536;
constexpr int LDS_TOTAL = 147456;

struct Params { const float* in[23]; float* out; unsigned char* ws; };
enum { I_X = 0, I_MEM, I_PREG, I_POSTG, I_WINA, I_LRE, I_LIM, I_LSTEP, I_BRE, I_BIM, I_CRE, I_CIM, I_DSKIP, I_WGLU, I_BGLU, I_KVG, I_WKV, I_WFG, I_BFG, I_WINB, I_MEMG, I_WMKV, I_WOUT };

__device__ __forceinline__ float wave_sum(float v) {
#pragma unroll
    for (int o = 1; o < 64; o <<= 1) v += __shfl_xor(v, o);
    return v;
}
__device__ __forceinline__ unsigned pkbf(float lo, float hi) { return pg8::cvt_pk_bf16(lo, hi); }
#define LDS_FENCE() asm volatile("s_waitcnt lgkmcnt(0)" ::: "memory")

__device__ __forceinline__ void transpose_item(const float* W, const float* gs, int K, int N, bf16r* WT, int row_off, LAS float* scr, int item, int lane) {
    const int nblk = N / 32, kb = item / nblk, nb = item % nblk, k0 = 64 * kb, n0 = 32 * nb;
    const float* src = W + (size_t)(k0 + (lane >> 5)) * N + n0 + (lane & 31);
    float v[32];
#pragma unroll
    for (int i = 0; i < 32; ++i) v[i] = __builtin_nontemporal_load(src + (size_t)(2 * i) * N);
    const int c = lane & 7;
    f32x4 g0 = {1.f, 1.f, 1.f, 1.f}, g1 = {1.f, 1.f, 1.f, 1.f};
    if (gs) { g0 = *(const f32x4*)(gs + k0 + 8 * c); g1 = *(const f32x4*)(gs + k0 + 8 * c + 4); }
#pragma unroll
    for (int i = 0; i < 32; ++i) scr[(2 * i + (lane >> 5)) * 33 + (lane & 31)] = v[i];
    LDS_FENCE();
#pragma unroll
    for (int j = 0; j < 4; ++j) { const int n = (lane >> 3) + 8 * j; const LAS float* s = scr + (8 * c) * 33 + n;
        u32x4 o; o.x = pkbf(s[0 * 33] * g0[0], s[1 * 33] * g0[1]); o.y = pkbf(s[2 * 33] * g0[2], s[3 * 33] * g0[3]); o.z = pkbf(s[4 * 33] * g1[0], s[5 * 33] * g1[1]); o.w = pkbf(s[6 * 33] * g1[2], s[7 * 33] * g1[3]);
        *(u32x4*)(WT + (size_t)(row_off + n0 + n) * K + k0 + 8 * c) = o; }
    LDS_FENCE();
}
__device__ __forceinline__ void rows_to_bf16(const float* x, bf16r* o, float* rstd_out, int m0, int stride, int nrows, int lane) {
    f32x4 v[8];
    if (m0 < nrows) { const f32x4* xp = (const f32x4*)(x + (size_t)m0 * DM) + lane;
#pragma unroll
        for (int j = 0; j < 8; ++j) v[j] = __builtin_nontemporal_load(xp + 64 * j); }
    for (int m = m0; m < nrows; m += stride) {
        f32x4 vn[8]; const int mn = m + stride;
        if (mn < nrows) { const f32x4* xp = (const f32x4*)(x + (size_t)mn * DM) + lane;
#pragma unroll
            for (int j = 0; j < 8; ++j) vn[j] = __builtin_nontemporal_load(xp + 64 * j); }
        float s = 0.f;
#pragma unroll
        for (int j = 0; j < 8; ++j) s += (v[j][0] * v[j][0] + v[j][1] * v[j][1]) + (v[j][2] * v[j][2] + v[j][3] * v[j][3]);
        s = wave_sum(s);
        if (lane == 0) rstd_out[m] = 1.0f / sqrtf(s * (1.0f / DM) + EPSN);
        u32x2* op = (u32x2*)(o + (size_t)m * DM) + lane;
#pragma unroll
        for (int j = 0; j < 8; ++j) { u32x2 w; w.x = pkbf(v[j][0], v[j][1]); w.y = pkbf(v[j][2], v[j][3]); op[64 * j] = w; }
        if (mn < nrows) {
#pragma unroll
            for (int j = 0; j < 8; ++j) v[j] = vn[j]; }
    }
}

struct Sel0 { bf16r* proj;
    __device__ __forceinline__ pg8::SecInfo operator()(int cs) const {
        if (cs < 1536) return {proj, 0, 1536, 0, 0, nullptr};
        if (cs < 3072) return {proj + (size_t)NTOK * 1536, 1536, 2048, 0, 1, nullptr};
        if (cs < 3584) return {proj + (size_t)NTOK * 3584, 3072, 0, 4, 0, nullptr};
        return {proj + (size_t)NTOK * 1536 + 1536, 3584, 2048, 0, 1, nullptr}; } };
struct Sel1 { bf16r* kvb; bf16r* proj; float* qnrm; float* knrm;
    __device__ __forceinline__ pg8::SecInfo operator()(int cs) const {
        if (cs < 1536) return {kvb, 0, 0, 12, 0, knrm};
        if (cs < 3072) return {kvb + (size_t)NTOK * 1536, 1536, 0, 12, 0, nullptr};
        if (cs < 4608) return {proj, 3072, 0, 12, 0, qnrm};
        if (cs < 6144) return {proj + (size_t)NTOK * 1536, 4608, 2048, 0, 1, nullptr};
        if (cs < 6656) return {proj + (size_t)NTOK * 3584, 6144, 0, 4, 0, nullptr};
        return {proj + (size_t)NTOK * 1536 + 1536, 6656, 2048, 0, 1, nullptr}; } };
struct SelM { bf16r* mkv;
    __device__ __forceinline__ pg8::SecInfo operator()(int cs) const {
        if (cs < 512) return {mkv, 0, 0, 4, 0, nullptr};
        return {mkv + (size_t)NBATCH * NMEM * 512, 512, 0, 4, 0, nullptr}; } };

constexpr int SSM_XS = 80;
constexpr int SSM_WAVE_LDS = 128 * 36 * 4 + 32 * SSM_XS * 4;
typedef float __attribute__((may_alias)) f32_ma; typedef unsigned __attribute__((may_alias)) u32_ma;
typedef f32x4 __attribute__((may_alias)) f32x4_ma; typedef bf16x8 __attribute__((may_alias)) bf16x8_ma;
__device__ __forceinline__ int crow16(int r, int hi) { return (r & 3) + 8 * (r >> 2) + 4 * hi; }
__device__ __forceinline__ float gelu_tanh(float y) {
    const float z = 0.7978845608028654f * (y + 0.044715f * y * y * y);
    return y * __builtin_amdgcn_rcpf(1.f + __builtin_amdgcn_exp2f(-2.8853900817779268f * z));
}
struct SsmCtx {
    f32_ma* Bu2; u32_ma* Xs; const bf16r* U; bf16r* YG; size_t tokb; int g, lane, c, hi, l16, kq;
    float ar, ai; bf16x8 Bf[4]; bf16x8 Cf[4]; float dsk[4];
};
__device__ __forceinline__ void ssm_s2(const SsmCtx& X, bf16x8 Uc) {
#pragma unroll
    for (int nt = 0; nt < 4; ++nt) {
        f32x16 a = {};
        a = __builtin_amdgcn_mfma_f32_32x32x16_bf16(Uc, X.Bf[nt], a, 0, 0, 0);
#pragma unroll
        for (int r4 = 0; r4 < 4; ++r4) { f32x4 v = {a[4 * r4], a[4 * r4 + 1], a[4 * r4 + 2], a[4 * r4 + 3]}; *(f32x4_ma*)(X.Bu2 + (32 * nt + X.c) * 36 + 8 * r4 + 4 * X.hi) = v; }
    }
}
__device__ __forceinline__ void ssm_s1(const SsmCtx& X, float& xr, float& xi) {
#pragma unroll
    for (int q = 0; q < 8; ++q) {
        const f32x4 re4 = *(const f32x4_ma*)(X.Bu2 + X.lane * 36 + 4 * q), im4 = *(const f32x4_ma*)(X.Bu2 + (64 + X.lane) * 36 + 4 * q);
#pragma unroll
        for (int e = 0; e < 4; ++e) {
            const float nr = X.ar * xr - X.ai * xi + re4[e], ni = X.ar * xi + X.ai * xr + im4[e];
            xr = nr; xi = ni; X.Xs[(4 * q + e) * SSM_XS + X.lane] = pkbf(xr, xi);
        }
    }
}
__device__ __forceinline__ void ssm_s3(const SsmCtx& X, bf16r* py, u32x2 us0, u32x2 us1) {
    f32x4 y0 = {0.f, 0.f, 0.f, 0.f}, y1 = {0.f, 0.f, 0.f, 0.f};
#pragma unroll
    for (int s = 0; s < 4; ++s) {
        const bf16x8 b0 = *(const bf16x8_ma*)(X.Xs + X.l16 * SSM_XS + 16 * s + 4 * X.kq), b1 = *(const bf16x8_ma*)(X.Xs + (16 + X.l16) * SSM_XS + 16 * s + 4 * X.kq);
        y0 = __builtin_amdgcn_mfma_f32_16x16x32_bf16(X.Cf[s], b0, y0, 0, 0, 0);
        y1 = __builtin_amdgcn_mfma_f32_16x16x32_bf16(X.Cf[s], b1, y1, 0, 0, 0);
    }
    y0[0] += X.dsk[0] * pg8::bf_lo(us0.x); y0[1] += X.dsk[1] * pg8::bf_hi(us0.x); y0[2] += X.dsk[2] * pg8::bf_lo(us0.y); y0[3] += X.dsk[3] * pg8::bf_hi(us0.y);
    y1[0] += X.dsk[0] * pg8::bf_lo(us1.x); y1[1] += X.dsk[1] * pg8::bf_hi(us1.x); y1[2] += X.dsk[2] * pg8::bf_lo(us1.y); y1[3] += X.dsk[3] * pg8::bf_hi(us1.y);
    u32x2 w0, w1;
    w0.x = pkbf(gelu_tanh(y0[0]), gelu_tanh(y0[1])); w0.y = pkbf(gelu_tanh(y0[2]), gelu_tanh(y0[3]));
    w1.x = pkbf(gelu_tanh(y1[0]), gelu_tanh(y1[1])); w1.y = pkbf(gelu_tanh(y1[2]), gelu_tanh(y1[3]));
    *(u32x2*)py = w0;
    *(u32x2*)(py + 16 * 1536) = w1;
}
#define SSM_BAR() asm volatile("s_waitcnt lgkmcnt(0)\n\ts_barrier" ::: "memory")
constexpr int SSM_TASK_LDS = 128 * 36 * 4 + 2 * 32 * SSM_XS * 4;
__device__ __forceinline__ void ssm_round(const Params& P, bool active, int role, int b, int g, unsigned char* wl, int lane) {
    SsmCtx X; X.g = g; X.lane = lane; X.c = lane & 31; X.hi = lane >> 5; X.l16 = lane & 15; X.kq = lane >> 4;
    const int c = X.c, hi = X.hi, l16 = X.l16, kq = X.kq;
    X.Bu2 = (f32_ma*)wl; u32_ma* Xs0 = (u32_ma*)(wl + 128 * 36 * 4); X.Xs = Xs0;
    X.U = (const bf16r*)(P.ws + WS_PROJ); X.YG = (bf16r*)(P.ws + WS_KVB); X.tokb = (size_t)b * SEQL;
    X.ar = 0.f; X.ai = 0.f;
    const bf16r* Ua = X.U + (X.tokb + c) * 1536 + g * 16 + 8 * hi;
    const bf16r* Us = X.U + (X.tokb + l16) * 1536 + g * 16 + 4 * kq;
    constexpr int NCH = SEQL / 32; constexpr size_t CHS = (size_t)32 * 1536;
    bf16x8 U0 = {}, U1 = {}, U2 = {}; u32x2 a0 = {0u, 0u}, a1 = {0u, 0u}, b0 = {0u, 0u}, b1 = {0u, 0u}, c0 = {0u, 0u}, c1 = {0u, 0u};
    if (active) {
        const float dt = __expf(P.in[I_LSTEP][g]), lr = P.in[I_LRE][g * 64 + lane], li = P.in[I_LIM][g * 64 + lane];
        const float mag = __expf(lr * dt); float rev = li * dt * 0.15915494309189535f; rev -= floorf(rev);
        const float ar = mag * __builtin_amdgcn_cosf(rev), ai = mag * __builtin_amdgcn_sinf(rev);
        const float den = lr * lr + li * li, cr = ((ar - 1.0f) * lr + ai * li) / den, ci = (ai * lr - (ar - 1.0f) * li) / den;
        X.ar = ar; X.ai = ai;
        if (role == 1) {
#pragma unroll
            for (int nt = 0; nt < 4; ++nt) {
                const int pp = 32 * nt + c, p = pp & 63; const float crp = __shfl(cr, p), cip = __shfl(ci, p);
                const f32x4 r0 = *(const f32x4*)(P.in[I_BRE] + ((size_t)(g * 64 + p)) * 16 + 8 * hi), r1 = *(const f32x4*)(P.in[I_BRE] + ((size_t)(g * 64 + p)) * 16 + 8 * hi + 4);
                const f32x4 i0 = *(const f32x4*)(P.in[I_BIM] + ((size_t)(g * 64 + p)) * 16 + 8 * hi), i1 = *(const f32x4*)(P.in[I_BIM] + ((size_t)(g * 64 + p)) * 16 + 8 * hi + 4);
                f32x4 v0, v1;
                if (nt < 2) { v0 = crp * r0 - cip * i0; v1 = crp * r1 - cip * i1; } else { v0 = crp * i0 + cip * r0; v1 = crp * i1 + cip * r1; }
                u32x4 w; w.x = pkbf(v0[0], v0[1]); w.y = pkbf(v0[2], v0[3]); w.z = pkbf(v1[0], v1[1]); w.w = pkbf(v1[2], v1[3]);
                X.Bf[nt] = __builtin_bit_cast(bf16x8, w);
            }
#pragma unroll
            for (int s = 0; s < 4; ++s) {
                const f32x4 re = *(const f32x4*)(P.in[I_CRE] + ((size_t)(g * 16 + l16)) * 64 + 16 * s + 4 * kq), im = *(const f32x4*)(P.in[I_CIM] + ((size_t)(g * 16 + l16)) * 64 + 16 * s + 4 * kq);
                u32x4 w; w.x = pkbf(re[0], -im[0]); w.y = pkbf(re[1], -im[1]); w.z = pkbf(re[2], -im[2]); w.w = pkbf(re[3], -im[3]);
                X.Cf[s] = __builtin_bit_cast(bf16x8, w);
            }
#pragma unroll
            for (int r = 0; r < 4; ++r) X.dsk[r] = P.in[I_DSKIP][g * 16 + 4 * kq + r];
            ssm_s2(X, *(const bf16x8*)Ua);
            U1 = *(const bf16x8*)(Ua + CHS); U2 = *(const bf16x8*)(Ua + 2 * CHS);
            a0 = *(const u32x2*)Us; a1 = *(const u32x2*)(Us + 16 * 1536);
        }
    }
    if (!active) {
        for (int i = 0; i < 2 * (NCH + 1) + 1; ++i) SSM_BAR();
    } else if (role == 0) {
        float xr = 0.f, xi = 0.f; const float nai_ = -X.ai; int wsel = 0;
        for (int ch = 0; ch <= NCH; ++ch) {
            SSM_BAR();
            f32x4 re4[8], im4[8];
            if (ch < NCH) {
#pragma unroll
                for (int q = 0; q < 8; ++q) { re4[q] = *(const f32x4_ma*)(X.Bu2 + lane * 36 + 4 * q); im4[q] = *(const f32x4_ma*)(X.Bu2 + (64 + lane) * 36 + 4 * q); }
            }
            SSM_BAR();
            if (ch < NCH) {
                u32_ma* Xw = Xs0 + wsel * (32 * SSM_XS); wsel ^= 1;
#pragma unroll
                for (int q = 0; q < 8; ++q) {
#pragma unroll
                    for (int e = 0; e < 4; ++e) {
                        float t1, t2, nr, ni;
                        asm("v_fma_f32 %0, %1, %2, %3" : "=v"(t1) : "v"(nai_), "v"(xi), "v"(re4[q][e]));
                        asm("v_fma_f32 %0, %1, %2, %3" : "=v"(t2) : "v"(X.ai), "v"(xr), "v"(im4[q][e]));
                        asm("v_fma_f32 %0, %1, %2, %3" : "=v"(nr) : "v"(X.ar), "v"(xr), "v"(t1));
                        asm("v_fma_f32 %0, %1, %2, %3" : "=v"(ni) : "v"(X.ar), "v"(xi), "v"(t2));
                        xr = nr; xi = ni; Xw[(4 * q + e) * SSM_XS + lane] = pkbf(xr, xi); } }
            }
        }
        SSM_BAR();
    } else {
        const bf16r* pU = Ua + 3 * CHS; const bf16r* pS = Us + CHS; bf16r* pY = X.YG + (X.tokb + l16) * 1536 + g * 16 + 4 * kq; int rsel = 0;
#define SSM_MM(DO_S2, DO_S3, DO_LD, U_USE, U_LD, S0_USE, S1_USE, S0_LD, S1_LD) do {                                               \
            SSM_BAR(); SSM_BAR();                                                                                      \
            if (DO_LD) { U_LD = *(const bf16x8*)pU; S0_LD = *(const u32x2*)pS; S1_LD = *(const u32x2*)(pS + 16 * 1536); pU += CHS; pS += CHS; } \
            __builtin_amdgcn_sched_barrier(0);                                                                                    \
            if (DO_S2) ssm_s2(X, U_USE);                                                                                          \
            if (DO_S3) { X.Xs = Xs0 + rsel * (32 * SSM_XS); rsel ^= 1; ssm_s3(X, pY, S0_USE, S1_USE); pY += CHS; }                \
            __builtin_amdgcn_sched_barrier(0);                                                                                    \
        } while (0)
#define MM_R0(S2_, S3_, LD) SSM_MM(S2_, S3_, LD, U1, U0, c0, c1, b0, b1)
#define MM_R1(S2_, S3_, LD) SSM_MM(S2_, S3_, LD, U2, U1, a0, a1, c0, c1)
#define MM_R2(S2_, S3_, LD) SSM_MM(S2_, S3_, LD, U0, U2, b0, b1, a0, a1)
        MM_R0(true, false, true);
        _Pragma("clang loop unroll(disable)") for (int ch = 1; ch + 2 < NCH - 1; ch += 3) { MM_R1(true, true, true); MM_R2(true, true, true); MM_R0(true, true, true); }
        static_assert((NCH - 2) % 3 == 2, "steady range 1..NCH-2 = 20 triples + 2");
        MM_R1(true, true, true);
        MM_R2(true, true, true);
        MM_R0(false, true, false);
        MM_R1(false, true, false);
#undef MM_R0
#undef MM_R1
#undef MM_R2
#undef SSM_MM
        SSM_BAR();
    }
}
__device__ __forceinline__ void ssm_phase(const Params& P, unsigned char* lds, int wave, int lane) {
    const int role = (wave == 0 || wave == 2 || wave == 6) ? 0 : 1;
    const int ts = (wave == 0 || wave == 4) ? 0 : (wave == 1 || wave == 2) ? 1 : (wave == 3 || wave == 6) ? 2 : 3;
    const int G = gridDim.x, rounds = (NBATCH * NGRP + 3 * G - 1) / (3 * G);
    for (int rd = 0; rd < rounds; ++rd) {
        const int tk = (rd * G + (int)blockIdx.x) * 3 + ts; const bool active = (ts < 3) && (tk < NBATCH * NGRP);
        const int tkc = active ? tk : 0;
        ssm_round(P, active, role, tkc / NGRP, tkc % NGRP, lds + (ts < 3 ? ts : 0) * SSM_TASK_LDS, lane);
    }
}

typedef att::BlockRef<att::bf16, att::bf16> ABlk;
__device__ __forceinline__ int fox_jlo(const Params& P, int bh, int qb, char* lds) {
    const int tid = opaque_tid(), lane = tid & 63, wave = tid >> 6;
    float* red = (float*)(lds + att::LDS_BYTES);
    const float* qn = (const float*)(P.ws + SM_QNRM) + (size_t)bh * SEQL + qb * 256; const float* kn = (const float*)(P.ws + SM_KNRM) + (size_t)bh * SEQL;
    float mq = (tid < 256) ? qn[tid] : 0.f, mk = 0.f;
    for (int i = tid; i < qb * 256; i += 512) mk = fmaxf(mk, kn[i]);
#pragma unroll
    for (int o = 1; o < 64; o <<= 1) { mq = fmaxf(mq, __shfl_xor(mq, o)); mk = fmaxf(mk, __shfl_xor(mk, o)); }
    if (lane == 0) { red[wave] = mq; red[8 + wave] = mk; }
    __syncthreads();
    float Q2 = 0.f, K2 = 0.f;
#pragma unroll
    for (int w = 0; w < 8; ++w) { Q2 = fmaxf(Q2, red[w]); K2 = fmaxf(K2, red[8 + w]); }
    const float bound = 2.04f * sqrtf(Q2 * K2) * att::SCALE + 30.f;
    const float* FC = (const float*)(P.ws + SM_FCUM) + (size_t)bh * SEQL; const float c0 = FC[qb * 256];
    const bool keep = (lane >= qb * 4) || (c0 - FC[lane < 32 ? 64 * lane + 63 : 2047] >= -bound);
    const unsigned long long m = __ballot(keep);
    const int jlo = __builtin_amdgcn_readfirstlane((int)__builtin_ctzll(m));
    __syncthreads();
    return jlo;
}
__device__ __forceinline__ void fox_item(int vc, int i, int& bh, int& qb) {
    const int gq = vc >> 3, j = vc & 7, e = j * 3 + i;
    const unsigned long long T0 = 7ull | (3ull << 5) | (0ull << 10) | ((7ull | 8ull) << 15) | (4ull << 20) | ((0ull | 8ull) << 25) | ((7ull | 16ull) << 30) | (2ull << 35) | (1ull << 40) | (6ull << 45) | (5ull << 50) | ((0ull | 16ull) << 55);
    const unsigned long long T1 = (6ull | 8ull) | ((4ull | 8ull) << 5) | ((1ull | 8ull) << 10) | ((6ull | 16ull) << 15) | ((3ull | 8ull) << 20) | ((1ull | 16ull) << 25) | ((5ull | 8ull) << 30) | ((4ull | 16ull) << 35) | ((2ull | 8ull) << 40) | ((5ull | 16ull) << 45) | ((3ull | 16ull) << 50) | ((2ull | 16ull) << 55);
    const unsigned code = (unsigned)(((e < 12) ? (T0 >> (5 * e)) : (T1 >> (5 * (e - 12)))) & 31ull);
    qb = code & 7; bh = gq * 3 + (code >> 3);
}
__device__ __forceinline__ void fox_jlo3(const Params& P, int vc, char* lds) {
    const int tid = opaque_tid(), lane = tid & 63, wave = tid >> 6;
    float* red = (float*)(lds + att::LDS_BYTES);
    int bh[3], qb[3]; float mq[3], mk[3];
#pragma unroll
    for (int i = 0; i < 3; ++i) { fox_item(vc, i, bh[i], qb[i]);
        const float* qn = (const float*)(P.ws + SM_QNRM) + (size_t)bh[i] * SEQL + qb[i] * 256; const float* kn = (const float*)(P.ws + SM_KNRM) + (size_t)bh[i] * SEQL;
        mq[i] = (tid < 256) ? qn[tid] : 0.f; mk[i] = 0.f;
#pragma unroll
        for (int k = 0; k < 4; ++k) { const int idx = tid + 512 * k; if (idx < qb[i] * 256) mk[i] = fmaxf(mk[i], kn[idx]); } }
#pragma unroll
    for (int o = 1; o < 64; o <<= 1) {
#pragma unroll
        for (int i = 0; i < 3; ++i) { mq[i] = fmaxf(mq[i], __shfl_xor(mq[i], o)); mk[i] = fmaxf(mk[i], __shfl_xor(mk[i], o)); } }
    if (lane == 0) {
#pragma unroll
        for (int i = 0; i < 3; ++i) { red[32 + 16 * i + wave] = mq[i]; red[32 + 16 * i + 8 + wave] = mk[i]; } }
    __syncthreads();
#pragma unroll
    for (int i = 0; i < 3; ++i) {
        float Q2 = 0.f, K2 = 0.f;
#pragma unroll
        for (int w = 0; w < 8; ++w) { Q2 = fmaxf(Q2, red[32 + 16 * i + w]); K2 = fmaxf(K2, red[32 + 16 * i + 8 + w]); }
        const float bound = 2.04f * sqrtf(Q2 * K2) * att::SCALE + 30.f;
        const float* FC = (const float*)(P.ws + SM_FCUM) + (size_t)bh[i] * SEQL; const float c0 = FC[qb[i] * 256];
        const bool keep = (lane >= qb[i] * 4) || (c0 - FC[lane < 32 ? 64 * lane + 63 : 2047] >= -bound);
        const unsigned long long m = __ballot(keep);
        if (tid == 0) ((int*)red)[16 + i] = (int)__builtin_ctzll(m);
    }
    __syncthreads();
}
template <bool FOX, int LYR> __device__ __forceinline__ bool att_get(const Params& P, int n, ABlk& r, int& skv, char* lds) {
    constexpr int PER = FOX ? 4 : 1;
    const int G = gridDim.x, bx = blockIdx.x;
    const int slot = n / PER, i = n % PER;
    const int vb = bx + slot * G; if (vb >= 256) return false;
    const int vc = (vb & 7) * 32 + (vb >> 3);
    const att::bf16* proj = (const att::bf16*)(P.ws + WS_PROJ); att::bf16* cat = (att::bf16*)(P.ws + WS_CAT);
    if (FOX && i < 3) {
        int bh, qb; fox_item(vc, i, bh, qb); const int b = bh / 12, h = bh % 12;
        const att::bf16* kvb = (const att::bf16*)(P.ws + WS_KVB);
        r.Q = proj + ((size_t)bh * SEQL + qb * 256) * 128; r.K = kvb + (size_t)bh * SEQL * 128; r.V = kvb + (size_t)NTOK * 1536 + (size_t)bh * SEQL * 128;
        r.O = cat + ((size_t)b * SEQL + qb * 256) * 2048 + h * 128; r.G = proj + (size_t)NTOK * 1536 + ((size_t)b * SEQL + qb * 256) * 2048 + h * 128;
        r.FC = (const float*)(P.ws + SM_FCUM) + (size_t)bh * SEQL; r.P0 = qb * 256; skv = SEQL;
        r.JLO = (slot == 0) ? __builtin_amdgcn_readfirstlane(((const int*)(lds + att::LDS_BYTES))[16 + i]) : fox_jlo(P, bh, qb, lds);
    } else {
        const int b = vc >> 5, hm = (vc >> 3) & 3, qb = vc & 7;
        const att::bf16* mkv = (const att::bf16*)(P.ws + WS_MKV) + (size_t)LYR * (2 * NBATCH * NMEM * 512);
        r.Q = proj + (size_t)NTOK * 3584 + ((size_t)(b * 4 + hm) * SEQL + qb * 256) * 128;
        r.K = mkv + (size_t)(b * 4 + hm) * NMEM * 128; r.V = mkv + (size_t)NBATCH * NMEM * 512 + (size_t)(b * 4 + hm) * NMEM * 128;
        r.O = cat + ((size_t)b * SEQL + qb * 256) * 2048 + 1536 + hm * 128; r.G = proj + (size_t)NTOK * 1536 + ((size_t)b * SEQL + qb * 256) * 2048 + 1536 + hm * 128;
        r.FC = nullptr; r.P0 = 256; skv = NMEM; r.JLO = 0;
    }
    return true;
}
template <bool FOX, int LYR> __device__ __forceinline__ void att_phase(const Params& P, char* lds) {
    ABlk cur, nxt; int skv = 0, skvn = 0;
    if (FOX && (int)blockIdx.x < 256) { const int vb = blockIdx.x; fox_jlo3(P, (vb & 7) * 32 + (vb >> 3), lds); }
    if (!att_get<FOX, LYR>(P, 0, cur, skv, lds)) return;
    att::Seam<att::bf16> S;
    att::causal_swa_prime<att::bf16, att::bf16>(cur, 1 << 20, lds, S);
    for (int n = 0;; ++n) {
        const bool more = att_get<FOX, LYR>(P, n + 1, nxt, skvn, lds);
        if (!more) { nxt = cur; skvn = skv; }
        att::causal_swa_block<att::bf16, att::bf16>(cur, nxt, skv, 1 << 20, lds, S);
        if (!more) break;
        cur = nxt; skv = skvn;
    }
}

#define XB_TMO      128
#define XB_XCNT(j)  (256  + 64 * (j))
#define XB_XSUB(j)  (1280 + 64 * (j))
#define XB_XGEN(j)  (2304 + 64 * (j))
#define XB_TOP      3328
#define XB_TOPGEN   3392
#define XCD_BAR_WORDS 3456
#define XB_SPIN_CAP (1u << 18)

__device__ __forceinline__ unsigned xb_ld(unsigned* p)              { return __hip_atomic_load(p, __ATOMIC_RELAXED, __HIP_MEMORY_SCOPE_AGENT); }
__device__ __forceinline__ unsigned xb_add(unsigned* p, unsigned v) { return __hip_atomic_fetch_add(p, v, __ATOMIC_RELAXED, __HIP_MEMORY_SCOPE_AGENT); }
__device__ __forceinline__ unsigned xb_xcc_id() { return (unsigned)__builtin_amdgcn_s_getreg((3 << 11) | 20) & 0xFu; }
#define XB_SPIN(cond, bar) do { unsigned _sp = 0; while (cond) { __builtin_amdgcn_s_sleep(1); \
    if ((++_sp & 255u) == 0u) { if (xb_ld(&(bar)[XB_TMO])) break; if (_sp > XB_SPIN_CAP) { atomicAdd(&(bar)[XB_TMO], 1u); break; } } } } while (0)

struct XcdBarrier {
    unsigned* bar; unsigned x;
    volatile LAS unsigned* st;
};

__device__ __forceinline__ XcdBarrier xcd_barrier_post(unsigned* bar, volatile LAS unsigned* st) {
    XcdBarrier b; b.bar = bar; b.x = xb_xcc_id(); b.st = st;
    if (threadIdx.x == 0) (void)xb_add(&bar[XB_XCNT(b.x)], 1u);
    return b;
}
__device__ __forceinline__ void xcd_barrier_complete(unsigned* bar, unsigned x, unsigned& nloc, unsigned& nx) {
    const unsigned G = gridDim.x * gridDim.y * gridDim.z;
    unsigned sum, cnt, mine, sp = 0u;
    for (;;) {
        sum = 0u; cnt = 0u; mine = 0u;
#pragma unroll
        for (unsigned j = 0; j < 16; ++j) { const unsigned c = xb_ld(&bar[XB_XCNT(j)]); sum += c; cnt += (c > 0u) ? 1u : 0u; mine = (j == x) ? c : mine; }
        if (sum == G) break;
        __builtin_amdgcn_s_sleep(1);
        if ((++sp & 255u) == 0u) { if (xb_ld(&bar[XB_TMO])) break; if (sp > XB_SPIN_CAP) { atomicAdd(&bar[XB_TMO], 1u); break; } }
    }
    nloc = mine > 0u ? mine : 1u; nx = cnt > 0u ? cnt : 1u;
}

__device__ __forceinline__ void xcd_barrier(const XcdBarrier& b) {
    asm volatile("s_waitcnt vmcnt(0)" ::: "memory");
    __syncthreads();
    if (threadIdx.x == 0) {
        unsigned* bar = b.bar;
        __builtin_amdgcn_s_waitcnt(0);
        unsigned nloc = b.st[0], nx = b.st[1];
        if (nloc == 0u) { xcd_barrier_complete(bar, b.x, nloc, nx); b.st[0] = nloc; b.st[1] = nx; }
        const unsigned old = xb_add(&bar[XB_XSUB(b.x)], 1u);
        const unsigned gen = old / nloc;
        if (old + 1u == (gen + 1u) * nloc) {
            __builtin_amdgcn_fence(__ATOMIC_RELEASE, "agent");
            asm volatile("s_waitcnt vmcnt(0)" ::: "memory");
            const unsigned og = xb_add(&bar[XB_TOP], 1u);
            const unsigned tg = og / nx;
            if (og + 1u == (tg + 1u) * nx) xb_add(&bar[XB_TOPGEN], 1u);
            else XB_SPIN(xb_ld(&bar[XB_TOPGEN]) == tg, bar);
            __builtin_amdgcn_fence(__ATOMIC_ACQUIRE, "agent");
            xb_add(&bar[XB_XGEN(b.x)], 1u);
            asm volatile("s_waitcnt vmcnt(0)" ::: "memory");
        } else {
            XB_SPIN(xb_ld(&bar[XB_XGEN(b.x)]) == gen, bar);
            __builtin_amdgcn_fence(__ATOMIC_ACQUIRE, "agent");
            asm volatile("s_waitcnt vmcnt(0)" ::: "memory");
        }
    }
    __syncthreads();
}

#ifndef PH_MASK
#define PH_MASK 0x7ff
#endif
#define PH(k) if constexpr ((PH_MASK >> (k)) & 1)
#ifndef REP_MASK
#define REP_MASK 0
#endif
#define REP(k) for (int rep_ = 0; rep_ <= ((REP_MASK >> (k)) & 1); ++rep_)
__global__ void __launch_bounds__(512, 2) yoco_fwd(Params P) {
    extern __shared__ __attribute__((aligned(16))) unsigned char lds[];
    cg::grid_group grid = cg::this_grid();
    volatile LAS unsigned* bst = (volatile LAS unsigned*)((LAS unsigned char*)lds + (LDS_TOTAL - 64));
    if (threadIdx.x == 0) { bst[0] = 0u; bst[1] = 0u; }
    __syncthreads();
    const XcdBarrier xbar = xcd_barrier_post((unsigned*)(P.ws + WS_BAR), bst);
#define GRID_SYNC() xcd_barrier(xbar)
    const int G = gridDim.x, NGW = G * 8;
#define PHASE_IDS() const int tid = opaque_tid(), lane = tid & 63, wave = __builtin_amdgcn_readfirstlane(tid >> 6), gw = blockIdx.x * 8 + wave; (void)lane; (void)gw
    unsigned char* ws = P.ws;
    float* rstd0 = (float*)(ws + SM_RSTD0); float* rstdm = (float*)(ws + SM_RSTDM); float* rowsq0 = (float*)(ws + SM_ROWSQ0); float* rowsq1 = (float*)(ws + SM_ROWSQ1);
    float* rstd1 = (float*)(ws + SM_RSTD1); float* logf_ = (float*)(ws + SM_LOGF); float* fcum = (float*)(ws + SM_FCUM); float* wft = (float*)(ws + SM_WFT);
    bf16r* xb = (bf16r*)(ws + WS_XB); bf16r* memb = (bf16r*)(ws + WS_MEMB); bf16r* proj = (bf16r*)(ws + WS_PROJ); bf16r* kvb = (bf16r*)(ws + WS_KVB);
    bf16r* cat = (bf16r*)(ws + WS_CAT); bf16r* ob = (bf16r*)(ws + WS_OB); bf16r* mkv = (bf16r*)(ws + WS_MKV);
    LAS unsigned char* glds = (LAS unsigned char*)lds;

    REP(0) {
    PH(0) { PHASE_IDS();
        LAS float* scr = (LAS float*)((LAS unsigned char*)lds + wave * 16384);
        constexpr int I_A = 32 * 128, I_GLU = 24 * 48, I_MK = 32 * 32, I_O = 32 * 64;
        constexpr int NIT = I_A + I_GLU + 2 * I_MK + I_O;
        for (int it = gw; it < NIT; it += NGW) {
            int r = it;
            if (r < I_A) { transpose_item(P.in[I_WINA], P.in[I_PREG], 2048, 4096, (bf16r*)(ws + WS_WINA), 0, scr, r, lane); continue; } r -= I_A;
            if (r < I_GLU) { transpose_item(P.in[I_WGLU], nullptr, 1536, 1536, (bf16r*)(ws + WS_WGLU), 0, scr, r, lane); continue; } r -= I_GLU;
            if (r < I_MK) { transpose_item(P.in[I_WMKV], P.in[I_MEMG], 2048, 1024, (bf16r*)(ws + WS_WMKV0), 0, scr, r, lane); continue; } r -= I_MK;
            if (r < I_MK) { transpose_item(P.in[I_WMKV] + (size_t)2048 * 1024, P.in[I_MEMG] + 2048, 2048, 1024, (bf16r*)(ws + WS_WMKV1), 0, scr, r, lane); continue; } r -= I_MK;
            transpose_item(P.in[I_WOUT], nullptr, 2048, 2048, (bf16r*)(ws + WS_WOUT0), 0, scr, r, lane);
        }
        rows_to_bf16(P.in[I_X], xb, rstd0, gw, NGW, NTOK, lane);
        rows_to_bf16(P.in[I_MEM], memb, rstdm, gw, NGW, NBATCH * NMEM, lane);
        for (int i = blockIdx.x * 512 + tid; i < NTOK; i += G * 512) { rowsq0[i] = 0.f; rowsq1[i] = 0.f; }
        for (int i = blockIdx.x * 512 + tid; i < 2 * 96 * SEQL; i += G * 512) ((float*)(ws + SM_QNRM))[i] = 0.f;
        for (int i = blockIdx.x * 512 + tid; i < 12 * DM; i += G * 512) { const int h = i / DM, k = i % DM; wft[i] = P.in[I_KVG][k] * P.in[I_WFG][k * 12 + h]; }
    }
    if (P.ws == nullptr) grid.sync();
    GRID_SYNC();
    }
    REP(1) {
    PH(1) {
        { pg8::Gemm g{xb, (const bf16r*)(ws + WS_WINA), NTOK, 4096, DM}; pg8::StaticOrder S; S.init(NTOK, 4096, G, (int)blockIdx.x);
          pg8::EpiProj<Sel0> E{rstd0, Sel0{proj}, 11};
          pg8::gemm_phase<pg8::EpiProj<Sel0>, pg8::StaticOrder, true, true>(glds, g, S, E); }
    }
    GRID_SYNC();
    }
    REP(2) {
    PH(2) { PHASE_IDS(); ssm_phase(P, lds, wave, lane);
    __syncthreads(); }
    GRID_SYNC();
    }
    REP(3) {
    PH(3) {
        { pg8::Gemm g{kvb  , (const bf16r*)(ws + WS_WGLU), NTOK, 1536, 1536}; pg8::StaticOrder S; S.init(NTOK, 1536, G, (int)blockIdx.x);
          pg8::EpiGlu E{kvb, proj + (size_t)NTOK * 1536, P.in[I_BGLU], cat};
          pg8::gemm_phase<pg8::EpiGlu, pg8::StaticOrder, true, true>(glds, g, S, E); }
        { pg8::Gemm g{memb, (const bf16r*)(ws + WS_WMKV0), NBATCH * NMEM, 1024, DM}; pg8::StaticOrder S; S.init(NBATCH * NMEM, 1024, G, (int)((blockIdx.x + G - G / 2) % G));
          pg8::EpiProj<SelM> E{rstdm, SelM{mkv}, 8};
          pg8::gemm_phase<pg8::EpiProj<SelM>, pg8::StaticOrder, true, true>(glds, g, S, E); }
        { pg8::Gemm g{memb, (const bf16r*)(ws + WS_WMKV1), NBATCH * NMEM, 1024, DM}; pg8::StaticOrder S; S.init(NBATCH * NMEM, 1024, G, (int)((blockIdx.x + G - G / 2 - 32) % G));
          pg8::EpiProj<SelM> E{rstdm, SelM{mkv + (size_t)2 * NBATCH * NMEM * 512}, 8};
          pg8::gemm_phase<pg8::EpiProj<SelM>, pg8::StaticOrder, true, true>(glds, g, S, E); }
        if ((int)blockIdx.x >= G - G / 4) {
            PHASE_IDS();
            LAS float* scr = (LAS float*)((LAS unsigned char*)lds + wave * 16384);
            constexpr int I_B = 32 * 128, I_KV = 32 * 96, I_O = 32 * 64, NIT2 = I_B + I_KV + I_O;
            const int gw2 = ((int)blockIdx.x - (G - G / 4)) * 8 + wave, NGW2 = (G / 4) * 8;
            for (int it = gw2; it < NIT2; it += NGW2) {
                int r = it;
                if (r < I_B) { transpose_item(P.in[I_WINB], P.in[I_PREG] + 2048, 2048, 4096, (bf16r*)(ws + WS_WKVB), 3072, scr, r, lane); continue; } r -= I_B;
                if (r < I_KV) { transpose_item(P.in[I_WKV], P.in[I_KVG], 2048, 3072, (bf16r*)(ws + WS_WKVB), 0, scr, r, lane); continue; } r -= I_KV;
                transpose_item(P.in[I_WOUT] + (size_t)2048 * 2048, nullptr, 2048, 2048, (bf16r*)(ws + WS_WOUT1), 0, scr, r, lane);
            }
        }
    }
    GRID_SYNC();
    }
    REP(10) {
    PH(10) att_phase<false, 0>(P, (char*)lds);
    GRID_SYNC();
    }
    REP(4) {
    PH(4) { pg8::Gemm g{cat, (const bf16r*)(ws + WS_WOUT0), NTOK, DM, DM}; pg8::StaticOrder S; S.init(NTOK, DM, G, (int)blockIdx.x);
      pg8::EpiOut E{ob, rep_ ? rowsq0 + 65536 * 9 : rowsq0};
      pg8::gemm_phase<pg8::EpiOut, pg8::StaticOrder, true, true>(glds, g, S, E); }
    GRID_SYNC();
    }
    REP(5) {
    PH(5) { PHASE_IDS();
        float* wl = (float*)lds;
        for (int i = tid; i < 12 * DM / 4; i += 512) ((f32x4*)wl)[i] = ((const f32x4*)wft)[i];
        __syncthreads();
        const float* gp = P.in[I_POSTG];
        f32x4 gv[8];
#pragma unroll
        for (int j = 0; j < 8; ++j) gv[j] = ((const f32x4*)gp)[lane + 64 * j];
        const float bfg = (lane < 12) ? P.in[I_BFG][lane] : 0.f;
        u32x2 xv[8]; u32x2 ov[8]; float rq = 0.f;
        if (gw < NTOK) { const u32x2* xp = (const u32x2*)(xb + (size_t)gw * DM) + lane; const u32x2* op = (const u32x2*)(ob + (size_t)gw * DM) + lane; rq = rowsq0[gw];
#pragma unroll
            for (int j = 0; j < 8; ++j) { xv[j] = xp[64 * j]; ov[j] = op[64 * j]; } }
        for (int m = gw; m < NTOK; m += NGW) {
            const float rso = 1.0f / sqrtf(rq * (1.0f / DM) + EPSN);
            u32x2 xn[8]; u32x2 on[8]; float rqn = 0.f; const int mn = m + NGW;
            if (mn < NTOK) { const u32x2* xp = (const u32x2*)(xb + (size_t)mn * DM) + lane; const u32x2* op = (const u32x2*)(ob + (size_t)mn * DM) + lane; rqn = rowsq0[mn];
#pragma unroll
                for (int j = 0; j < 8; ++j) { xn[j] = xp[64 * j]; on[j] = op[64 * j]; } }
            u32x2* hb = (u32x2*)(xb + (size_t)m * DM) + lane;
            f32x4 hv[8]; float s = 0.f;
#pragma unroll
            for (int j = 0; j < 8; ++j) {
                f32x4 h; h[0] = pg8::bf_lo(xv[j].x) + pg8::bf_lo(ov[j].x) * rso * gv[j][0]; h[1] = pg8::bf_hi(xv[j].x) + pg8::bf_hi(ov[j].x) * rso * gv[j][1];
                h[2] = pg8::bf_lo(xv[j].y) + pg8::bf_lo(ov[j].y) * rso * gv[j][2]; h[3] = pg8::bf_hi(xv[j].y) + pg8::bf_hi(ov[j].y) * rso * gv[j][3];
                hv[j] = h; s += (h[0] * h[0] + h[1] * h[1]) + (h[2] * h[2] + h[3] * h[3]);
                u32x2 w; w.x = pkbf(h[0], h[1]); w.y = pkbf(h[2], h[3]); hb[64 * j] = w; }
            if (mn < NTOK) {
#pragma unroll
                for (int j = 0; j < 8; ++j) { xv[j] = xn[j]; ov[j] = on[j]; } rq = rqn; }
            s = wave_sum(s); const float rs1 = 1.0f / sqrtf(s * (1.0f / DM) + EPSN);
            if (lane == 0) rstd1[m] = rs1;
            float dh[12];
#pragma unroll
            for (int h = 0; h < 12; ++h) {
                f32x4 wa[8];
#pragma unroll
                for (int j = 0; j < 8; ++j) wa[j] = *(const f32x4*)(wl + h * DM + (lane + 64 * j) * 4);
                __builtin_amdgcn_sched_barrier(0);
                float da = 0.f;
#pragma unroll
                for (int j = 0; j < 8; ++j) da += (hv[j][0] * wa[j][0] + hv[j][1] * wa[j][1]) + (hv[j][2] * wa[j][2] + hv[j][3] * wa[j][3]);
                dh[h] = da;
                __builtin_amdgcn_sched_barrier(0);
            }
#pragma unroll
            for (int o = 1; o < 64; o <<= 1) {
#pragma unroll
                for (int h = 0; h < 12; ++h) dh[h] += __shfl_xor(dh[h], o); }
            float mine = 0.f;
#pragma unroll
            for (int h = 0; h < 12; ++h) if (lane == h) mine = dh[h];
            if (lane < 12) { const float a = mine * rs1 + bfg; const float lf = fminf(a, 0.f) - __logf(1.f + __expf(-fabsf(a)));
                const int b = m >> 11, sidx = m & 2047; logf_[((size_t)(b * 12 + lane)) * SEQL + sidx] = lf; }
        }
    }
    GRID_SYNC();
    }
    REP(6) {
    PH(6) { PHASE_IDS();
        if (wave == 0) for (int rwi = blockIdx.x; rwi < NBATCH * 12; rwi += G) {
            const float* src = logf_ + (size_t)rwi * SEQL + lane * 32; float* dst = fcum + (size_t)rwi * SEQL + lane * 32;
            float v[32]; float run = 0.f;
#pragma unroll
            for (int q = 0; q < 8; ++q) { const f32x4 t = ((const f32x4*)src)[q]; v[4 * q] = t[0]; v[4 * q + 1] = t[1]; v[4 * q + 2] = t[2]; v[4 * q + 3] = t[3]; }
#pragma unroll
            for (int e = 0; e < 32; ++e) { run += v[e]; v[e] = run; }
            float incl = run;
#pragma unroll
            for (int o = 1; o < 64; o <<= 1) { const float t = __shfl_up(incl, o); if (lane >= o) incl += t; }
            const float excl = incl - run;
#pragma unroll
            for (int q = 0; q < 8; ++q) { f32x4 t = {v[4 * q] + excl, v[4 * q + 1] + excl, v[4 * q + 2] + excl, v[4 * q + 3] + excl}; ((f32x4*)dst)[q] = t; }
        }
        pg8::Gemm g{xb, (const bf16r*)(ws + WS_WKVB), NTOK, 7168, DM}; pg8::StaticOrder S; S.init(NTOK, 7168, G, (int)blockIdx.x);
        pg8::EpiProj<Sel1> E{rstd1, Sel1{kvb, proj, (float*)(ws + SM_QNRM), (float*)(ws + SM_KNRM)}, 11};
        pg8::gemm_phase<pg8::EpiProj<Sel1>, pg8::StaticOrder, true, true>(glds, g, S, E);
    }
    GRID_SYNC();
    }
    REP(7) {
    PH(7) att_phase<true, 1>(P, (char*)lds);
    GRID_SYNC();
    }
    REP(8) {
    PH(8) { pg8::Gemm g{cat, (const bf16r*)(ws + WS_WOUT1), NTOK, DM, DM}; pg8::StaticOrder S; S.init(NTOK, DM, G, (int)blockIdx.x);
      pg8::EpiOut E{ob, rep_ ? rowsq0 + 65536 * 9 : rowsq1};
      pg8::gemm_phase<pg8::EpiOut, pg8::StaticOrder, true, true>(glds, g, S, E); }
    GRID_SYNC();
    }
    REP(9) {
    PH(9) { PHASE_IDS();
        const float* gp = P.in[I_POSTG] + DM;
        f32x4 gv[8];
#pragma unroll
        for (int j = 0; j < 8; ++j) gv[j] = ((const f32x4*)gp)[lane + 64 * j];
        u32x2 hv[8]; u32x2 ov[8]; float rq = 0.f;
        if (gw < NTOK) { const u32x2* hp = (const u32x2*)(xb + (size_t)gw * DM) + lane; const u32x2* op = (const u32x2*)(ob + (size_t)gw * DM) + lane; rq = rowsq1[gw];
#pragma unroll
            for (int j = 0; j < 8; ++j) { hv[j] = hp[64 * j]; ov[j] = op[64 * j]; } }
        for (int m = gw; m < NTOK; m += NGW) {
            const float rso = 1.0f / sqrtf(rq * (1.0f / DM) + EPSN);
            u32x2 hn[8]; u32x2 on[8]; float rqn = 0.f; const int mn = m + NGW;
            if (mn < NTOK) { const u32x2* hp2 = (const u32x2*)(xb + (size_t)mn * DM) + lane; const u32x2* op = (const u32x2*)(ob + (size_t)mn * DM) + lane; rqn = rowsq1[mn];
#pragma unroll
                for (int j = 0; j < 8; ++j) { hn[j] = hp2[64 * j]; on[j] = op[64 * j]; } }
            f32x4* hp = (f32x4*)(P.out + (size_t)m * DM) + lane;
#pragma unroll
            for (int j = 0; j < 8; ++j) { f32x4 h;
                h[0] = pg8::bf_lo(hv[j].x) + pg8::bf_lo(ov[j].x) * rso * gv[j][0]; h[1] = pg8::bf_hi(hv[j].x) + pg8::bf_hi(ov[j].x) * rso * gv[j][1];
                h[2] = pg8::bf_lo(hv[j].y) + pg8::bf_lo(ov[j].y) * rso * gv[j][2]; h[3] = pg8::bf_hi(hv[j].y) + pg8::bf_hi(ov[j].y) * rso * gv[j][3];
                __builtin_nontemporal_store(h, hp + 64 * j); }
            if (mn < NTOK) {
#pragma unroll
                for (int j = 0; j < 8; ++j) { hv[j] = hn[j]; ov[j] = on[j]; } rq = rqn; }
        }
    }
    }
}

extern "C" void kernel_launch(void* const* d_in, const int* in_sizes, int n_in, void* d_out, int out_size, void* d_ws, size_t ws_size, hipStream_t stream) {
    static int grid = 0;
    if (grid == 0) {
        if (n_in != 23 || out_size != NTOK * DM || ws_size < WS_END) { fprintf(stderr, "kernel_launch: unexpected shapes: n_in %d out %d ws %zu (need %zu)\n", n_in, out_size, ws_size, (size_t)WS_END); grid = -1; return; }
        int dev = 0, cus = 0, per_cu = 0;
        (void)hipGetDevice(&dev); (void)hipDeviceGetAttribute(&cus, hipDeviceAttributeMultiprocessorCount, dev);
        if (hipFuncSetAttribute((const void*)yoco_fwd, hipFuncAttributeMaxDynamicSharedMemorySize, LDS_TOTAL) != hipSuccess) { fprintf(stderr, "kernel_launch: hipFuncSetAttribute failed\n"); grid = -1; return; }
        if (hipOccupancyMaxActiveBlocksPerMultiprocessor(&per_cu, (const void*)yoco_fwd, 512, LDS_TOTAL) != hipSuccess || per_cu < 1) { fprintf(stderr, "kernel_launch: occupancy query says %d\n", per_cu); per_cu = 1; }
        (void)hipGetLastError();
        grid = cus * (per_cu > 1 ? 1 : per_cu);
        if (grid <= 0) grid = 256;
    }
    if (grid < 0) return;
    if (hipMemsetAsync((char*)d_ws + WS_BAR, 0, 16384, stream) != hipSuccess) { fprintf(stderr, "kernel_launch: hipMemsetAsync failed\n"); return; }
    Params p{};
    for (int i = 0; i < 23; ++i) p.in[i] = (const float*)d_in[i];
    p.out = (float*)d_out; p.ws = (unsigned char*)d_ws;
    void* args[] = {&p};
    hipError_t e = hipLaunchCooperativeKernel((const void*)yoco_fwd, dim3(grid), dim3(512), args, LDS_TOTAL, stream);
    if (e != hipSuccess) fprintf(stderr, "cooperative launch failed: %s (grid %d)\n", hipGetErrorString(e), grid);
}
```

```cpp
#include <hip/hip_runtime.h>
#include <hip/hip_bf16.h>
#include <hip/hip_cooperative_groups.h>
#include <cstdio>
#include <cstdint>
namespace cg = cooperative_groups;
__device__ __forceinline__ int opaque_tid() { int t = threadIdx.x; asm volatile("" : "+v"(t)); return t; }
namespace pg8 {
#define PG8_LAS __attribute__((address_space(3)))
typedef unsigned short bf16_t;
typedef short bf16x8 __attribute__((ext_vector_type(8)));
typedef float f32x4 __attribute__((ext_vector_type(4)));
typedef unsigned u32x4 __attribute__((ext_vector_type(4)));
constexpr int BM = 256, BK = 64, HALF = 128, HTB = HALF * BK * 2  , STAGE_BYTES = 8 * HTB, NXCD = 8, WGM = 8;

__host__ __device__ __forceinline__ int lds_byte(int r, int c) { const int st = (r >> 4) * 2 + (c >> 5), rr = r & 15, cc = c & 31, ob = rr * 64 + cc * 2; return st * 1024 + (ob ^ (((ob >> 9) & 1) << 5)); }
__host__ __device__ __forceinline__ void stage_rc(int b, int& R, int& C) { const int st = b / 1024, sb = b % 1024, swz = sb ^ (((sb >> 9) & 1) << 5); R = (st >> 1) * 16 + swz / 64; C = (st & 1) * 32 + (swz % 64) / 2; }
__host__ __device__ __forceinline__ int perm32(int rho) { const int n = rho >> 4, i = rho & 15; return 8 * (i >> 2) + 4 * n + (i & 3); }

struct Unit { int pm, pn; };
struct Gemm { const bf16_t* A; const bf16_t* Bt; int M, N, K; };

struct StaticOrder {
    int nM, nN, nwg, G, c;
    __host__ __device__ void init(int M, int N, int G_, int c_) { nM = M / BM; nN = N / BM; nwg = nM * nN; G = G_; c = c_; }
    __host__ __device__ bool next(int i, Unit& u) const {
        const long L = (long)i * G + c; if (L >= nwg) return false;
        int wgid = (int)L; { const int q = nwg / NXCD, r = nwg % NXCD, xcd = wgid % NXCD, off = wgid / NXCD; wgid = (xcd < r ? xcd * (q + 1) : r * (q + 1) + (xcd - r) * q) + off; }
        const int nig = WGM * nN, gid = wgid / nig, fm = gid * WGM, gsz = (nM - fm) < WGM ? (nM - fm) : WGM;
        u.pm = fm + ((wgid % nig) % gsz); u.pn = (wgid % nig) / gsz; return true;
    }
    __device__ __forceinline__ void a_ready(const Unit&) const {}
    __device__ __forceinline__ void done(const Unit&) const {}
};

__device__ __forceinline__ unsigned cvt_pk_bf16(float lo, float hi) { unsigned r; asm volatile("v_cvt_pk_bf16_f32 %0, %1, %2" : "=v"(r) : "v"(lo), "v"(hi)); return r; }
__device__ __forceinline__ float sigmoid_f(float v) { return __builtin_amdgcn_rcpf(1.f + __builtin_amdgcn_exp2f(-1.4426950408889634f * v)); }
__device__ __forceinline__ float silu_f(float v) { return v * sigmoid_f(v); }
__device__ __forceinline__ float bf_lo(unsigned w) { return __uint_as_float(w << 16); }
__device__ __forceinline__ float bf_hi(unsigned w) { return __uint_as_float(w & 0xffff0000u); }

__device__ __forceinline__ float xfq_sum(float v) {
    { auto r = __builtin_amdgcn_permlane16_swap(__float_as_uint(v), __float_as_uint(v), false, false); v = __uint_as_float(r[0]) + __uint_as_float(r[1]); }
    { auto r = __builtin_amdgcn_permlane32_swap(__float_as_uint(v), __float_as_uint(v), false, false); v = __uint_as_float(r[0]) + __uint_as_float(r[1]); }
    return v;
}
struct SecInfo { bf16_t* dst; int start; int ld; int nh; int act; float* nrm; };
template <class Sel> struct EpiProj {
    static constexpr bool PERM = true, AFTER_DRAIN = false;
    const float* rstd; Sel sel; int lgS;
    __device__ __forceinline__ void operator()(const f32x4 (&acc)[2][2][4][2], const Unit& u, int wr, int wc, int fr, int fq) const {
        const int row0 = u.pm * BM + wr * 64 + fr, cin = wc * 32 + 8 * fq;
        float rsv[2][4];
#pragma unroll
        for (int ai = 0; ai < 2; ++ai)
#pragma unroll
            for (int m = 0; m < 4; ++m) rsv[ai][m] = rstd[row0 + ai * HALF + m * 16];
#pragma unroll
        for (int bj = 0; bj < 2; ++bj) {
            const int cs = u.pn * BM + bj * HALF; const SecInfo si = sel(cs);
#pragma unroll
            for (int ai = 0; ai < 2; ++ai)
#pragma unroll
                for (int m = 0; m < 4; ++m) {
                    const int row = row0 + ai * HALF + m * 16; const float rs = rsv[ai][m];
                    f32x4 v0 = acc[ai][bj][m][0] * rs, v1 = acc[ai][bj][m][1] * rs;
                    if (si.act) {
#pragma unroll
                        for (int e = 0; e < 4; ++e) { v0[e] = silu_f(v0[e]); v1[e] = silu_f(v1[e]); } }
                    bf16_t* p;
                    if (si.nh) { const int b = row >> lgS, s = row & ((1 << lgS) - 1); const size_t hr = (((size_t)(b * si.nh + ((cs - si.start) >> 7))) << lgS) + s; p = si.dst + hr * 128 + cin;
                        if (si.nrm) { float q = (v0[0] * v0[0] + v0[1] * v0[1]) + (v0[2] * v0[2] + v0[3] * v0[3]) + (v1[0] * v1[0] + v1[1] * v1[1]) + (v1[2] * v1[2] + v1[3] * v1[3]);
                            q = xfq_sum(q); if (fq == 0) atomicAdd(si.nrm + hr, q); } }
                    else p = si.dst + (size_t)row * si.ld + (cs - si.start) + cin;
                    u32x4 w; w.x = cvt_pk_bf16(v0[0], v0[1]); w.y = cvt_pk_bf16(v0[2], v0[3]); w.z = cvt_pk_bf16(v1[0], v1[1]); w.w = cvt_pk_bf16(v1[2], v1[3]);
                    *(u32x4*)p = w;
                }
        }
    }
};
struct EpiGlu {
    static constexpr bool PERM = true, AFTER_DRAIN = false;
    const bf16_t* yg; const bf16_t* sz; const float* bias; bf16_t* cat;
    __device__ __forceinline__ void operator()(const f32x4 (&acc)[2][2][4][2], const Unit& u, int wr, int wc, int fr, int fq) const {
        const int row0 = u.pm * BM + wr * 64 + fr, col0 = u.pn * BM + wc * 32 + 8 * fq;
#pragma unroll
        for (int bj = 0; bj < 2; ++bj) {
            const int col = col0 + bj * HALF; const f32x4 b0 = *(const f32x4*)(bias + col), b1 = *(const f32x4*)(bias + col + 4);
#pragma unroll
            for (int ai = 0; ai < 2; ++ai) {
                u32x4 yv[4], zv[4];
#pragma unroll
                for (int m = 0; m < 4; ++m) { const int row = row0 + ai * HALF + m * 16;
                    yv[m] = __builtin_nontemporal_load((const u32x4*)(yg + (size_t)row * 1536 + col)); zv[m] = __builtin_nontemporal_load((const u32x4*)(sz + (size_t)row * 2048 + col)); }
#pragma unroll
                for (int m = 0; m < 4; ++m) {
                    const int row = row0 + ai * HALF + m * 16;
                    const u32x4 y = yv[m], z = zv[m];
                    const f32x4 g0 = acc[ai][bj][m][0] + b0, g1 = acc[ai][bj][m][1] + b1;
                    float o[8];
                    o[0] = bf_lo(y.x) * bf_lo(z.x) * sigmoid_f(g0[0]); o[1] = bf_hi(y.x) * bf_hi(z.x) * sigmoid_f(g0[1]);
                    o[2] = bf_lo(y.y) * bf_lo(z.y) * sigmoid_f(g0[2]); o[3] = bf_hi(y.y) * bf_hi(z.y) * sigmoid_f(g0[3]);
                    o[4] = bf_lo(y.z) * bf_lo(z.z) * sigmoid_f(g1[0]); o[5] = bf_hi(y.z) * bf_hi(z.z) * sigmoid_f(g1[1]);
                    o[6] = bf_lo(y.w) * bf_lo(z.w) * sigmoid_f(g1[2]); o[7] = bf_hi(y.w) * bf_hi(z.w) * sigmoid_f(g1[3]);
                    u32x4 w; w.x = cvt_pk_bf16(o[0], o[1]); w.y = cvt_pk_bf16(o[2], o[3]); w.z = cvt_pk_bf16(o[4], o[5]); w.w = cvt_pk_bf16(o[6], o[7]);
                    *(u32x4*)(cat + (size_t)row * 2048 + col) = w;
                }
            }
        }
    }
};
struct EpiOut {
    static constexpr bool PERM = true, AFTER_DRAIN = false;
    bf16_t* o; float* rowsq;
    __device__ __forceinline__ void operator()(const f32x4 (&acc)[2][2][4][2], const Unit& u, int wr, int wc, int fr, int fq) const {
        const int row0 = u.pm * BM + wr * 64 + fr, col0 = u.pn * BM + wc * 32 + 8 * fq;
#pragma unroll
        for (int ai = 0; ai < 2; ++ai)
#pragma unroll
            for (int m = 0; m < 4; ++m) {
                const int row = row0 + ai * HALF + m * 16; float s = 0.f;
#pragma unroll
                for (int bj = 0; bj < 2; ++bj) {
                    const f32x4 v0 = acc[ai][bj][m][0], v1 = acc[ai][bj][m][1];
                    s += (v0[0] * v0[0] + v0[1] * v0[1]) + (v0[2] * v0[2] + v0[3] * v0[3]) + (v1[0] * v1[0] + v1[1] * v1[1]) + (v1[2] * v1[2] + v1[3] * v1[3]);
                    u32x4 w; w.x = cvt_pk_bf16(v0[0], v0[1]); w.y = cvt_pk_bf16(v0[2], v0[3]); w.z = cvt_pk_bf16(v1[0], v1[1]); w.w = cvt_pk_bf16(v1[2], v1[3]);
                    *(u32x4*)(o + (size_t)row * 2048 + col0 + bj * HALF) = w;
                }
                s = xfq_sum(s);
                if (fq == 0) atomicAdd(rowsq + row, s);
            }
    }
};

template <class Epi, class Sched, bool ALIGN_EPI = false, bool SP2 = false>
__device__ __forceinline__ void gemm_phase(PG8_LAS unsigned char* lds, const Gemm g, const Sched& S, const Epi& E) {
    const int tid = opaque_tid(), wid = __builtin_amdgcn_readfirstlane(tid >> 6), lane = tid & 63, wr = wid >> 2, wc = wid & 3, fr = lane & 15, fq = lane >> 4;
    const int K = g.K, nt = K / BK;
    unsigned voffA[2], voffB[2];
#pragma unroll
    for (int i = 0; i < 2; ++i) { int R, C; stage_rc(tid * 16 + i * 8192, R, C); const int Rb = Epi::PERM ? ((R & ~31) + perm32(R & 31)) : R;
        voffA[i] = (unsigned)(R * K + C) * 2u; voffB[i] = (unsigned)(Rb * K + C) * 2u; }
    const size_t kstep = (size_t)(BK * 2);
    const size_t hstep = (size_t)HALF * K * 2;
    const size_t tstep = 2 * hstep;
    const unsigned ldsw = (unsigned)wid * 1024u;
    const int aoff = lds_byte(wr * 64 + fr, fq * 8), boff = lds_byte(wc * 32 + fr, fq * 8);
#define PG8_SA(b, h) (((b) * 2 + (h)) * HTB)
#define PG8_SB(b, h) ((4 + (b) * 2 + (h)) * HTB)
#define PG8_STAGE(bufoff, gbase, voff) do { _Pragma("unroll") for (int _i = 0; _i < 2; ++_i) \
        __builtin_amdgcn_global_load_lds((const unsigned*)((const char*)(gbase) + (voff)[_i]), (PG8_LAS unsigned*)(lds + (bufoff) + ldsw + _i * 8192), 16, 0, 0); } while (0)
#define PG8_LDA(dst, b, h) do { _Pragma("unroll") for (int m = 0; m < 4; ++m) _Pragma("unroll") for (int k = 0; k < 2; ++k) dst[m][k] = *(const PG8_LAS bf16x8*)(lds + PG8_SA(b, h) + aoff + m * 2048 + k * 1024); } while (0)
#define PG8_LDB(dst, b, h) do { _Pragma("unroll") for (int n = 0; n < 2; ++n) _Pragma("unroll") for (int k = 0; k < 2; ++k) dst[n][k] = *(const PG8_LAS bf16x8*)(lds + PG8_SB(b, h) + boff + n * 2048 + k * 1024); } while (0)
#define PG8_MMA(ai, bj, At, Bt) do { __builtin_amdgcn_s_setprio(1); _Pragma("unroll") for (int m = 0; m < 4; ++m) _Pragma("unroll") for (int n = 0; n < 2; ++n) _Pragma("unroll") for (int k = 0; k < 2; ++k) \
        acc[ai][bj][m][n] = __builtin_amdgcn_mfma_f32_16x16x32_bf16(Bt[n][k], At[m][k], acc[ai][bj][m][n], 0, 0, 0); __builtin_amdgcn_s_setprio(0); } while (0)
#define PG8_WAIT_V(n) asm volatile("s_waitcnt vmcnt(" #n ")" ::: "memory")
#define PG8_WAIT_L(n) asm volatile("s_waitcnt lgkmcnt(" #n ")" ::: "memory")
#define PG8_BAR __builtin_amdgcn_s_barrier()
#define PG8_SCHED __builtin_amdgcn_sched_barrier(0)
    Unit cur, nxt; int ui = 0;
    if (!S.next(0, cur)) return;
    f32x4 acc[2][2][4][2];
#pragma unroll
    for (int a = 0; a < 2; ++a)
#pragma unroll
        for (int b = 0; b < 2; ++b)
#pragma unroll
            for (int m = 0; m < 4; ++m)
#pragma unroll
                for (int n = 0; n < 2; ++n) acc[a][b][m][n] = (f32x4){0.f, 0.f, 0.f, 0.f};
    bf16x8 At[4][2], B0[2][2], B1[2][2];
    const char* cA = (const char*)g.A + (size_t)cur.pm * tstep; const char* cB = (const char*)g.Bt + (size_t)cur.pn * tstep;
    S.a_ready(cur);
    if constexpr (SP2) {
        PG8_STAGE(PG8_SB(0, 0), cB, voffB); PG8_STAGE(PG8_SB(0, 1), cB + hstep, voffB); PG8_STAGE(PG8_SA(0, 0), cA, voffA); PG8_STAGE(PG8_SA(0, 1), cA + hstep, voffA);
        if (wr == 1) PG8_BAR;
        PG8_WAIT_V(2); PG8_BAR;
        PG8_STAGE(PG8_SB(1, 0), cB + kstep, voffB); PG8_STAGE(PG8_SA(1, 0), cA + kstep, voffA); PG8_STAGE(PG8_SB(1, 1), cB + hstep + kstep, voffB);
        PG8_WAIT_V(6); PG8_BAR;
    } else {
        PG8_STAGE(PG8_SB(0, 0), cB, voffB); PG8_STAGE(PG8_SA(0, 0), cA, voffA); PG8_STAGE(PG8_SB(0, 1), cB + hstep, voffB); PG8_STAGE(PG8_SA(0, 1), cA + hstep, voffA);
        if (wr == 1) PG8_BAR;
        PG8_WAIT_V(4); PG8_BAR;
        PG8_STAGE(PG8_SB(1, 0), cB + kstep, voffB); PG8_STAGE(PG8_SA(1, 0), cA + kstep, voffA); PG8_STAGE(PG8_SB(1, 1), cB + hstep + kstep, voffB);
        PG8_WAIT_V(6); PG8_BAR;
    }
    for (;;) {
        const bool has_next = S.next(ui + 1, nxt);
        const char* nA = has_next ? (const char*)g.A + (size_t)nxt.pm * tstep : cA; const char* nB = has_next ? (const char*)g.Bt + (size_t)nxt.pn * tstep : cB;
        for (int t = 0; t < nt; t += 2) {
            const bool last = (t == nt - 2);
            const char* a1 = cA + (size_t)(t + 1) * kstep;
            const char* a2 = last ? nA : cA + (size_t)(t + 2) * kstep; const char* b2 = last ? nB : cB + (size_t)(t + 2) * kstep;
            const char* a3 = a2 + kstep; const char* b3 = b2 + kstep;
            if (last && has_next) S.a_ready(nxt);
            if constexpr (SP2) {
            PG8_LDB(B0, 0, 0); PG8_LDB(B1, 0, 1); PG8_SCHED; PG8_LDA(At, 0, 0); PG8_STAGE(PG8_SA(1, 1), a1 + hstep, voffA);
            PG8_WAIT_V(8); PG8_WAIT_L(0); PG8_BAR; PG8_MMA(0, 0, At, B0); PG8_MMA(0, 1, At, B1); PG8_BAR; PG8_SCHED;
            PG8_LDA(At, 0, 1); PG8_STAGE(PG8_SB(0, 0), b2, voffB); PG8_STAGE(PG8_SB(0, 1), b2 + hstep, voffB); PG8_STAGE(PG8_SA(0, 0), a2, voffA);
            PG8_WAIT_V(8); PG8_WAIT_L(0); PG8_BAR; PG8_MMA(1, 0, At, B0); PG8_MMA(1, 1, At, B1); PG8_BAR; PG8_SCHED;
            PG8_LDB(B0, 1, 0); PG8_LDB(B1, 1, 1); PG8_SCHED; PG8_LDA(At, 1, 0); PG8_STAGE(PG8_SA(0, 1), a2 + hstep, voffA);
            PG8_WAIT_V(8); PG8_WAIT_L(0); PG8_BAR; PG8_MMA(0, 0, At, B0); PG8_MMA(0, 1, At, B1); PG8_BAR; PG8_SCHED;
            PG8_LDA(At, 1, 1); PG8_STAGE(PG8_SB(1, 0), b3, voffB); PG8_STAGE(PG8_SB(1, 1), b3 + hstep, voffB); PG8_STAGE(PG8_SA(1, 0), a3, voffA);
            PG8_WAIT_V(8); PG8_WAIT_L(0); PG8_BAR; PG8_MMA(1, 0, At, B0); PG8_MMA(1, 1, At, B1); PG8_BAR; PG8_SCHED;
            } else {
            PG8_LDB(B0, 0, 0); PG8_SCHED; PG8_LDA(At, 0, 0); PG8_STAGE(PG8_SA(1, 1), a1 + hstep, voffA);
            PG8_WAIT_L(8); PG8_BAR; PG8_WAIT_L(0); PG8_MMA(0, 0, At, B0); PG8_BAR; PG8_SCHED;
            PG8_LDB(B1, 0, 1); PG8_STAGE(PG8_SB(0, 0), b2, voffB);
            PG8_BAR; PG8_WAIT_L(0); PG8_MMA(0, 1, At, B1); PG8_BAR;
            PG8_LDA(At, 0, 1); PG8_STAGE(PG8_SA(0, 0), a2, voffA);
            PG8_BAR; PG8_WAIT_L(0); PG8_MMA(1, 0, At, B0); PG8_BAR; PG8_SCHED;
            PG8_STAGE(PG8_SB(0, 1), b2 + hstep, voffB);
            PG8_WAIT_V(6); PG8_BAR; PG8_MMA(1, 1, At, B1); PG8_BAR;
            PG8_LDB(B0, 1, 0); PG8_SCHED; PG8_LDA(At, 1, 0); PG8_STAGE(PG8_SA(0, 1), a2 + hstep, voffA);
            PG8_WAIT_L(8); PG8_BAR; PG8_WAIT_L(0); PG8_MMA(0, 0, At, B0); PG8_BAR; PG8_SCHED;
            PG8_LDB(B1, 1, 1); PG8_STAGE(PG8_SB(1, 0), b3, voffB);
            PG8_BAR; PG8_WAIT_L(0); PG8_MMA(0, 1, At, B1); PG8_BAR;
            PG8_LDA(At, 1, 1); PG8_STAGE(PG8_SA(1, 0), a3, voffA);
            PG8_BAR; PG8_WAIT_L(0); PG8_MMA(1, 0, At, B0); PG8_BAR; PG8_SCHED;
            PG8_STAGE(PG8_SB(1, 1), b3 + hstep, voffB);
            PG8_WAIT_V(6); PG8_BAR; PG8_MMA(1, 1, At, B1); PG8_BAR;
            }
        }
        if constexpr (ALIGN_EPI) { if (wr == 0) PG8_BAR; }
        if constexpr (!Epi::AFTER_DRAIN) { E(acc, cur, wr, wc, fr, fq); S.done(cur); }
        if (!has_next) break;
#pragma unroll
        for (int a = 0; a < 2; ++a)
#pragma unroll
            for (int b = 0; b < 2; ++b)
#pragma unroll
                for (int m = 0; m < 4; ++m)
#pragma unroll
                    for (int n = 0; n < 2; ++n) acc[a][b][m][n] = (f32x4){0.f, 0.f, 0.f, 0.f};
        cur = nxt; cA = nA; cB = nB; ++ui;
        if constexpr (ALIGN_EPI) { if (wr == 1) PG8_BAR; }
    }
    PG8_WAIT_V(0);
    if constexpr (!ALIGN_EPI) { if (wr == 0) PG8_BAR; }
    PG8_BAR;
    if constexpr (Epi::AFTER_DRAIN) { E.fused(acc, cur, wr, wc, fr, fq, lds, wid, lane); S.done(cur); }
#undef PG8_SA
#undef PG8_SB
#undef PG8_STAGE
#undef PG8_LDA
#undef PG8_LDB
#undef PG8_MMA
#undef PG8_WAIT_V
#undef PG8_WAIT_L
#undef PG8_BAR
#undef PG8_SCHED
}
}
namespace att {
constexpr int D = 128; constexpr bool WSKIP = false; constexpr float THR = 8.f;
constexpr float SCALE = 0.08838834764831845f;
constexpr int NW = 8, QBLK = 32, KVBLK = 64, QB = NW * QBLK;
constexpr int SHM_V = KVBLK * D * 2, SHM_K = KVBLK * D * 2;
constexpr int FB_OFF = 2 * SHM_V + 2 * SHM_K + NW * 64 * 4;
constexpr int QL_OFF = FB_OFF + 2048 * 4;
constexpr int LDS_BYTES = QL_OFF + NW * QBLK * D * 2;
constexpr int LDO = 2048; constexpr float INV_SCALE = 11.313708498984761f;

using bf16 = __hip_bfloat16;
typedef short bf16x8 __attribute__((ext_vector_type(8)));
typedef short s16x4 __attribute__((ext_vector_type(4)));
typedef float f32x16 __attribute__((ext_vector_type(16)));
typedef float f32x4 __attribute__((ext_vector_type(4)));
typedef unsigned u32x4 __attribute__((ext_vector_type(4)));
template <class A, class Bt> struct same_t { static constexpr bool v = false; };
template <class A> struct same_t<A, A> { static constexpr bool v = true; };

#define KSWZ(row, colB) ((row) * 256 + ((colB) ^ (((row) & 7) << 4)))
#define SBAR() __builtin_amdgcn_sched_barrier(0)
__device__ __forceinline__ int v_st(int k, int c) { const int kk = (k & ~0xC) | ((k & 4) << 1) | ((k & 8) >> 1); return ((kk >> 3) * 4 + (c >> 5)) * 512 + ((kk & 7) * 32 + (c & 31)) * 2; }
__device__ __forceinline__ int v_rd_base(int lane) { return ((lane & 3) << 3) | (((lane >> 2) & 3) << 6) | (((lane >> 4) & 1) << 5) | (((lane >> 5) & 1) << 8); }
constexpr int v_rd_off(int d0, int ks, int half) { return d0 * 512 + ks * 4096 + half * 2048; }
__device__ __forceinline__ int crow(int r, int hi) { return (r & 3) + 8 * (r >> 2) + 4 * hi; }
__device__ __forceinline__ unsigned cvtpk(float lo, float hi) {
    unsigned r; asm volatile("v_cvt_pk_bf16_f32 %0, %1, %2" : "=v"(r) : "v"(lo), "v"(hi)); return r;
}
__device__ __forceinline__ bf16x8 pack8(f32x4 a, f32x4 b) {
    u32x4 w = {cvtpk(a[0], a[1]), cvtpk(a[2], a[3]), cvtpk(b[0], b[1]), cvtpk(b[2], b[3])};
    return *reinterpret_cast<bf16x8*>(&w);
}
template <class T> __device__ __forceinline__ bf16x8 load8(const T* p) {
    if constexpr (same_t<T, float>::v) { return pack8(*(const f32x4*)p, *(const f32x4*)(p + 4)); }
    else { return *reinterpret_cast<const bf16x8*>(p); }
}
__device__ __forceinline__ void mask_tile(f32x16& p0, f32x16& p1, int dq, unsigned W) {
    const float NEG = -__builtin_inff();
#pragma unroll
    for (int r = 0; r < 16; ++r) {
        const int c = (r & 3) + 8 * (r >> 2);
        if ((unsigned)(dq - c) >= W) p0[r] = NEG;
        if ((unsigned)(dq - c - 32) >= W) p1[r] = NEG;
    }
}
__device__ __forceinline__ void partialSM(f32x16& p0, f32x16& p1, float& m_reg, float& mn, float& alpha) {
    float pmax = p0[0]; for (int r = 1; r < 16; ++r) pmax = fmaxf(pmax, p0[r]); for (int r = 0; r < 16; ++r) pmax = fmaxf(pmax, p1[r]);
    { auto rr = __builtin_amdgcn_permlane32_swap(__float_as_uint(pmax), __float_as_uint(pmax), false, false);
      pmax = fmaxf(__uint_as_float(rr[0]), __uint_as_float(rr[1])); }
    constexpr float C2 = 1.4426950408889634f * SCALE;
    if (__builtin_expect(__all((pmax - m_reg) * SCALE <= THR), 1)) { mn = m_reg; alpha = 1.f; }
    else { mn = fmaxf(m_reg, pmax); alpha = __builtin_amdgcn_exp2f((m_reg - mn) * C2); m_reg = mn; }
    const float mnL = -mn * C2;
    for (int r = 0; r < 16; ++r) p0[r] = fmaf(p0[r], C2, mnL); for (int r = 0; r < 16; ++r) p1[r] = fmaf(p1[r], C2, mnL);
    for (int r = 0; r < 16; ++r) p0[r] = __builtin_amdgcn_exp2f(p0[r]);
}
__device__ __forceinline__ void finishSM(f32x16& p0, f32x16& p1, float alpha, float& l_reg, bf16x8& pa0, bf16x8& pa1, bf16x8& pa2, bf16x8& pa3) {
    for (int r = 0; r < 16; ++r) p1[r] = __builtin_amdgcn_exp2f(p1[r]);
    float ps = 0; for (int r = 0; r < 16; ++r) ps += p0[r]; for (int r = 0; r < 16; ++r) ps += p1[r];
    { auto rr = __builtin_amdgcn_permlane32_swap(__float_as_uint(ps), __float_as_uint(ps), false, false);
      ps = __uint_as_float(rr[0]) + __uint_as_float(rr[1]); }
    l_reg = l_reg * alpha + ps;
#define PK4(P, B_, OUT) do { unsigned a0 = cvtpk(P[B_+0], P[B_+1]), a1 = cvtpk(P[B_+2], P[B_+3]);                          \
        unsigned b0 = cvtpk(P[B_+4], P[B_+5]), b1 = cvtpk(P[B_+6], P[B_+7]);                                             \
        auto r0 = __builtin_amdgcn_permlane32_swap(a0, b0, false, false); auto r1 = __builtin_amdgcn_permlane32_swap(a1, b1, false, false); \
        u32x4 w = {r0[0], r1[0], r0[1], r1[1]}; OUT = *reinterpret_cast<bf16x8*>(&w); } while (0)
    PK4(p0, 0, pa0); PK4(p0, 8, pa1); PK4(p1, 0, pa2); PK4(p1, 8, pa3);
#undef PK4
}
template <int KB, bool SK>
__device__ __forceinline__ void qkt(f32x16& p0, f32x16& p1, const char* K_lds, int r32, int hi, const char* q_w, bool act, const float* fbt) {
    if (SK && !act) { const float NEG = -__builtin_inff();
#pragma unroll
        for (int r = 0; r < 16; ++r) { p0[r] = NEG; p1[r] = NEG; } return; }
    {
#pragma unroll
        for (int r4 = 0; r4 < 4; ++r4) { const f32x4 a = *(const f32x4*)(fbt + 8 * r4 + 4 * hi), b = *(const f32x4*)(fbt + 32 + 8 * r4 + 4 * hi);
            p0[4 * r4] = a[0]; p0[4 * r4 + 1] = a[1]; p0[4 * r4 + 2] = a[2]; p0[4 * r4 + 3] = a[3];
            p1[4 * r4] = b[0]; p1[4 * r4 + 1] = b[1]; p1[4 * r4 + 2] = b[2]; p1[4 * r4 + 3] = b[3]; }
    }
    const char* kb[4]; const char* qb[4];
#pragma unroll
    for (int dd = 0; dd < 4; ++dd) { kb[dd] = K_lds + KB * SHM_K + KSWZ(r32, (dd * 16 + hi * 8) * 2); qb[dd] = q_w + KSWZ(r32, (dd * 16 + hi * 8) * 2); }
    bf16x8 b0 = *reinterpret_cast<const bf16x8*>(kb[0]), b1 = *reinterpret_cast<const bf16x8*>(kb[0] + 32 * 256), qf = *reinterpret_cast<const bf16x8*>(qb[0]);
#pragma unroll
    for (int d0 = 0; d0 < 8; ++d0) {
        bf16x8 b0n = b0, b1n = b1, qfn = qf;
        if (d0 < 7) { const char* a = kb[(d0 + 1) & 3] + ((d0 + 1) >> 2) * 128;
            b0n = *reinterpret_cast<const bf16x8*>(a); b1n = *reinterpret_cast<const bf16x8*>(a + 32 * 256);
            qfn = *reinterpret_cast<const bf16x8*>(qb[(d0 + 1) & 3] + ((d0 + 1) >> 2) * 128); }
        __builtin_amdgcn_sched_barrier(0);
        p0 = __builtin_amdgcn_mfma_f32_32x32x16_bf16(b0, qf, p0, 0, 0, 0);
        p1 = __builtin_amdgcn_mfma_f32_32x32x16_bf16(b1, qf, p1, 0, 0, 0);
        __builtin_amdgcn_sched_barrier(0);
        b0 = b0n; b1 = b1n; qf = qfn; }
}
template <int VB, bool SK>
__device__ __forceinline__ void pv_tile(f32x16* o, int vb0, bf16x8 pa0, bf16x8 pa1, bf16x8 pa2, bf16x8 pa3, bool act) {
    if (SK && !act) return;
#define TRRD(dst, off) asm volatile("ds_read_b64_tr_b16 %0, %1 offset:%2" : "=&v"(dst) : "v"(vb0), "i"(off) : "memory")
#define PV_D0(d0) do { s16x4 l0, l1, l2, l3, h0, h1, h2, h3; constexpr int b_ = VB * SHM_V + v_rd_off(d0, 0, 0);     \
        TRRD(l0, b_); TRRD(h0, b_ + 2048); TRRD(l1, b_ + 4096); TRRD(h1, b_ + 6144); TRRD(l2, b_ + 8192); TRRD(h2, b_ + 10240); TRRD(l3, b_ + 12288); TRRD(h3, b_ + 14336); \
        asm volatile("s_waitcnt lgkmcnt(0)" ::: "memory"); SBAR();                 \
        o[d0] = __builtin_amdgcn_mfma_f32_32x32x16_bf16(pa0, (bf16x8){l0[0], l0[1], l0[2], l0[3], h0[0], h0[1], h0[2], h0[3]}, o[d0], 0, 0, 0);   \
        o[d0] = __builtin_amdgcn_mfma_f32_32x32x16_bf16(pa1, (bf16x8){l1[0], l1[1], l1[2], l1[3], h1[0], h1[1], h1[2], h1[3]}, o[d0], 0, 0, 0);   \
        o[d0] = __builtin_amdgcn_mfma_f32_32x32x16_bf16(pa2, (bf16x8){l2[0], l2[1], l2[2], l2[3], h2[0], h2[1], h2[2], h2[3]}, o[d0], 0, 0, 0);   \
        o[d0] = __builtin_amdgcn_mfma_f32_32x32x16_bf16(pa3, (bf16x8){l3[0], l3[1], l3[2], l3[3], h3[0], h3[1], h3[2], h3[3]}, o[d0], 0, 0, 0); } while (0)
    PV_D0(0); PV_D0(1); PV_D0(2); PV_D0(3);
#undef PV_D0
#undef TRRD
}

template <class TIn, class TOut> struct BlockRef { const TIn* Q; const TIn* K; const TIn* V; TOut* O; const float* FC; const TIn* G; int P0; int JLO; };
template <class TIn> struct Seam {
    bf16x8 qr[8];
    bf16x8 st_v0, st_v1, st_k0, st_k1; f32x4 sf0, sf1, sf2, sf3;
    f32x4 tq[16];
};
__device__ __forceinline__ int swa_jlo(int P0, int W) { const int lowk = P0 - W + 1; return lowk > 0 ? lowk / KVBLK : 0; }
#define ROW(p, k0, rr) ((p) + (size_t)((k0) + (rr)) * D + sc)
#define VMW() asm volatile("s_waitcnt vmcnt(0)" ::: "memory")
#define VMWN(n) asm volatile("s_waitcnt vmcnt(%0)" :: "i"(n) : "memory")
#define SLOAD_H(Kp, Vp, k0) do { S.st_v0 = load8<TIn>(ROW(Vp, k0, sr)); S.st_v1 = load8<TIn>(ROW(Vp, k0, 32 + sr));              \
                         S.st_k0 = load8<TIn>(ROW(Kp, k0, sr)); S.st_k1 = load8<TIn>(ROW(Kp, k0, 32 + sr)); } while (0)
#define SWRITE_HK(bf) do { *(bf16x8*)(K_lds + (bf) * SHM_K + kws) = S.st_k0; *(bf16x8*)(K_lds + (bf) * SHM_K + kws + 32 * 256) = S.st_k1; } while (0)
#define SWRITE_HV(bf) do { *(bf16x8*)(V_lds + (bf) * SHM_V + vst0) = S.st_v0; *(bf16x8*)(V_lds + (bf) * SHM_V + vst1) = S.st_v1; } while (0)
#define SWRITE_H(bf) do { SWRITE_HV(bf); SWRITE_HK(bf); } while (0)
#define SLOAD_F(p, k0) do { S.sf0 = *(const f32x4*)ROW(p, k0, sr); S.sf1 = *(const f32x4*)(ROW(p, k0, sr) + 4);                \
                            S.sf2 = *(const f32x4*)ROW(p, k0, 32 + sr); S.sf3 = *(const f32x4*)(ROW(p, k0, 32 + sr) + 4); } while (0)
#define SWRITE_KF(bf) do { *(bf16x8*)(K_lds + (bf) * SHM_K + kws) = pack8(S.sf0, S.sf1); *(bf16x8*)(K_lds + (bf) * SHM_K + kws + 32 * 256) = pack8(S.sf2, S.sf3); } while (0)
#define SWRITE_VF(bf) do { *(bf16x8*)(V_lds + (bf) * SHM_V + vst0) = pack8(S.sf0, S.sf1); *(bf16x8*)(V_lds + (bf) * SHM_V + vst1) = pack8(S.sf2, S.sf3); } while (0)
template <class TIn, class TOut>
__device__ __forceinline__ void causal_swa_prime(const BlockRef<TIn, TOut>& cur, int W, char* lds, Seam<TIn>& S) {
    constexpr bool F32 = same_t<TIn, float>::v;
    const int tid = opaque_tid(), wid = __builtin_amdgcn_readfirstlane(tid >> 6), lane = tid & 63, r32 = lane & 31, hi = lane >> 5;
    const int sr = tid >> 4, sc = (tid & 15) * 8, kws = KSWZ(sr, sc * 2); char* K_lds = lds + 2 * SHM_V;
    const int kb0 = cur.JLO * KVBLK;
    for (int d0 = 0; d0 < 8; ++d0) S.qr[d0] = load8<TIn>(cur.Q + (size_t)(wid * QBLK + r32) * D + d0 * 16 + hi * 8);
    { char* q_w = lds + QL_OFF + wid * (QBLK * D * 2);
      for (int d0 = 0; d0 < 8; ++d0) *reinterpret_cast<bf16x8*>(q_w + KSWZ(r32, (d0 * 16 + hi * 8) * 2)) = S.qr[d0]; }
    if constexpr (F32) { SLOAD_F((const float*)cur.K, kb0); VMW(); SWRITE_KF(0); SBAR(); SLOAD_F((const float*)cur.V, kb0); }
    else { SLOAD_H(cur.K, cur.V, kb0); VMW(); SWRITE_HK(0); }
    __syncthreads();
}
template <class TIn, class TOut>
__device__ __forceinline__ void causal_swa_block(const BlockRef<TIn, TOut>& cur, const BlockRef<TIn, TOut>& nxt, int skv, int W, char* lds, Seam<TIn>& S) {
    constexpr bool F32 = same_t<TIn, float>::v;
    const int tid = opaque_tid(), wid = __builtin_amdgcn_readfirstlane(tid >> 6), lane = tid & 63, r32 = lane & 31, hi = lane >> 5;
    const int j_lo = cur.JLO;
    int j_hi = (cur.P0 + QB - 1) / KVBLK + 1; if (j_hi > skv / KVBLK) j_hi = skv / KVBLK;
    const int NT = j_hi - j_lo;
    const int kbn = nxt.JLO * KVBLK;
    const int qlo = cur.P0 + wid * QBLK, qm = qlo + r32 - 4 * hi;
    char* V_lds = lds; char* K_lds = lds + 2 * SHM_V;
    float* ws = (float*)(lds + 2 * SHM_V + 2 * SHM_K) + wid * 64; float* li_l = ws, * al_l = ws + 32;
    float m_reg = -1e30f, l_reg = 0; f32x16 o[4] = {};
    const int sr = tid >> 4, sc = (tid & 15) * 8, vst0 = v_st(sr, sc), vst1 = v_st(32 + sr, sc), kws = KSWZ(sr, sc * 2);
    const int vb0 = (int)(uintptr_t)V_lds + v_rd_base(lane);
    const TIn* Kh = cur.K; const TIn* Vh = cur.V;
    char* q_w = lds + QL_OFF + wid * (QBLK * D * 2);
    float* fb = (float*)(lds + FB_OFF);
    { const int nk = j_hi * KVBLK; const float* FCp = cur.FC; const float c0 = FCp ? FCp[cur.P0] : 0.f;
#pragma unroll
      for (int k = 0; k < 4; ++k) { const int i = tid + 64 * NW * k;
          if (i < nk) { float v = 0.f; if (FCp) v = (c0 - FCp[i]) * INV_SCALE; fb[i] = v; } }
      __syncthreads(); }
#define RESC(a) do { if (__any((a) < 1.f)) { if (hi == 0) al_l[r32] = (a); asm volatile("s_waitcnt lgkmcnt(0)" ::: "memory");              \
                     for (int d_ = 0; d_ < 4; ++d_) for (int r = 0; r < 16; ++r) o[d_][r] *= al_l[crow(r, hi)]; } } while (0)
#define KBASE(t) ((j_lo + (t)) * KVBLK)
#define ACT(t) (KBASE(t) <= qlo + QBLK - 1 && KBASE(t) + KVBLK - 1 >= qlo - W + 1)
#define MASKT(P0_, P1_, t) do { const int kb_ = KBASE(t); if ((!SK || ACT(t)) && (kb_ + KVBLK - 1 > qlo || kb_ <= qlo + QBLK - 1 - W)) mask_tile(P0_, P1_, qm - kb_, (unsigned)W); } while (0)
    constexpr int NQL = F32 ? 16 : 8;
    constexpr bool SK = WSKIP && !F32;
#define SEAM_K0() do { VMWN(NQL); if constexpr (F32) { SWRITE_KF(0); SBAR(); SLOAD_F((const float*)nxt.V, kbn); } else { SWRITE_HK(0); } SBAR(); } while (0)
    f32x16 pA0, pA1, pB0, pB1; float mnA, mnB, alA, alB; bf16x8 pa0, pa1, pa2, pa3;
    if constexpr (F32) { VMW(); SWRITE_VF(0); SBAR(); } else { SWRITE_HV(0); SBAR(); }
    if (NT > 1) { if constexpr (F32) SLOAD_F((const float*)Kh, KBASE(1)); else SLOAD_H(Kh, Vh, KBASE(1)); }
    SBAR(); qkt<0, SK>(pA0, pA1, K_lds, r32, hi, q_w, ACT(0), fb + KBASE(0));
    if constexpr (F32) { if (NT > 1) { VMW(); SWRITE_KF(1); SBAR(); SLOAD_F((const float*)Vh, KBASE(1)); } }
    MASKT(pA0, pA1, 0); partialSM(pA0, pA1, m_reg, mnA, alA);
    if (NT > 1) { VMW(); if constexpr (F32) { SWRITE_VF(1); SBAR(); if (NT > 2) SLOAD_F((const float*)Kh, KBASE(2)); } else SWRITE_H(1); }
    __syncthreads();
#define HALF_STEP(PX0, PX1, mnX, alX, PY0, PY1, alY, t, KB, VB, SB) do {                                                      \
        SBAR(); qkt<KB, SK>(PX0, PX1, K_lds, r32, hi, q_w, ACT(t), fb + KBASE(t));                                             \
        finishSM(PY0, PY1, alY, l_reg, pa0, pa1, pa2, pa3); SBAR();                                                           \
        if ((t) + 1 < NT) { if constexpr (F32) { VMW(); SWRITE_KF(SB); SBAR(); SLOAD_F((const float*)Vh, KBASE((t) + 1)); }  \
                            else { SLOAD_H(Kh, Vh, KBASE((t) + 1)); } SBAR(); }                                               \
        pv_tile<VB, SK>(o, vb0, pa0, pa1, pa2, pa3, ACT((t) - 1)); MASKT(PX0, PX1, (t)); partialSM(PX0, PX1, m_reg, mnX, alX);                                        \
        __syncthreads();                                                                                                      \
        if ((t) + 1 < NT) { VMW(); if constexpr (F32) { SWRITE_VF(SB); SBAR(); if ((t) + 2 < NT) SLOAD_F((const float*)Kh, KBASE((t) + 2)); } \
                            else { SWRITE_H(SB); } }                                                                          \
        RESC(alX); __syncthreads(); } while (0)
    for (int t = 1; t + 1 < NT; t += 2) {
        HALF_STEP(pB0, pB1, mnB, alB, pA0, pA1, alA, t, 1, 0, 0);
        HALF_STEP(pA0, pA1, mnA, alA, pB0, pB1, alB, t + 1, 0, 1, 1);
    }
    const bool even = (NT & 1) == 0;
    if (even) { SBAR(); qkt<1, SK>(pB0, pB1, K_lds, r32, hi, q_w, ACT(NT - 1), fb + KBASE(NT - 1)); SBAR(); }
#define QROW(e) (nxt.Q + (size_t)(wid * QBLK + r32) * D + ((e) >> 1) * 16 + hi * 8 + ((e) & 1) * 4)
    if constexpr (F32) { SLOAD_F((const float*)nxt.K, kbn); SBAR();
#pragma unroll
        for (int e = 0; e < 8; ++e) S.tq[e] = *(const f32x4*)QROW(e); }
    else { SLOAD_H(nxt.K, nxt.V, kbn); SBAR();
#pragma unroll
        for (int d0 = 0; d0 < 8; ++d0) S.qr[d0] = load8<TIn>(nxt.Q + (size_t)(wid * QBLK + r32) * D + d0 * 16 + hi * 8); }
    SBAR();
    finishSM(pA0, pA1, alA, l_reg, pa0, pa1, pa2, pa3); SBAR();
    if constexpr (F32) {
#pragma unroll
        for (int e = 8; e < 16; ++e) S.tq[e] = *(const f32x4*)QROW(e); SBAR(); }
#undef QROW
    pv_tile<0, SK>(o, vb0, pa0, pa1, pa2, pa3, ACT(even ? NT - 2 : NT - 1));
    if (even) { MASKT(pB0, pB1, NT - 1); partialSM(pB0, pB1, m_reg, mnB, alB); __syncthreads(); RESC(alB);
        finishSM(pB0, pB1, alB, l_reg, pa0, pa1, pa2, pa3); SBAR(); pv_tile<1, SK>(o, vb0, pa0, pa1, pa2, pa3, ACT(NT - 1)); }
    SBAR(); SEAM_K0();
    if (hi == 0) li_l[r32] = l_reg; asm volatile("s_waitcnt lgkmcnt(0)" ::: "memory");
    float rli[16];
#pragma unroll
    for (int r = 0; r < 16; ++r) rli[r] = __builtin_amdgcn_rcpf(li_l[crow(r, hi)]);
    {
        unsigned short* ost = (unsigned short*)q_w;
        {
            const bool odd = (r32 & 1) != 0; unsigned short* ob_ = ost + (odd ? 32 : 0) + (r32 & ~1);
#pragma unroll
            for (int r = 0; r < 16; ++r) { const int orow = crow(r, hi);
#pragma unroll
                for (int dp = 0; dp < 4; dp += 2) { const float e0 = o[dp][r] * rli[r], e1 = o[dp + 1][r] * rli[r];
                    const float snd = odd ? e0 : e1;
                    const float rcv = __int_as_float(__builtin_amdgcn_update_dpp(0, __float_as_int(snd), 0xB1, 0xF, 0xF, true));
                    const float lo = odd ? rcv : e0, hi_ = odd ? e1 : rcv;
                    *(unsigned*)(ob_ + orow * 128 + dp * 32) = cvtpk(lo, hi_); } }
        }
        asm volatile("s_waitcnt lgkmcnt(0)" ::: "memory");
        const unsigned short* Gw = (const unsigned short*)cur.G + (size_t)(wid * QBLK) * LDO; TOut* Ow = cur.O + (size_t)(wid * QBLK) * LDO;
        const int ck = lane & 15, rq = lane >> 4;
        u32x4 gq[8];
#pragma unroll
        for (int i = 0; i < 8; ++i) gq[i] = __builtin_nontemporal_load((const u32x4*)(Gw + (size_t)(4 * i + rq) * LDO + ck * 8));
#pragma unroll
        for (int i = 0; i < 8; ++i) { const u32x4 ov = *(const u32x4*)(ost + (4 * i + rq) * 128 + ck * 8); const u32x4 g = gq[i]; u32x4 w;
#define GMUL(a_, b_) cvtpk(__uint_as_float((a_) << 16) * __uint_as_float((b_) << 16), __uint_as_float((a_) & 0xffff0000u) * __uint_as_float((b_) & 0xffff0000u))
            w.x = GMUL(ov.x, g.x); w.y = GMUL(ov.y, g.y); w.z = GMUL(ov.z, g.z); w.w = GMUL(ov.w, g.w);
#undef GMUL
            *(u32x4*)(Ow + (size_t)(4 * i + rq) * LDO + ck * 8) = w; }
        asm volatile("s_waitcnt lgkmcnt(0)" ::: "memory");
    }
    if constexpr (F32) {
#pragma unroll
        for (int d0 = 0; d0 < 8; ++d0) S.qr[d0] = pack8(S.tq[2 * d0], S.tq[2 * d0 + 1]); }
#pragma unroll
    for (int d0 = 0; d0 < 8; ++d0) *reinterpret_cast<bf16x8*>(q_w + KSWZ(r32, (d0 * 16 + hi * 8) * 2)) = S.qr[d0];
    __syncthreads();
#undef RESC
#undef KBASE
#undef ACT
#undef MASKT
#undef SEAM_K0
#undef HALF_STEP
}
#undef ROW
#undef VMW
#undef VMWN
#undef SLOAD_H
#undef SWRITE_HK
#undef SWRITE_HV
#undef SWRITE_H
#undef SLOAD_F
#undef SWRITE_KF
#undef SWRITE_VF


#undef KSWZ
#undef SBAR
}
#define LAS __attribute__((address_space(3)))
typedef unsigned short bf16r;
typedef float f32x4 __attribute__((ext_vector_type(4)));
typedef float f32x16 __attribute__((ext_vector_type(16)));
typedef short bf16x8 __attribute__((ext_vector_type(8)));
typedef unsigned u32x4 __attribute__((ext_vector_type(4)));
typedef unsigned u32x2 __attribute__((ext_vector_type(2)));

constexpr int NTOK = 16384, DM = 2048, SEQL = 2048, NBATCH = 8, NMEM = 256, MAINW = 1536, MEMW = 512, NGRP = 96;
constexpr float EPSN = 1e-6f;
constexpr size_t MiB = (size_t)1 << 20;
constexpr size_t SM_RSTD0 = 0, SM_RSTDM = 64 * 1024, SM_ROWSQ0 = 128 * 1024, SM_ROWSQ1 = 192 * 1024, SM_RSTD1 = 256 * 1024,
                 SM_LOGF = 320 * 1024, SM_FCUM = 1152 * 1024, SM_WFT = 1984 * 1024, SM_QNRM = 2560 * 1024, SM_KNRM = 3328 * 1024;
constexpr size_t WS_WINA = 4 * MiB, WS_WKVB = 20 * MiB, WS_WGLU = 48 * MiB, WS_WMKV0 = 53 * MiB, WS_WMKV1 = 57 * MiB, WS_WOUT0 = 61 * MiB, WS_WOUT1 = 69 * MiB,
                 WS_XB = 77 * MiB, WS_MEMB = 141 * MiB, WS_MKV = 149 * MiB, WS_PROJ = 157 * MiB, WS_KVB = 285 * MiB, WS_CAT = 381 * MiB, WS_OB = 445 * MiB, WS_BAR = 509 * MiB, WS_END = 509 * MiB + 65536;
constexpr int LDS_TOTAL = 147456;

struct Params { const float* in[23]; float* out; unsigned char* ws; };
enum { I_X = 0, I_MEM, I_PREG, I_POSTG, I_WINA, I_LRE, I_LIM, I_LSTEP, I_BRE, I_BIM, I_CRE, I_CIM, I_DSKIP, I_WGLU, I_BGLU, I_KVG, I_WKV, I_WFG, I_BFG, I_WINB, I_MEMG, I_WMKV, I_WOUT };

__device__ __forceinline__ float wave_sum(float v) {
#pragma unroll
    for (int o = 1; o < 64; o <<= 1) v += __shfl_xor(v, o);
    return v;
}
__device__ __forceinline__ unsigned pkbf(float lo, float hi) { return pg8::cvt_pk_bf16(lo, hi); }
#define LDS_FENCE() asm volatile("s_waitcnt lgkmcnt(0)" ::: "memory")

__device__ __forceinline__ void transpose_item(const float* W, const float* gs, int K, int N, bf16r* WT, int row_off, LAS float* scr, int item, int lane) {
    const int nblk = N / 32, kb = item / nblk, nb = item % nblk, k0 = 64 * kb, n0 = 32 * nb;
    const float* src = W + (size_t)(k0 + (lane >> 5)) * N + n0 + (lane & 31);
    float v[32];
#pragma unroll
    for (int i = 0; i < 32; ++i) v[i] = __builtin_nontemporal_load(src + (size_t)(2 * i) * N);
    const int c = lane & 7;
    f32x4 g0 = {1.f, 1.f, 1.f, 1.f}, g1 = {1.f, 1.f, 1.f, 1.f};
    if (gs) { g0 = *(const f32x4*)(gs + k0 + 8 * c); g1 = *(const f32x4*)(gs + k0 + 8 * c + 4); }
#pragma unroll
    for (int i = 0; i < 32; ++i) scr[(2 * i + (lane >> 5)) * 33 + (lane & 31)] = v[i];
    LDS_FENCE();
#pragma unroll
    for (int j = 0; j < 4; ++j) { const int n = (lane >> 3) + 8 * j; const LAS float* s = scr + (8 * c) * 33 + n;
        u32x4 o; o.x = pkbf(s[0 * 33] * g0[0], s[1 * 33] * g0[1]); o.y = pkbf(s[2 * 33] * g0[2], s[3 * 33] * g0[3]); o.z = pkbf(s[4 * 33] * g1[0], s[5 * 33] * g1[1]); o.w = pkbf(s[6 * 33] * g1[2], s[7 * 33] * g1[3]);
        *(u32x4*)(WT + (size_t)(row_off + n0 + n) * K + k0 + 8 * c) = o; }
    LDS_FENCE();
}
__device__ __forceinline__ void rows_to_bf16(const float* x, bf16r* o, float* rstd_out, int m0, int stride, int nrows, int lane) {
    f32x4 v[8];
    if (m0 < nrows) { const f32x4* xp = (const f32x4*)(x + (size_t)m0 * DM) + lane;
#pragma unroll
        for (int j = 0; j < 8; ++j) v[j] = __builtin_nontemporal_load(xp + 64 * j); }
    for (int m = m0; m < nrows; m += stride) {
        f32x4 vn[8]; const int mn = m + stride;
        if (mn < nrows) { const f32x4* xp = (const f32x4*)(x + (size_t)mn * DM) + lane;
#pragma unroll
            for (int j = 0; j < 8; ++j) vn[j] = __builtin_nontemporal_load(xp + 64 * j); }
        float s = 0.f;
#pragma unroll
        for (int j = 0; j < 8; ++j) s += (v[j][0] * v[j][0] + v[j][1] * v[j][1]) + (v[j][2] * v[j][2] + v[j][3] * v[j][3]);
        s = wave_sum(s);
        if (lane == 0) rstd_out[m] = 1.0f / sqrtf(s * (1.0f / DM) + EPSN);
        u32x2* op = (u32x2*)(o + (size_t)m * DM) + lane;
#pragma unroll
        for (int j = 0; j < 8; ++j) { u32x2 w; w.x = pkbf(v[j][0], v[j][1]); w.y = pkbf(v[j][2], v[j][3]); op[64 * j] = w; }
        if (mn < nrows) {
#pragma unroll
            for (int j = 0; j < 8; ++j) v[j] = vn[j]; }
    }
}

struct Sel0 { bf16r* proj;
    __device__ __forceinline__ pg8::SecInfo operator()(int cs) const {
        if (cs < 1536) return {proj, 0, 1536, 0, 0, nullptr};
        if (cs < 3072) return {proj + (size_t)NTOK * 1536, 1536, 2048, 0, 1, nullptr};
        if (cs < 3584) return {proj + (size_t)NTOK * 3584, 3072, 0, 4, 0, nullptr};
        return {proj + (size_t)NTOK * 1536 + 1536, 3584, 2048, 0, 1, nullptr}; } };
struct Sel1 { bf16r* kvb; bf16r* proj; float* qnrm; float* knrm;
    __device__ __forceinline__ pg8::SecInfo operator()(int cs) const {
        if (cs < 1536) return {kvb, 0, 0, 12, 0, knrm};
        if (cs < 3072) return {kvb + (size_t)NTOK * 1536, 1536, 0, 12, 0, nullptr};
        if (cs < 4608) return {proj, 3072, 0, 12, 0, qnrm};
        if (cs < 6144) return {proj + (size_t)NTOK * 1536, 4608, 2048, 0, 1, nullptr};
        if (cs < 6656) return {proj + (size_t)NTOK * 3584, 6144, 0, 4, 0, nullptr};
        return {proj + (size_t)NTOK * 1536 + 1536, 6656, 2048, 0, 1, nullptr}; } };
struct SelM { bf16r* mkv;
    __device__ __forceinline__ pg8::SecInfo operator()(int cs) const {
        if (cs < 512) return {mkv, 0, 0, 4, 0, nullptr};
        return {mkv + (size_t)NBATCH * NMEM * 512, 512, 0, 4, 0, nullptr}; } };

constexpr int SSM_XS = 80;
constexpr int SSM_WAVE_LDS = 128 * 36 * 4 + 32 * SSM_XS * 4;
typedef float __attribute__((may_alias)) f32_ma; typedef unsigned __attribute__((may_alias)) u32_ma;
typedef f32x4 __attribute__((may_alias)) f32x4_ma; typedef bf16x8 __attribute__((may_alias)) bf16x8_ma;
__device__ __forceinline__ int crow16(int r, int hi) { return (r & 3) + 8 * (r >> 2) + 4 * hi; }
__device__ __forceinline__ float gelu_tanh(float y) {
    const float z = 0.7978845608028654f * (y + 0.044715f * y * y * y);
    return y * __builtin_amdgcn_rcpf(1.f + __builtin_amdgcn_exp2f(-2.8853900817779268f * z));
}
struct SsmCtx {
    f32_ma* Bu2; u32_ma* Xs; const bf16r* U; bf16r* YG; size_t tokb; int g, lane, c, hi, l16, kq;
    float ar, ai; bf16x8 Bf[4]; bf16x8 Cf[4]; float dsk[4];
};
__device__ __forceinline__ void ssm_s2(const SsmCtx& X, bf16x8 Uc) {
#pragma unroll
    for (int nt = 0; nt < 4; ++nt) {
        f32x16 a = {};
        a = __builtin_amdgcn_mfma_f32_32x32x16_bf16(Uc, X.Bf[nt], a, 0, 0, 0);
#pragma unroll
        for (int r4 = 0; r4 < 4; ++r4) { f32x4 v = {a[4 * r4], a[4 * r4 + 1], a[4 * r4 + 2], a[4 * r4 + 3]}; *(f32x4_ma*)(X.Bu2 + (32 * nt + X.c) * 36 + 8 * r4 + 4 * X.hi) = v; }
    }
}
__device__ __forceinline__ void ssm_s1(const SsmCtx& X, float& xr, float& xi) {
#pragma unroll
    for (int q = 0; q < 8; ++q) {
        const f32x4 re4 = *(const f32x4_ma*)(X.Bu2 + X.lane * 36 + 4 * q), im4 = *(const f32x4_ma*)(X.Bu2 + (64 + X.lane) * 36 + 4 * q);
#pragma unroll
        for (int e = 0; e < 4; ++e) {
            const float nr = X.ar * xr - X.ai * xi + re4[e], ni = X.ar * xi + X.ai * xr + im4[e];
            xr = nr; xi = ni; X.Xs[(4 * q + e) * SSM_XS + X.lane] = pkbf(xr, xi);
        }
    }
}
__device__ __forceinline__ void ssm_s3(const SsmCtx& X, bf16r* py, u32x2 us0, u32x2 us1) {
    f32x4 y0 = {0.f, 0.f, 0.f, 0.f}, y1 = {0.f, 0.f, 0.f, 0.f};
#pragma unroll
    for (int s = 0; s < 4; ++s) {
        const bf16x8 b0 = *(const bf16x8_ma*)(X.Xs + X.l16 * SSM_XS + 16 * s + 4 * X.kq), b1 = *(const bf16x8_ma*)(X.Xs + (16 + X.l16) * SSM_XS + 16 * s + 4 * X.kq);
        y0 = __builtin_amdgcn_mfma_f32_16x16x32_bf16(X.Cf[s], b0, y0, 0, 0, 0);
        y1 = __builtin_amdgcn_mfma_f32_16x16x32_bf16(X.Cf[s], b1, y1, 0, 0, 0);
    }
    y0[0] += X.dsk[0] * pg8::bf_lo(us0.x); y0[1] += X.dsk[1] * pg8::bf_hi(us0.x); y0[2] += X.dsk[2] * pg8::bf_lo(us0.y); y0[3] += X.dsk[3] * pg8::bf_hi(us0.y);
    y1[0] += X.dsk[0] * pg8::bf_lo(us1.x); y1[1] += X.dsk[1] * pg8::bf_hi(us1.x); y1[2] += X.dsk[2] * pg8::bf_lo(us1.y); y1[3] += X.dsk[3] * pg8::bf_hi(us1.y);
    u32x2 w0, w1;
    w0.x = pkbf(gelu_tanh(y0[0]), gelu_tanh(y0[1])); w0.y = pkbf(gelu_tanh(y0[2]), gelu_tanh(y0[3]));
    w1.x = pkbf(gelu_tanh(y1[0]), gelu_tanh(y1[1])); w1.y = pkbf(gelu_tanh(y1[2]), gelu_tanh(y1[3]));
    *(u32x2*)py = w0;
    *(u32x2*)(py + 16 * 1536) = w1;
}
#define SSM_BAR() asm volatile("s_waitcnt lgkmcnt(0)\n\ts_barrier" ::: "memory")
constexpr int SSM_TASK_LDS = 128 * 36 * 4 + 2 * 32 * SSM_XS * 4;
__device__ __forceinline__ void ssm_round(const Params& P, bool active, int role, int b, int g, unsigned char* wl, int lane) {
    SsmCtx X; X.g = g; X.lane = lane; X.c = lane & 31; X.hi = lane >> 5; X.l16 = lane & 15; X.kq = lane >> 4;
    const int c = X.c, hi = X.hi, l16 = X.l16, kq = X.kq;
    X.Bu2 = (f32_ma*)wl; u32_ma* Xs0 = (u32_ma*)(wl + 128 * 36 * 4); X.Xs = Xs0;
    X.U = (const bf16r*)(P.ws + WS_PROJ); X.YG = (bf16r*)(P.ws + WS_KVB); X.tokb = (size_t)b * SEQL;
    X.ar = 0.f; X.ai = 0.f;
    const bf16r* Ua = X.U + (X.tokb + c) * 1536 + g * 16 + 8 * hi;
    const bf16r* Us = X.U + (X.tokb + l16) * 1536 + g * 16 + 4 * kq;
    constexpr int NCH = SEQL / 32; constexpr size_t CHS = (size_t)32 * 1536;
    bf16x8 U0 = {}, U1 = {}, U2 = {}; u32x2 a0 = {0u, 0u}, a1 = {0u, 0u}, b0 = {0u, 0u}, b1 = {0u, 0u}, c0 = {0u, 0u}, c1 = {0u, 0u};
    if (active) {
        const float dt = __expf(P.in[I_LSTEP][g]), lr = P.in[I_LRE][g * 64 + lane], li = P.in[I_LIM][g * 64 + lane];
        const float mag = __expf(lr * dt); float rev = li * dt * 0.15915494309189535f; rev -= floorf(rev);
        const float ar = mag * __builtin_amdgcn_cosf(rev), ai = mag * __builtin_amdgcn_sinf(rev);
        const float den = lr * lr + li * li, cr = ((ar - 1.0f) * lr + ai * li) / den, ci = (ai * lr - (ar - 1.0f) * li) / den;
        X.ar = ar; X.ai = ai;
        if (role == 1) {
#pragma unroll
            for (int nt = 0; nt < 4; ++nt) {
                const int pp = 32 * nt + c, p = pp & 63; const float crp = __shfl(cr, p), cip = __shfl(ci, p);
                const f32x4 r0 = *(const f32x4*)(P.in[I_BRE] + ((size_t)(g * 64 + p)) * 16 + 8 * hi), r1 = *(const f32x4*)(P.in[I_BRE] + ((size_t)(g * 64 + p)) * 16 + 8 * hi + 4);
                const f32x4 i0 = *(const f32x4*)(P.in[I_BIM] + ((size_t)(g * 64 + p)) * 16 + 8 * hi), i1 = *(const f32x4*)(P.in[I_BIM] + ((size_t)(g * 64 + p)) * 16 + 8 * hi + 4);
                f32x4 v0, v1;
                if (nt < 2) { v0 = crp * r0 - cip * i0; v1 = crp * r1 - cip * i1; } else { v0 = crp * i0 + cip * r0; v1 = crp * i1 + cip * r1; }
                u32x4 w; w.x = pkbf(v0[0], v0[1]); w.y = pkbf(v0[2], v0[3]); w.z = pkbf(v1[0], v1[1]); w.w = pkbf(v1[2], v1[3]);
                X.Bf[nt] = __builtin_bit_cast(bf16x8, w);
            }
#pragma unroll
            for (int s = 0; s < 4; ++s) {
                const f32x4 re = *(const f32x4*)(P.in[I_CRE] + ((size_t)(g * 16 + l16)) * 64 + 16 * s + 4 * kq), im = *(const f32x4*)(P.in[I_CIM] + ((size_t)(g * 16 + l16)) * 64 + 16 * s + 4 * kq);
                u32x4 w; w.x = pkbf(re[0], -im[0]); w.y = pkbf(re[1], -im[1]); w.z = pkbf(re[2], -im[2]); w.w = pkbf(re[3], -im[3]);
                X.Cf[s] = __builtin_bit_cast(bf16x8, w);
            }
#pragma unroll
            for (int r = 0; r < 4; ++r) X.dsk[r] = P.in[I_DSKIP][g * 16 + 4 * kq + r];
            ssm_s2(X, *(const bf16x8*)Ua);
            U1 = *(const bf16x8*)(Ua + CHS); U2 = *(const bf16x8*)(Ua + 2 * CHS);
            a0 = *(const u32x2*)Us; a1 = *(const u32x2*)(Us + 16 * 1536);
        }
    }
    if (!active) {
        for (int i = 0; i < 2 * (NCH + 1) + 1; ++i) SSM_BAR();
    } else if (role == 0) {
        float xr = 0.f, xi = 0.f; const float nai_ = -X.ai; int wsel = 0;
        for (int ch = 0; ch <= NCH; ++ch) {
            SSM_BAR();
            f32x4 re4[8], im4[8];
            if (ch < NCH) {
#pragma unroll
                for (int q = 0; q < 8; ++q) { re4[q] = *(const f32x4_ma*)(X.Bu2 + lane * 36 + 4 * q); im4[q] = *(const f32x4_ma*)(X.Bu2 + (64 + lane) * 36 + 4 * q); }
            }
            SSM_BAR();
            if (ch < NCH) {
                u32_ma* Xw = Xs0 + wsel * (32 * SSM_XS); wsel ^= 1;
#pragma unroll
                for (int q = 0; q < 8; ++q) {
#pragma unroll
                    for (int e = 0; e < 4; ++e) {
                        float t1, t2, nr, ni;
                        asm("v_fma_f32 %0, %1, %2, %3" : "=v"(t1) : "v"(nai_), "v"(xi), "v"(re4[q][e]));
                        asm("v_fma_f32 %0, %1, %2, %3" : "=v"(t2) : "v"(X.ai), "v"(xr), "v"(im4[q][e]));
                        asm("v_fma_f32 %0, %1, %2, %3" : "=v"(nr) : "v"(X.ar), "v"(xr), "v"(t1));
                        asm("v_fma_f32 %0, %1, %2, %3" : "=v"(ni) : "v"(X.ar), "v"(xi), "v"(t2));
                        xr = nr; xi = ni; Xw[(4 * q + e) * SSM_XS + lane] = pkbf(xr, xi); } }
            }
        }
        SSM_BAR();
    } else {
        const bf16r* pU = Ua + 3 * CHS; const bf16r* pS = Us + CHS; bf16r* pY = X.YG + (X.tokb + l16) * 1536 + g * 16 + 4 * kq; int rsel = 0;
#define SSM_MM(DO_S2, DO_S3, DO_LD, U_USE, U_LD, S0_USE, S1_USE, S0_LD, S1_LD) do {                                               \
            SSM_BAR(); SSM_BAR();                                                                                      \
            if (DO_LD) { U_LD = *(const bf16x8*)pU; S0_LD = *(const u32x2*)pS; S1_LD = *(const u32x2*)(pS + 16 * 1536); pU += CHS; pS += CHS; } \
            __builtin_amdgcn_sched_barrier(0);                                                                                    \
            if (DO_S2) ssm_s2(X, U_USE);                                                                                          \
            if (DO_S3) { X.Xs = Xs0 + rsel * (32 * SSM_XS); rsel ^= 1; ssm_s3(X, pY, S0_USE, S1_USE); pY += CHS; }                \
            __builtin_amdgcn_sched_barrier(0);                                                                                    \
        } while (0)
#define MM_R0(S2_, S3_, LD) SSM_MM(S2_, S3_, LD, U1, U0, c0, c1, b0, b1)
#define MM_R1(S2_, S3_, LD) SSM_MM(S2_, S3_, LD, U2, U1, a0, a1, c0, c1)
#define MM_R2(S2_, S3_, LD) SSM_MM(S2_, S3_, LD, U0, U2, b0, b1, a0, a1)
        MM_R0(true, false, true);
        _Pragma("clang loop unroll(disable)") for (int ch = 1; ch + 2 < NCH - 1; ch += 3) { MM_R1(true, true, true); MM_R2(true, true, true); MM_R0(true, true, true); }
        static_assert((NCH - 2) % 3 == 2, "steady range 1..NCH-2 = 20 triples + 2");
        MM_R1(true, true, true);
        MM_R2(true, true, true);
        MM_R0(false, true, false);
        MM_R1(false, true, false);
#undef MM_R0
#undef MM_R1
#undef MM_R2
#undef SSM_MM
        SSM_BAR();
    }
}
__device__ __forceinline__ void ssm_phase(const Params& P, unsigned char* lds, int wave, int lane) {
    const int role = (wave == 0 || wave == 2 || wave == 6) ? 0 : 1;
    const int ts = (wave == 0 || wave == 4) ? 0 : (wave == 1 || wave == 2) ? 1 : (wave == 3 || wave == 6) ? 2 : 3;
    const int G = gridDim.x, rounds = (NBATCH * NGRP + 3 * G - 1) / (3 * G);
    for (int rd = 0; rd < rounds; ++rd) {
        const int tk = (rd * G + (int)blockIdx.x) * 3 + ts; const bool active = (ts < 3) && (tk < NBATCH * NGRP);
        const int tkc = active ? tk : 0;
        ssm_round(P, active, role, tkc / NGRP, tkc % NGRP, lds + (ts < 3 ? ts : 0) * SSM_TASK_LDS, lane);
    }
}

typedef att::BlockRef<att::bf16, att::bf16> ABlk;
__device__ __forceinline__ int fox_jlo(const Params& P, int bh, int qb, char* lds) {
    const int tid = opaque_tid(), lane = tid & 63, wave = tid >> 6;
    float* red = (float*)(lds + att::LDS_BYTES);
    const float* qn = (const float*)(P.ws + SM_QNRM) + (size_t)bh * SEQL + qb * 256; const float* kn = (const float*)(P.ws + SM_KNRM) + (size_t)bh * SEQL;
    float mq = (tid < 256) ? qn[tid] : 0.f, mk = 0.f;
    for (int i = tid; i < qb * 256; i += 512) mk = fmaxf(mk, kn[i]);
#pragma unroll
    for (int o = 1; o < 64; o <<= 1) { mq = fmaxf(mq, __shfl_xor(mq, o)); mk = fmaxf(mk, __shfl_xor(mk, o)); }
    if (lane == 0) { red[wave] = mq; red[8 + wave] = mk; }
    __syncthreads();
    float Q2 = 0.f, K2 = 0.f;
#pragma unroll
    for (int w = 0; w < 8; ++w) { Q2 = fmaxf(Q2, red[w]); K2 = fmaxf(K2, red[8 + w]); }
    const float bound = 2.04f * sqrtf(Q2 * K2) * att::SCALE + 30.f;
    const float* FC = (const float*)(P.ws + SM_FCUM) + (size_t)bh * SEQL; const float c0 = FC[qb * 256];
    const bool keep = (lane >= qb * 4) || (c0 - FC[lane < 32 ? 64 * lane + 63 : 2047] >= -bound);
    const unsigned long long m = __ballot(keep);
    const int jlo = __builtin_amdgcn_readfirstlane((int)__builtin_ctzll(m));
    __syncthreads();
    return jlo;
}
__device__ __forceinline__ void fox_item(int vc, int i, int& bh, int& qb) {
    const int gq = vc >> 3, j = vc & 7, e = j * 3 + i;
    const unsigned long long T0 = 7ull | (3ull << 5) | (0ull << 10) | ((7ull | 8ull) << 15) | (4ull << 20) | ((0ull | 8ull) << 25) | ((7ull | 16ull) << 30) | (2ull << 35) | (1ull << 40) | (6ull << 45) | (5ull << 50) | ((0ull | 16ull) << 55);
    const unsigned long long T1 = (6ull | 8ull) | ((4ull | 8ull) << 5) | ((1ull | 8ull) << 10) | ((6ull | 16ull) << 15) | ((3ull | 8ull) << 20) | ((1ull | 16ull) << 25) | ((5ull | 8ull) << 30) | ((4ull | 16ull) << 35) | ((2ull | 8ull) << 40) | ((5ull | 16ull) << 45) | ((3ull | 16ull) << 50) | ((2ull | 16ull) << 55);
    const unsigned code = (unsigned)(((e < 12) ? (T0 >> (5 * e)) : (T1 >> (5 * (e - 12)))) & 31ull);
    qb = code & 7; bh = gq * 3 + (code >> 3);
}
__device__ __forceinline__ void fox_jlo3(const Params& P, int vc, char* lds) {
    const int tid = opaque_tid(), lane = tid & 63, wave = tid >> 6;
    float* red = (float*)(lds + att::LDS_BYTES);
    int bh[3], qb[3]; float mq[3], mk[3];
#pragma unroll
    for (int i = 0; i < 3; ++i) { fox_item(vc, i, bh[i], qb[i]);
        const float* qn = (const float*)(P.ws + SM_QNRM) + (size_t)bh[i] * SEQL + qb[i] * 256; const float* kn = (const float*)(P.ws + SM_KNRM) + (size_t)bh[i] * SEQL;
        mq[i] = (tid < 256) ? qn[tid] : 0.f; mk[i] = 0.f;
#pragma unroll
        for (int k = 0; k < 4; ++k) { const int idx = tid + 512 * k; if (idx < qb[i] * 256) mk[i] = fmaxf(mk[i], kn[idx]); } }
#pragma unroll
    for (int o = 1; o < 64; o <<= 1) {
#pragma unroll
        for (int i = 0; i < 3; ++i) { mq[i] = fmaxf(mq[i], __shfl_xor(mq[i], o)); mk[i] = fmaxf(mk[i], __shfl_xor(mk[i], o)); } }
    if (lane == 0) {
#pragma unroll
        for (int i = 0; i < 3; ++i) { red[32 + 16 * i + wave] = mq[i]; red[32 + 16 * i + 8 + wave] = mk[i]; } }
    __syncthreads();
#pragma unroll
    for (int i = 0; i < 3; ++i) {
        float Q2 = 0.f, K2 = 0.f;
#pragma unroll
        for (int w = 0; w < 8; ++w) { Q2 = fmaxf(Q2, red[32 + 16 * i + w]); K2 = fmaxf(K2, red[32 + 16 * i + 8 + w]); }
        const float bound = 2.04f * sqrtf(Q2 * K2) * att::SCALE + 30.f;
        const float* FC = (const float*)(P.ws + SM_FCUM) + (size_t)bh[i] * SEQL; const float c0 = FC[qb[i] * 256];
        const bool keep = (lane >= qb[i] * 4) || (c0 - FC[lane < 32 ? 64 * lane + 63 : 2047] >= -bound);
        const unsigned long long m = __ballot(keep);
        if (tid == 0) ((int*)red)[16 + i] = (int)__builtin_ctzll(m);
    }
    __syncthreads();
}
template <bool FOX, int LYR> __device__ __forceinline__ bool att_get(const Params& P, int n, ABlk& r, int& skv, char* lds) {
    constexpr int PER = FOX ? 4 : 1;
    const int G = gridDim.x, bx = blockIdx.x;
    const int slot = n / PER, i = n % PER;
    const int vb = bx + slot * G; if (vb >= 256) return false;
    const int vc = (vb & 7) * 32 + (vb >> 3);
    const att::bf16* proj = (const att::bf16*)(P.ws + WS_PROJ); att::bf16* cat = (att::bf16*)(P.ws + WS_CAT);
    if (FOX && i < 3) {
        int bh, qb; fox_item(vc, i, bh, qb); const int b = bh / 12, h = bh % 12;
        const att::bf16* kvb = (const att::bf16*)(P.ws + WS_KVB);
        r.Q = proj + ((size_t)bh * SEQL + qb * 256) * 128; r.K = kvb + (size_t)bh * SEQL * 128; r.V = kvb + (size_t)NTOK * 1536 + (size_t)bh * SEQL * 128;
        r.O = cat + ((size_t)b * SEQL + qb * 256) * 2048 + h * 128; r.G = proj + (size_t)NTOK * 1536 + ((size_t)b * SEQL + qb * 256) * 2048 + h * 128;
        r.FC = (const float*)(P.ws + SM_FCUM) + (size_t)bh * SEQL; r.P0 = qb * 256; skv = SEQL;
        r.JLO = (slot == 0) ? __builtin_amdgcn_readfirstlane(((const int*)(lds + att::LDS_BYTES))[16 + i]) : fox_jlo(P, bh, qb, lds);
    } else {
        const int b = vc >> 5, hm = (vc >> 3) & 3, qb = vc & 7;
        const att::bf16* mkv = (const att::bf16*)(P.ws + WS_MKV) + (size_t)LYR * (2 * NBATCH * NMEM * 512);
        r.Q = proj + (size_t)NTOK * 3584 + ((size_t)(b * 4 + hm) * SEQL + qb * 256) * 128;
        r.K = mkv + (size_t)(b * 4 + hm) * NMEM * 128; r.V = mkv + (size_t)NBATCH * NMEM * 512 + (size_t)(b * 4 + hm) * NMEM * 128;
        r.O = cat + ((size_t)b * SEQL + qb * 256) * 2048 + 1536 + hm * 128; r.G = proj + (size_t)NTOK * 1536 + ((size_t)b * SEQL + qb * 256) * 2048 + 1536 + hm * 128;
        r.FC = nullptr; r.P0 = 256; skv = NMEM; r.JLO = 0;
    }
    return true;
}
template <bool FOX, int LYR> __device__ __forceinline__ void att_phase(const Params& P, char* lds) {
    ABlk cur, nxt; int skv = 0, skvn = 0;
    if (FOX && (int)blockIdx.x < 256) { const int vb = blockIdx.x; fox_jlo3(P, (vb & 7) * 32 + (vb >> 3), lds); }
    if (!att_get<FOX, LYR>(P, 0, cur, skv, lds)) return;
    att::Seam<att::bf16> S;
    att::causal_swa_prime<att::bf16, att::bf16>(cur, 1 << 20, lds, S);
    for (int n = 0;; ++n) {
        const bool more = att_get<FOX, LYR>(P, n + 1, nxt, skvn, lds);
        if (!more) { nxt = cur; skvn = skv; }
        att::causal_swa_block<att::bf16, att::bf16>(cur, nxt, skv, 1 << 20, lds, S);
        if (!more) break;
        cur = nxt; skv = skvn;
    }
}

#define XB_TMO      128
#define XB_XCNT(j)  (256  + 64 * (j))
#define XB_XSUB(j)  (1280 + 64 * (j))
#define XB_XGEN(j)  (2304 + 64 * (j))
#define XB_TOP      3328
#define XB_TOPGEN   3392
#define XCD_BAR_WORDS 3456
#define XB_SPIN_CAP (1u << 18)

__device__ __forceinline__ unsigned xb_ld(unsigned* p)              { return __hip_atomic_load(p, __ATOMIC_RELAXED, __HIP_MEMORY_SCOPE_AGENT); }
__device__ __forceinline__ unsigned xb_add(unsigned* p, unsigned v) { return __hip_atomic_fetch_add(p, v, __ATOMIC_RELAXED, __HIP_MEMORY_SCOPE_AGENT); }
__device__ __forceinline__ unsigned xb_xcc_id() { return (unsigned)__builtin_amdgcn_s_getreg((3 << 11) | 20) & 0xFu; }
#define XB_SPIN(cond, bar) do { unsigned _sp = 0; while (cond) { __builtin_amdgcn_s_sleep(1); \
    if ((++_sp & 255u) == 0u) { if (xb_ld(&(bar)[XB_TMO])) break; if (_sp > XB_SPIN_CAP) { atomicAdd(&(bar)[XB_TMO], 1u); break; } } } } while (0)

struct XcdBarrier {
    unsigned* bar; unsigned x;
    volatile LAS unsigned* st;
};

__device__ __forceinline__ XcdBarrier xcd_barrier_post(unsigned* bar, volatile LAS unsigned* st) {
    XcdBarrier b; b.bar = bar; b.x = xb_xcc_id(); b.st = st;
    if (threadIdx.x == 0) (void)xb_add(&bar[XB_XCNT(b.x)], 1u);
    return b;
}
__device__ __forceinline__ void xcd_barrier_complete(unsigned* bar, unsigned x, unsigned& nloc, unsigned& nx) {
    const unsigned G = gridDim.x * gridDim.y * gridDim.z;
    unsigned sum, cnt, mine, sp = 0u;
    for (;;) {
        sum = 0u; cnt = 0u; mine = 0u;
#pragma unroll
        for (unsigned j = 0; j < 16; ++j) { const unsigned c = xb_ld(&bar[XB_XCNT(j)]); sum += c; cnt += (c > 0u) ? 1u : 0u; mine = (j == x) ? c : mine; }
        if (sum == G) break;
        __builtin_amdgcn_s_sleep(1);
        if ((++sp & 255u) == 0u) { if (xb_ld(&bar[XB_TMO])) break; if (sp > XB_SPIN_CAP) { atomicAdd(&bar[XB_TMO], 1u); break; } }
    }
    nloc = mine > 0u ? mine : 1u; nx = cnt > 0u ? cnt : 1u;
}

__device__ __forceinline__ void xcd_barrier(const XcdBarrier& b) {
    asm volatile("s_waitcnt vmcnt(0)" ::: "memory");
    __syncthreads();
    if (threadIdx.x == 0) {
        unsigned* bar = b.bar;
        __builtin_amdgcn_s_waitcnt(0);
        unsigned nloc = b.st[0], nx = b.st[1];
        if (nloc == 0u) { xcd_barrier_complete(bar, b.x, nloc, nx); b.st[0] = nloc; b.st[1] = nx; }
        const unsigned old = xb_add(&bar[XB_XSUB(b.x)], 1u);
        const unsigned gen = old / nloc;
        if (old + 1u == (gen + 1u) * nloc) {
            __builtin_amdgcn_fence(__ATOMIC_RELEASE, "agent");
            asm volatile("s_waitcnt vmcnt(0)" ::: "memory");
            const unsigned og = xb_add(&bar[XB_TOP], 1u);
            const unsigned tg = og / nx;
            if (og + 1u == (tg + 1u) * nx) xb_add(&bar[XB_TOPGEN], 1u);
            else XB_SPIN(xb_ld(&bar[XB_TOPGEN]) == tg, bar);
            __builtin_amdgcn_fence(__ATOMIC_ACQUIRE, "agent");
            xb_add(&bar[XB_XGEN(b.x)], 1u);
            asm volatile("s_waitcnt vmcnt(0)" ::: "memory");
        } else {
            XB_SPIN(xb_ld(&bar[XB_XGEN(b.x)]) == gen, bar);
            __builtin_amdgcn_fence(__ATOMIC_ACQUIRE, "agent");
            asm volatile("s_waitcnt vmcnt(0)" ::: "memory");
        }
    }
    __syncthreads();
}

#ifndef PH_MASK
#define PH_MASK 0x7ff
#endif
#define PH(k) if constexpr ((PH_MASK >> (k)) & 1)
#ifndef REP_MASK
#define REP_MASK 0
#endif
#define REP(k) for (int rep_ = 0; rep_ <= ((REP_MASK >> (k)) & 1); ++rep_)
__global__ void __launch_bounds__(512, 2) yoco_fwd(Params P) {
    extern __shared__ __attribute__((aligned(16))) unsigned char lds[];
    cg::grid_group grid = cg::this_grid();
    volatile LAS unsigned* bst = (volatile LAS unsigned*)((LAS unsigned char*)lds + (LDS_TOTAL - 64));
    if (threadIdx.x == 0) { bst[0] = 0u; bst[1] = 0u; }
    __syncthreads();
    const XcdBarrier xbar = xcd_barrier_post((unsigned*)(P.ws + WS_BAR), bst);
#define GRID_SYNC() xcd_barrier(xbar)
    const int G = gridDim.x, NGW = G * 8;
#define PHASE_IDS() const int tid = opaque_tid(), lane = tid & 63, wave = __builtin_amdgcn_readfirstlane(tid >> 6), gw = blockIdx.x * 8 + wave; (void)lane; (void)gw
    unsigned char* ws = P.ws;
    float* rstd0 = (float*)(ws + SM_RSTD0); float* rstdm = (float*)(ws + SM_RSTDM); float* rowsq0 = (float*)(ws + SM_ROWSQ0); float* rowsq1 = (float*)(ws + SM_ROWSQ1);
    float* rstd1 = (float*)(ws + SM_RSTD1); float* logf_ = (float*)(ws + SM_LOGF); float* fcum = (float*)(ws + SM_FCUM); float* wft = (float*)(ws + SM_WFT);
    bf16r* xb = (bf16r*)(ws + WS_XB); bf16r* memb = (bf16r*)(ws + WS_MEMB); bf16r* proj = (bf16r*)(ws + WS_PROJ); bf16r* kvb = (bf16r*)(ws + WS_KVB);
    bf16r* cat = (bf16r*)(ws + WS_CAT); bf16r* ob = (bf16r*)(ws + WS_OB); bf16r* mkv = (bf16r*)(ws + WS_MKV);
    LAS unsigned char* glds = (LAS unsigned char*)lds;

    REP(0) {
    PH(0) { PHASE_IDS();
        LAS float* scr = (LAS float*)((LAS unsigned char*)lds + wave * 16384);
        constexpr int I_A = 32 * 128, I_GLU = 24 * 48, I_MK = 32 * 32, I_O = 32 * 64;
        constexpr int NIT = I_A + I_GLU + 2 * I_MK + I_O;
        for (int it = gw; it < NIT; it += NGW) {
            int r = it;
            if (r < I_A) { transpose_item(P.in[I_WINA], P.in[I_PREG], 2048, 4096, (bf16r*)(ws + WS_WINA), 0, scr, r, lane); continue; } r -= I_A;
            if (r < I_GLU) { transpose_item(P.in[I_WGLU], nullptr, 1536, 1536, (bf16r*)(ws + WS_WGLU), 0, scr, r, lane); continue; } r -= I_GLU;
            if (r < I_MK) { transpose_item(P.in[I_WMKV], P.in[I_MEMG], 2048, 1024, (bf16r*)(ws + WS_WMKV0), 0, scr, r, lane); continue; } r -= I_MK;
            if (r < I_MK) { transpose_item(P.in[I_WMKV] + (size_t)2048 * 1024, P.in[I_MEMG] + 2048, 2048, 1024, (bf16r*)(ws + WS_WMKV1), 0, scr, r, lane); continue; } r -= I_MK;
            transpose_item(P.in[I_WOUT], nullptr, 2048, 2048, (bf16r*)(ws + WS_WOUT0), 0, scr, r, lane);
        }
        rows_to_bf16(P.in[I_X], xb, rstd0, gw, NGW, NTOK, lane);
        rows_to_bf16(P.in[I_MEM], memb, rstdm, gw, NGW, NBATCH * NMEM, lane);
        for (int i = blockIdx.x * 512 + tid; i < NTOK; i += G * 512) { rowsq0[i] = 0.f; rowsq1[i] = 0.f; }
        for (int i = blockIdx.x * 512 + tid; i < 2 * 96 * SEQL; i += G * 512) ((float*)(ws + SM_QNRM))[i] = 0.f;
        for (int i = blockIdx.x * 512 + tid; i < 12 * DM; i += G * 512) { const int h = i / DM, k = i % DM; wft[i] = P.in[I_KVG][k] * P.in[I_WFG][k * 12 + h]; }
    }
    if (P.ws == nullptr) grid.sync();
    GRID_SYNC();
    }
    REP(1) {
    PH(1) {
        { pg8::Gemm g{xb, (const bf16r*)(ws + WS_WINA), NTOK, 4096, DM}; pg8::StaticOrder S; S.init(NTOK, 4096, G, (int)blockIdx.x);
          pg8::EpiProj<Sel0> E{rstd0, Sel0{proj}, 11};
          pg8::gemm_phase<pg8::EpiProj<Sel0>, pg8::StaticOrder, true, true>(glds, g, S, E); }
    }
    GRID_SYNC();
    }
    REP(2) {
    PH(2) { PHASE_IDS(); ssm_phase(P, lds, wave, lane);
    __syncthreads(); }
    GRID_SYNC();
    }
    REP(3) {
    PH(3) {
        { pg8::Gemm g{kvb  , (const bf16r*)(ws + WS_WGLU), NTOK, 1536, 1536}; pg8::StaticOrder S; S.init(NTOK, 1536, G, (int)blockIdx.x);
          pg8::EpiGlu E{kvb, proj + (size_t)NTOK * 1536, P.in[I_BGLU], cat};
          pg8::gemm_phase<pg8::EpiGlu, pg8::StaticOrder, true, true>(glds, g, S, E); }
        { pg8::Gemm g{memb, (const bf16r*)(ws + WS_WMKV0), NBATCH * NMEM, 1024, DM}; pg8::StaticOrder S; S.init(NBATCH * NMEM, 1024, G, (int)((blockIdx.x + G - G / 2) % G));
          pg8::EpiProj<SelM> E{rstdm, SelM{mkv}, 8};
          pg8::gemm_phase<pg8::EpiProj<SelM>, pg8::StaticOrder, true, true>(glds, g, S, E); }
        { pg8::Gemm g{memb, (const bf16r*)(ws + WS_WMKV1), NBATCH * NMEM, 1024, DM}; pg8::StaticOrder S; S.init(NBATCH * NMEM, 1024, G, (int)((blockIdx.x + G - G / 2 - 32) % G));
          pg8::EpiProj<SelM> E{rstdm, SelM{mkv + (size_t)2 * NBATCH * NMEM * 512}, 8};
          pg8::gemm_phase<pg8::EpiProj<SelM>, pg8::StaticOrder, true, true>(glds, g, S, E); }
        if ((int)blockIdx.x >= G - G / 4) {
            PHASE_IDS();
            LAS float* scr = (LAS float*)((LAS unsigned char*)lds + wave * 16384);
            constexpr int I_B = 32 * 128, I_KV = 32 * 96, I_O = 32 * 64, NIT2 = I_B + I_KV + I_O;
            const int gw2 = ((int)blockIdx.x - (G - G / 4)) * 8 + wave, NGW2 = (G / 4) * 8;
            for (int it = gw2; it < NIT2; it += NGW2) {
                int r = it;
                if (r < I_B) { transpose_item(P.in[I_WINB], P.in[I_PREG] + 2048, 2048, 4096, (bf16r*)(ws + WS_WKVB), 3072, scr, r, lane); continue; } r -= I_B;
                if (r < I_KV) { transpose_item(P.in[I_WKV], P.in[I_KVG], 2048, 3072, (bf16r*)(ws + WS_WKVB), 0, scr, r, lane); continue; } r -= I_KV;
                transpose_item(P.in[I_WOUT] + (size_t)2048 * 2048, nullptr, 2048, 2048, (bf16r*)(ws + WS_WOUT1), 0, scr, r, lane);
            }
        }
    }
    GRID_SYNC();
    }
    REP(10) {
    PH(10) att_phase<false, 0>(P, (char*)lds);
    GRID_SYNC();
    }
    REP(4) {
    PH(4) { pg8::Gemm g{cat, (const bf16r*)(ws + WS_WOUT0), NTOK, DM, DM}; pg8::StaticOrder S; S.init(NTOK, DM, G, (int)blockIdx.x);
      pg8::EpiOut E{ob, rep_ ? rowsq0 + 65536 * 9 : rowsq0};
      pg8::gemm_phase<pg8::EpiOut, pg8::StaticOrder, true, true>(glds, g, S, E); }
    GRID_SYNC();
    }
    REP(5) {
    PH(5) { PHASE_IDS();
        float* wl = (float*)lds;
        for (int i = tid; i < 12 * DM / 4; i += 512) ((f32x4*)wl)[i] = ((const f32x4*)wft)[i];
        __syncthreads();
        const float* gp = P.in[I_POSTG];
        f32x4 gv[8];
#pragma unroll
        for (int j = 0; j < 8; ++j) gv[j] = ((const f32x4*)gp)[lane + 64 * j];
        const float bfg = (lane < 12) ? P.in[I_BFG][lane] : 0.f;
        u32x2 xv[8]; u32x2 ov[8]; float rq = 0.f;
        if (gw < NTOK) { const u32x2* xp = (const u32x2*)(xb + (size_t)gw * DM) + lane; const u32x2* op = (const u32x2*)(ob + (size_t)gw * DM) + lane; rq = rowsq0[gw];
#pragma unroll
            for (int j = 0; j < 8; ++j) { xv[j] = __builtin_nontemporal_load(xp + 64 * j); ov[j] = __builtin_nontemporal_load(op + 64 * j); } }
        for (int m = gw; m < NTOK; m += NGW) {
            const float rso = 1.0f / sqrtf(rq * (1.0f / DM) + EPSN);
            u32x2 xn[8]; u32x2 on[8]; float rqn = 0.f; const int mn = m + NGW;
            if (mn < NTOK) { const u32x2* xp = (const u32x2*)(xb + (size_t)mn * DM) + lane; const u32x2* op = (const u32x2*)(ob + (size_t)mn * DM) + lane; rqn = rowsq0[mn];
#pragma unroll
                for (int j = 0; j < 8; ++j) { xn[j] = __builtin_nontemporal_load(xp + 64 * j); on[j] = __builtin_nontemporal_load(op + 64 * j); } }
            u32x2* hb = (u32x2*)(xb + (size_t)m * DM) + lane;
            f32x4 hv[8]; float s = 0.f;
#pragma unroll
            for (int j = 0; j < 8; ++j) {
                f32x4 h; h[0] = pg8::bf_lo(xv[j].x) + pg8::bf_lo(ov[j].x) * rso * gv[j][0]; h[1] = pg8::bf_hi(xv[j].x) + pg8::bf_hi(ov[j].x) * rso * gv[j][1];
                h[2] = pg8::bf_lo(xv[j].y) + pg8::bf_lo(ov[j].y) * rso * gv[j][2]; h[3] = pg8::bf_hi(xv[j].y) + pg8::bf_hi(ov[j].y) * rso * gv[j][3];
                hv[j] = h; s += (h[0] * h[0] + h[1] * h[1]) + (h[2] * h[2] + h[3] * h[3]);
                u32x2 w; w.x = pkbf(h[0], h[1]); w.y = pkbf(h[2], h[3]); hb[64 * j] = w; }
            if (mn < NTOK) {
#pragma unroll
                for (int j = 0; j < 8; ++j) { xv[j] = xn[j]; ov[j] = on[j]; } rq = rqn; }
            s = wave_sum(s); const float rs1 = 1.0f / sqrtf(s * (1.0f / DM) + EPSN);
            if (lane == 0) rstd1[m] = rs1;
            float dh[12];
#pragma unroll
            for (int h = 0; h < 12; ++h) {
                f32x4 wa[8];
#pragma unroll
                for (int j = 0; j < 8; ++j) wa[j] = *(const f32x4*)(wl + h * DM + (lane + 64 * j) * 4);
                __builtin_amdgcn_sched_barrier(0);
                float da = 0.f;
#pragma unroll
                for (int j = 0; j < 8; ++j) da += (hv[j][0] * wa[j][0] + hv[j][1] * wa[j][1]) + (hv[j][2] * wa[j][2] + hv[j][3] * wa[j][3]);
                dh[h] = da;
                __builtin_amdgcn_sched_barrier(0);
            }
#pragma unroll
            for (int o = 1; o < 64; o <<= 1) {
#pragma unroll
                for (int h = 0; h < 12; ++h) dh[h] += __shfl_xor(dh[h], o); }
            float mine = 0.f;
#pragma unroll
            for (int h = 0; h < 12; ++h) if (lane == h) mine = dh[h];
            if (lane < 12) { const float a = mine * rs1 + bfg; const float lf = fminf(a, 0.f) - __logf(1.f + __expf(-fabsf(a)));
                const int b = m >> 11, sidx = m & 2047; logf_[((size_t)(b * 12 + lane)) * SEQL + sidx] = lf; }
        }
    }
    GRID_SYNC();
    }
    REP(6) {
    PH(6) { PHASE_IDS();
        if (wave == 0) for (int rwi = blockIdx.x; rwi < NBATCH * 12; rwi += G) {
            const float* src = logf_ + (size_t)rwi * SEQL + lane * 32; float* dst = fcum + (size_t)rwi * SEQL + lane * 32;
            float v[32]; float run = 0.f;
#pragma unroll
            for (int q = 0; q < 8; ++q) { const f32x4 t = ((const f32x4*)src)[q]; v[4 * q] = t[0]; v[4 * q + 1] = t[1]; v[4 * q + 2] = t[2]; v[4 * q + 3] = t[3]; }
#pragma unroll
            for (int e = 0; e < 32; ++e) { run += v[e]; v[e] = run; }
            float incl = run;
#pragma unroll
            for (int o = 1; o < 64; o <<= 1) { const float t = __shfl_up(incl, o); if (lane >= o) incl += t; }
            const float excl = incl - run;
#pragma unroll
            for (int q = 0; q < 8; ++q) { f32x4 t = {v[4 * q] + excl, v[4 * q + 1] + excl, v[4 * q + 2] + excl, v[4 * q + 3] + excl}; ((f32x4*)dst)[q] = t; }
        }
        pg8::Gemm g{xb, (const bf16r*)(ws + WS_WKVB), NTOK, 7168, DM}; pg8::StaticOrder S; S.init(NTOK, 7168, G, (int)blockIdx.x);
        pg8::EpiProj<Sel1> E{rstd1, Sel1{kvb, proj, (float*)(ws + SM_QNRM), (float*)(ws + SM_KNRM)}, 11};
        pg8::gemm_phase<pg8::EpiProj<Sel1>, pg8::StaticOrder, true, true>(glds, g, S, E);
    }
    GRID_SYNC();
    }
    REP(7) {
    PH(7) att_phase<true, 1>(P, (char*)lds);
    GRID_SYNC();
    }
    REP(8) {
    PH(8) { pg8::Gemm g{cat, (const bf16r*)(ws + WS_WOUT1), NTOK, DM, DM}; pg8::StaticOrder S; S.init(NTOK, DM, G, (int)blockIdx.x);
      pg8::EpiOut E{ob, rep_ ? rowsq0 + 65536 * 9 : rowsq1};
      pg8::gemm_phase<pg8::EpiOut, pg8::StaticOrder, true, true>(glds, g, S, E); }
    GRID_SYNC();
    }
    REP(9) {
    PH(9) { PHASE_IDS();
        const float* gp = P.in[I_POSTG] + DM;
        f32x4 gv[8];
#pragma unroll
        for (int j = 0; j < 8; ++j) gv[j] = ((const f32x4*)gp)[lane + 64 * j];
        u32x2 hv[8]; u32x2 ov[8]; float rq = 0.f;
        if (gw < NTOK) { const u32x2* hp = (const u32x2*)(xb + (size_t)gw * DM) + lane; const u32x2* op = (const u32x2*)(ob + (size_t)gw * DM) + lane; rq = rowsq1[gw];
#pragma unroll
            for (int j = 0; j < 8; ++j) { hv[j] = __builtin_nontemporal_load(hp + 64 * j); ov[j] = __builtin_nontemporal_load(op + 64 * j); } }
        for (int m = gw; m < NTOK; m += NGW) {
            const float rso = 1.0f / sqrtf(rq * (1.0f / DM) + EPSN);
            u32x2 hn[8]; u32x2 on[8]; float rqn = 0.f; const int mn = m + NGW;
            if (mn < NTOK) { const u32x2* hp2 = (const u32x2*)(xb + (size_t)mn * DM) + lane; const u32x2* op = (const u32x2*)(ob + (size_t)mn * DM) + lane; rqn = rowsq1[mn];
#pragma unroll
                for (int j = 0; j < 8; ++j) { hn[j] = __builtin_nontemporal_load(hp2 + 64 * j); on[j] = __builtin_nontemporal_load(op + 64 * j); } }
            f32x4* hp = (f32x4*)(P.out + (size_t)m * DM) + lane;
#pragma unroll
            for (int j = 0; j < 8; ++j) { f32x4 h;
                h[0] = pg8::bf_lo(hv[j].x) + pg8::bf_lo(ov[j].x) * rso * gv[j][0]; h[1] = pg8::bf_hi(hv[j].x) + pg8::bf_hi(ov[j].x) * rso * gv[j][1];
                h[2] = pg8::bf_lo(hv[j].y) + pg8::bf_lo(ov[j].y) * rso * gv[j][2]; h[3] = pg8::bf_hi(hv[j].y) + pg8::bf_hi(ov[j].y) * rso * gv[j][3];
                __builtin_nontemporal_store(h, hp + 64 * j); }
            if (mn < NTOK) {
#pragma unroll
                for (int j = 0; j < 8; ++j) { hv[j] = hn[j]; ov[j] = on[j]; } rq = rqn; }
        }
    }
    }
}

extern "C" void kernel_launch(void* const* d_in, const int* in_sizes, int n_in, void* d_out, int out_size, void* d_ws, size_t ws_size, hipStream_t stream) {
    static int grid = 0;
    if (grid == 0) {
        if (n_in != 23 || out_size != NTOK * DM || ws_size < WS_END) { fprintf(stderr, "kernel_launch: unexpected shapes: n_in %d out %d ws %zu (need %zu)\n", n_in, out_size, ws_size, (size_t)WS_END); grid = -1; return; }
        int dev = 0, cus = 0, per_cu = 0;
        (void)hipGetDevice(&dev); (void)hipDeviceGetAttribute(&cus, hipDeviceAttributeMultiprocessorCount, dev);
        if (hipFuncSetAttribute((const void*)yoco_fwd, hipFuncAttributeMaxDynamicSharedMemorySize, LDS_TOTAL) != hipSuccess) { fprintf(stderr, "kernel_launch: hipFuncSetAttribute failed\n"); grid = -1; return; }
        if (hipOccupancyMaxActiveBlocksPerMultiprocessor(&per_cu, (const void*)yoco_fwd, 512, LDS_TOTAL) != hipSuccess || per_cu < 1) { fprintf(stderr, "kernel_launch: occupancy query says %d\n", per_cu); per_cu = 1; }
        (void)hipGetLastError();
        grid = cus * (per_cu > 1 ? 1 : per_cu);
        if (grid <= 0) grid = 256;
    }
    if (grid < 0) return;
    if (hipMemsetAsync((char*)d_ws + WS_BAR, 0, 16384, stream) != hipSuccess) { fprintf(stderr, "kernel_launch: hipMemsetAsync failed\n"); return; }
    Params p{};
    for (int i = 0; i < 23; ++i) p.in[i] = (const float*)d_in[i];
    p.out = (float*)d_out; p.ws = (unsigned char*)d_ws;
    void* args[] = {&p};
    hipError_t e = hipLaunchCooperativeKernel((const void*)yoco_fwd, dim3(grid), dim3(512), args, LDS_TOTAL, stream);
    if (e != hipSuccess) fprintf(stderr, "cooperative launch failed: %s (grid %d)\n", hipGetErrorString(e), grid);
}
```

```cpp
#include <hip/hip_runtime.h>
#include <hip/hip_bf16.h>
#include <hip/hip_cooperative_groups.h>
#include <cstdio>
#include <cstdint>
namespace cg = cooperative_groups;
__device__ __forceinline__ int opaque_tid() { int t = threadIdx.x; asm volatile("" : "+v"(t)); return t; }
namespace pg8 {
#define PG8_LAS __attribute__((address_space(3)))
typedef unsigned short bf16_t;
typedef short bf16x8 __attribute__((ext_vector_type(8)));
typedef float f32x4 __attribute__((ext_vector_type(4)));
typedef unsigned u32x4 __attribute__((ext_vector_type(4)));
constexpr int BM = 256, BK = 64, HALF = 128, HTB = HALF * BK * 2  , STAGE_BYTES = 8 * HTB, NXCD = 8, WGM = 4;

__host__ __device__ __forceinline__ int lds_byte(int r, int c) { const int st = (r >> 4) * 2 + (c >> 5), rr = r & 15, cc = c & 31, ob = rr * 64 + cc * 2; return st * 1024 + (ob ^ (((ob >> 9) & 1) << 5)); }
__host__ __device__ __forceinline__ void stage_rc(int b, int& R, int& C) { const int st = b / 1024, sb = b % 1024, swz = sb ^ (((sb >> 9) & 1) << 5); R = (st >> 1) * 16 + swz / 64; C = (st & 1) * 32 + (swz % 64) / 2; }
__host__ __device__ __forceinline__ int perm32(int rho) { const int n = rho >> 4, i = rho & 15; return 8 * (i >> 2) + 4 * n + (i & 3); }

struct Unit { int pm, pn; };
struct Gemm { const bf16_t* A; const bf16_t* Bt; int M, N, K; };

struct StaticOrder {
    int nM, nN, nwg, G, c;
    __host__ __device__ void init(int M, int N, int G_, int c_) { nM = M / BM; nN = N / BM; nwg = nM * nN; G = G_; c = c_; }
    __host__ __device__ bool next(int i, Unit& u) const {
        const long L = (long)i * G + c; if (L >= nwg) return false;
        int wgid = (int)L; { const int q = nwg / NXCD, r = nwg % NXCD, xcd = wgid % NXCD, off = wgid / NXCD; wgid = (xcd < r ? xcd * (q + 1) : r * (q + 1) + (xcd - r) * q) + off; }
        const int nig = WGM * nN, gid = wgid / nig, fm = gid * WGM, gsz = (nM - fm) < WGM ? (nM - fm) : WGM;
        u.pm = fm + ((wgid % nig) % gsz); u.pn = (wgid % nig) / gsz; return true;
    }
    __device__ __forceinline__ void a_ready(const Unit&) const {}
    __device__ __forceinline__ void done(const Unit&) const {}
};

__device__ __forceinline__ unsigned cvt_pk_bf16(float lo, float hi) { unsigned r; asm volatile("v_cvt_pk_bf16_f32 %0, %1, %2" : "=v"(r) : "v"(lo), "v"(hi)); return r; }
__device__ __forceinline__ float sigmoid_f(float v) { return __builtin_amdgcn_rcpf(1.f + __builtin_amdgcn_exp2f(-1.4426950408889634f * v)); }
__device__ __forceinline__ float silu_f(float v) { return v * sigmoid_f(v); }
__device__ __forceinline__ float bf_lo(unsigned w) { return __uint_as_float(w << 16); }
__device__ __forceinline__ float bf_hi(unsigned w) { return __uint_as_float(w & 0xffff0000u); }

__device__ __forceinline__ float xfq_sum(float v) {
    { auto r = __builtin_amdgcn_permlane16_swap(__float_as_uint(v), __float_as_uint(v), false, false); v = __uint_as_float(r[0]) + __uint_as_float(r[1]); }
    { auto r = __builtin_amdgcn_permlane32_swap(__float_as_uint(v), __float_as_uint(v), false, false); v = __uint_as_float(r[0]) + __uint_as_float(r[1]); }
    return v;
}
struct SecInfo { bf16_t* dst; int start; int ld; int nh; int act; float* nrm; };
template <class Sel> struct EpiProj {
    static constexpr bool PERM = true, AFTER_DRAIN = false;
    const float* rstd; Sel sel; int lgS;
    __device__ __forceinline__ void operator()(const f32x4 (&acc)[2][2][4][2], const Unit& u, int wr, int wc, int fr, int fq) const {
        const int row0 = u.pm * BM + wr * 64 + fr, cin = wc * 32 + 8 * fq;
        float rsv[2][4];
#pragma unroll
        for (int ai = 0; ai < 2; ++ai)
#pragma unroll
            for (int m = 0; m < 4; ++m) rsv[ai][m] = rstd[row0 + ai * HALF + m * 16];
#pragma unroll
        for (int bj = 0; bj < 2; ++bj) {
            const int cs = u.pn * BM + bj * HALF; const SecInfo si = sel(cs);
#pragma unroll
            for (int ai = 0; ai < 2; ++ai)
#pragma unroll
                for (int m = 0; m < 4; ++m) {
                    const int row = row0 + ai * HALF + m * 16; const float rs = rsv[ai][m];
                    f32x4 v0 = acc[ai][bj][m][0] * rs, v1 = acc[ai][bj][m][1] * rs;
                    if (si.act) {
#pragma unroll
                        for (int e = 0; e < 4; ++e) { v0[e] = silu_f(v0[e]); v1[e] = silu_f(v1[e]); } }
                    bf16_t* p;
                    if (si.nh) { const int b = row >> lgS, s = row & ((1 << lgS) - 1); const size_t hr = (((size_t)(b * si.nh + ((cs - si.start) >> 7))) << lgS) + s; p = si.dst + hr * 128 + cin;
                        if (si.nrm) { float q = (v0[0] * v0[0] + v0[1] * v0[1]) + (v0[2] * v0[2] + v0[3] * v0[3]) + (v1[0] * v1[0] + v1[1] * v1[1]) + (v1[2] * v1[2] + v1[3] * v1[3]);
                            q = xfq_sum(q); if (fq == 0) atomicAdd(si.nrm + hr, q); } }
                    else p = si.dst + (size_t)row * si.ld + (cs - si.start) + cin;
                    u32x4 w; w.x = cvt_pk_bf16(v0[0], v0[1]); w.y = cvt_pk_bf16(v0[2], v0[3]); w.z = cvt_pk_bf16(v1[0], v1[1]); w.w = cvt_pk_bf16(v1[2], v1[3]);
                    *(u32x4*)p = w;
                }
        }
    }
};
struct EpiGlu {
    static constexpr bool PERM = true, AFTER_DRAIN = false;
    const bf16_t* yg; const bf16_t* sz; const float* bias; bf16_t* cat;
    __device__ __forceinline__ void operator()(const f32x4 (&acc)[2][2][4][2], const Unit& u, int wr, int wc, int fr, int fq) const {
        const int row0 = u.pm * BM + wr * 64 + fr, col0 = u.pn * BM + wc * 32 + 8 * fq;
#pragma unroll
        for (int bj = 0; bj < 2; ++bj) {
            const int col = col0 + bj * HALF; const f32x4 b0 = *(const f32x4*)(bias + col), b1 = *(const f32x4*)(bias + col + 4);
#pragma unroll
            for (int ai = 0; ai < 2; ++ai) {
                u32x4 yv[4], zv[4];
#pragma unroll
                for (int m = 0; m < 4; ++m) { const int row = row0 + ai * HALF + m * 16;
                    yv[m] = __builtin_nontemporal_load((const u32x4*)(yg + (size_t)row * 1536 + col)); zv[m] = __builtin_nontemporal_load((const u32x4*)(sz + (size_t)row * 2048 + col)); }
#pragma unroll
                for (int m = 0; m < 4; ++m) {
                    const int row = row0 + ai * HALF + m * 16;
                    const u32x4 y = yv[m], z = zv[m];
                    const f32x4 g0 = acc[ai][bj][m][0] + b0, g1 = acc[ai][bj][m][1] + b1;
                    float o[8];
                    o[0] = bf_lo(y.x) * bf_lo(z.x) * sigmoid_f(g0[0]); o[1] = bf_hi(y.x) * bf_hi(z.x) * sigmoid_f(g0[1]);
                    o[2] = bf_lo(y.y) * bf_lo(z.y) * sigmoid_f(g0[2]); o[3] = bf_hi(y.y) * bf_hi(z.y) * sigmoid_f(g0[3]);
                    o[4] = bf_lo(y.z) * bf_lo(z.z) * sigmoid_f(g1[0]); o[5] = bf_hi(y.z) * bf_hi(z.z) * sigmoid_f(g1[1]);
                    o[6] = bf_lo(y.w) * bf_lo(z.w) * sigmoid_f(g1[2]); o[7] = bf_hi(y.w) * bf_hi(z.w) * sigmoid_f(g1[3]);
                    u32x4 w; w.x = cvt_pk_bf16(o[0], o[1]); w.y = cvt_pk_bf16(o[2], o[3]); w.z = cvt_pk_bf16(o[4], o[5]); w.w = cvt_pk_bf16(o[6], o[7]);
                    *(u32x4*)(cat + (size_t)row * 2048 + col) = w;
                }
            }
        }
    }
};
struct EpiOut {
    static constexpr bool PERM = true, AFTER_DRAIN = false;
    bf16_t* o; float* rowsq;
    __device__ __forceinline__ void operator()(const f32x4 (&acc)[2][2][4][2], const Unit& u, int wr, int wc, int fr, int fq) const {
        const int row0 = u.pm * BM + wr * 64 + fr, col0 = u.pn * BM + wc * 32 + 8 * fq;
#pragma unroll
        for (int ai = 0; ai < 2; ++ai)
#pragma unroll
            for (int m = 0; m < 4; ++m) {
                const int row = row0 + ai * HALF + m * 16; float s = 0.f;
#pragma unroll
                for (int bj = 0; bj < 2; ++bj) {
                    const f32x4 v0 = acc[ai][bj][m][0], v1 = acc[ai][bj][m][1];
                    s += (v0[0] * v0[0] + v0[1] * v0[1]) + (v0[2] * v0[2] + v0[3] * v0[3]) + (v1[0] * v1[0] + v1[1] * v1[1]) + (v1[2] * v1[2] + v1[3] * v1[3]);
                    u32x4 w; w.x = cvt_pk_bf16(v0[0], v0[1]); w.y = cvt_pk_bf16(v0[2], v0[3]); w.z = cvt_pk_bf16(v1[0], v1[1]); w.w = cvt_pk_bf16(v1[2], v1[3]);
                    *(u32x4*)(o + (size_t)row * 2048 + col0 + bj * HALF) = w;
                }
                s = xfq_sum(s);
                if (fq == 0) atomicAdd(rowsq + row, s);
            }
    }
};

template <class Epi, class Sched, bool ALIGN_EPI = false, bool SP2 = false>
__device__ __forceinline__ void gemm_phase(PG8_LAS unsigned char* lds, const Gemm g, const Sched& S, const Epi& E) {
    const int tid = opaque_tid(), wid = __builtin_amdgcn_readfirstlane(tid >> 6), lane = tid & 63, wr = wid >> 2, wc = wid & 3, fr = lane & 15, fq = lane >> 4;
    const int K = g.K, nt = K / BK;
    unsigned voffA[2], voffB[2];
#pragma unroll
    for (int i = 0; i < 2; ++i) { int R, C; stage_rc(tid * 16 + i * 8192, R, C); const int Rb = Epi::PERM ? ((R & ~31) + perm32(R & 31)) : R;
        voffA[i] = (unsigned)(R * K + C) * 2u; voffB[i] = (unsigned)(Rb * K + C) * 2u; }
    const size_t kstep = (size_t)(BK * 2);
    const size_t hstep = (size_t)HALF * K * 2;
    const size_t tstep = 2 * hstep;
    const unsigned ldsw = (unsigned)wid * 1024u;
    const int aoff = lds_byte(wr * 64 + fr, fq * 8), boff = lds_byte(wc * 32 + fr, fq * 8);
#define PG8_SA(b, h) (((b) * 2 + (h)) * HTB)
#define PG8_SB(b, h) ((4 + (b) * 2 + (h)) * HTB)
#define PG8_STAGE(bufoff, gbase, voff) do { _Pragma("unroll") for (int _i = 0; _i < 2; ++_i) \
        __builtin_amdgcn_global_load_lds((const unsigned*)((const char*)(gbase) + (voff)[_i]), (PG8_LAS unsigned*)(lds + (bufoff) + ldsw + _i * 8192), 16, 0, 0); } while (0)
#define PG8_LDA(dst, b, h) do { _Pragma("unroll") for (int m = 0; m < 4; ++m) _Pragma("unroll") for (int k = 0; k < 2; ++k) dst[m][k] = *(const PG8_LAS bf16x8*)(lds + PG8_SA(b, h) + aoff + m * 2048 + k * 1024); } while (0)
#define PG8_LDB(dst, b, h) do { _Pragma("unroll") for (int n = 0; n < 2; ++n) _Pragma("unroll") for (int k = 0; k < 2; ++k) dst[n][k] = *(const PG8_LAS bf16x8*)(lds + PG8_SB(b, h) + boff + n * 2048 + k * 1024); } while (0)
#define PG8_MMA(ai, bj, At, Bt) do { __builtin_amdgcn_s_setprio(1); _Pragma("unroll") for (int m = 0; m < 4; ++m) _Pragma("unroll") for (int n = 0; n < 2; ++n) _Pragma("unroll") for (int k = 0; k < 2; ++k) \
        acc[ai][bj][m][n] = __builtin_amdgcn_mfma_f32_16x16x32_bf16(Bt[n][k], At[m][k], acc[ai][bj][m][n], 0, 0, 0); __builtin_amdgcn_s_setprio(0); } while (0)
#define PG8_WAIT_V(n) asm volatile("s_waitcnt vmcnt(" #n ")" ::: "memory")
#define PG8_WAIT_L(n) asm volatile("s_waitcnt lgkmcnt(" #n ")" ::: "memory")
#define PG8_BAR __builtin_amdgcn_s_barrier()
#define PG8_SCHED __builtin_amdgcn_sched_barrier(0)
    Unit cur, nxt; int ui = 0;
    if (!S.next(0, cur)) return;
    f32x4 acc[2][2][4][2];
#pragma unroll
    for (int a = 0; a < 2; ++a)
#pragma unroll
        for (int b = 0; b < 2; ++b)
#pragma unroll
            for (int m = 0; m < 4; ++m)
#pragma unroll
                for (int n = 0; n < 2; ++n) acc[a][b][m][n] = (f32x4){0.f, 0.f, 0.f, 0.f};
    bf16x8 At[4][2], B0[2][2], B1[2][2];
    const char* cA = (const char*)g.A + (size_t)cur.pm * tstep; const char* cB = (const char*)g.Bt + (size_t)cur.pn * tstep;
    S.a_ready(cur);
    if constexpr (SP2) {
        PG8_STAGE(PG8_SB(0, 0), cB, voffB); PG8_STAGE(PG8_SB(0, 1), cB + hstep, voffB); PG8_STAGE(PG8_SA(0, 0), cA, voffA); PG8_STAGE(PG8_SA(0, 1), cA + hstep, voffA);
        if (wr == 1) PG8_BAR;
        PG8_WAIT_V(2); PG8_BAR;
        PG8_STAGE(PG8_SB(1, 0), cB + kstep, voffB); PG8_STAGE(PG8_SA(1, 0), cA + kstep, voffA); PG8_STAGE(PG8_SB(1, 1), cB + hstep + kstep, voffB);
        PG8_WAIT_V(6); PG8_BAR;
    } else {
        PG8_STAGE(PG8_SB(0, 0), cB, voffB); PG8_STAGE(PG8_SA(0, 0), cA, voffA); PG8_STAGE(PG8_SB(0, 1), cB + hstep, voffB); PG8_STAGE(PG8_SA(0, 1), cA + hstep, voffA);
        if (wr == 1) PG8_BAR;
        PG8_WAIT_V(4); PG8_BAR;
        PG8_STAGE(PG8_SB(1, 0), cB + kstep, voffB); PG8_STAGE(PG8_SA(1, 0), cA + kstep, voffA); PG8_STAGE(PG8_SB(1, 1), cB + hstep + kstep, voffB);
        PG8_WAIT_V(6); PG8_BAR;
    }
    for (;;) {
        const bool has_next = S.next(ui + 1, nxt);
        const char* nA = has_next ? (const char*)g.A + (size_t)nxt.pm * tstep : cA; const char* nB = has_next ? (const char*)g.Bt + (size_t)nxt.pn * tstep : cB;
        for (int t = 0; t < nt; t += 2) {
            const bool last = (t == nt - 2);
            const char* a1 = cA + (size_t)(t + 1) * kstep;
            const char* a2 = last ? nA : cA + (size_t)(t + 2) * kstep; const char* b2 = last ? nB : cB + (size_t)(t + 2) * kstep;
            const char* a3 = a2 + kstep; const char* b3 = b2 + kstep;
            if (last && has_next) S.a_ready(nxt);
            if constexpr (SP2) {
            PG8_LDB(B0, 0, 0); PG8_LDB(B1, 0, 1); PG8_SCHED; PG8_LDA(At, 0, 0); PG8_STAGE(PG8_SA(1, 1), a1 + hstep, voffA);
            PG8_WAIT_V(8); PG8_WAIT_L(0); PG8_BAR; PG8_MMA(0, 0, At, B0); PG8_MMA(0, 1, At, B1); PG8_BAR; PG8_SCHED;
            PG8_LDA(At, 0, 1); PG8_STAGE(PG8_SB(0, 0), b2, voffB); PG8_STAGE(PG8_SB(0, 1), b2 + hstep, voffB); PG8_STAGE(PG8_SA(0, 0), a2, voffA);
            PG8_WAIT_V(8); PG8_WAIT_L(0); PG8_BAR; PG8_MMA(1, 0, At, B0); PG8_MMA(1, 1, At, B1); PG8_BAR; PG8_SCHED;
            PG8_LDB(B0, 1, 0); PG8_LDB(B1, 1, 1); PG8_SCHED; PG8_LDA(At, 1, 0); PG8_STAGE(PG8_SA(0, 1), a2 + hstep, voffA);
            PG8_WAIT_V(8); PG8_WAIT_L(0); PG8_BAR; PG8_MMA(0, 0, At, B0); PG8_MMA(0, 1, At, B1); PG8_BAR; PG8_SCHED;
            PG8_LDA(At, 1, 1); PG8_STAGE(PG8_SB(1, 0), b3, voffB); PG8_STAGE(PG8_SB(1, 1), b3 + hstep, voffB); PG8_STAGE(PG8_SA(1, 0), a3, voffA);
            PG8_WAIT_V(8); PG8_WAIT_L(0); PG8_BAR; PG8_MMA(1, 0, At, B0); PG8_MMA(1, 1, At, B1); PG8_BAR; PG8_SCHED;
            } else {
            PG8_LDB(B0, 0, 0); PG8_SCHED; PG8_LDA(At, 0, 0); PG8_STAGE(PG8_SA(1, 1), a1 + hstep, voffA);
            PG8_WAIT_L(8); PG8_BAR; PG8_WAIT_L(0); PG8_MMA(0, 0, At, B0); PG8_BAR; PG8_SCHED;
            PG8_LDB(B1, 0, 1); PG8_STAGE(PG8_SB(0, 0), b2, voffB);
            PG8_BAR; PG8_WAIT_L(0); PG8_MMA(0, 1, At, B1); PG8_BAR;
            PG8_LDA(At, 0, 1); PG8_STAGE(PG8_SA(0, 0), a2, voffA);
            PG8_BAR; PG8_WAIT_L(0); PG8_MMA(1, 0, At, B0); PG8_BAR; PG8_SCHED;
            PG8_STAGE(PG8_SB(0, 1), b2 + hstep, voffB);
            PG8_WAIT_V(6); PG8_BAR; PG8_MMA(1, 1, At, B1); PG8_BAR;
            PG8_LDB(B0, 1, 0); PG8_SCHED; PG8_LDA(At, 1, 0); PG8_STAGE(PG8_SA(0, 1), a2 + hstep, voffA);
            PG8_WAIT_L(8); PG8_BAR; PG8_WAIT_L(0); PG8_MMA(0, 0, At, B0); PG8_BAR; PG8_SCHED;
            PG8_LDB(B1, 1, 1); PG8_STAGE(PG8_SB(1, 0), b3, voffB);
            PG8_BAR; PG8_WAIT_L(0); PG8_MMA(0, 1, At, B1); PG8_BAR;
            PG8_LDA(At, 1, 1); PG8_STAGE(PG8_SA(1, 0), a3, voffA);
            PG8_BAR; PG8_WAIT_L(0); PG8_MMA(1, 0, At, B0); PG8_BAR; PG8_SCHED;
            PG8_STAGE(PG8_SB(1, 1), b3 + hstep, voffB);
            PG8_WAIT_V(6); PG8_BAR; PG8_MMA(1, 1, At, B1); PG8_BAR;
            }
        }
        if constexpr (ALIGN_EPI) { if (wr == 0) PG8_BAR; }
        if constexpr (!Epi::AFTER_DRAIN) { E(acc, cur, wr, wc, fr, fq); S.done(cur); }
        if (!has_next) break;
#pragma unroll
        for (int a = 0; a < 2; ++a)
#pragma unroll
            for (int b = 0; b < 2; ++b)
#pragma unroll
                for (int m = 0; m < 4; ++m)
#pragma unroll
                    for (int n = 0; n < 2; ++n) acc[a][b][m][n] = (f32x4){0.f, 0.f, 0.f, 0.f};
        cur = nxt; cA = nA; cB = nB; ++ui;
        if constexpr (ALIGN_EPI) { if (wr == 1) PG8_BAR; }
    }
    PG8_WAIT_V(0);
    if constexpr (!ALIGN_EPI) { if (wr == 0) PG8_BAR; }
    PG8_BAR;
    if constexpr (Epi::AFTER_DRAIN) { E.fused(acc, cur, wr, wc, fr, fq, lds, wid, lane); S.done(cur); }
#undef PG8_SA
#undef PG8_SB
#undef PG8_STAGE
#undef PG8_LDA
#undef PG8_LDB
#undef PG8_MMA
#undef PG8_WAIT_V
#undef PG8_WAIT_L
#undef PG8_BAR
#undef PG8_SCHED
}
}
namespace att {
constexpr int D = 128; constexpr bool WSKIP = false; constexpr float THR = 8.f;
constexpr float SCALE = 0.08838834764831845f;
constexpr int NW = 8, QBLK = 32, KVBLK = 64, QB = NW * QBLK;
constexpr int SHM_V = KVBLK * D * 2, SHM_K = KVBLK * D * 2;
constexpr int FB_OFF = 2 * SHM_V + 2 * SHM_K + NW * 64 * 4;
constexpr int QL_OFF = FB_OFF + 2048 * 4;
constexpr int LDS_BYTES = QL_OFF + NW * QBLK * D * 2;
constexpr int LDO = 2048; constexpr float INV_SCALE = 11.313708498984761f;

using bf16 = __hip_bfloat16;
typedef short bf16x8 __attribute__((ext_vector_type(8)));
typedef short s16x4 __attribute__((ext_vector_type(4)));
typedef float f32x16 __attribute__((ext_vector_type(16)));
typedef float f32x4 __attribute__((ext_vector_type(4)));
typedef unsigned u32x4 __attribute__((ext_vector_type(4)));
template <class A, class Bt> struct same_t { static constexpr bool v = false; };
template <class A> struct same_t<A, A> { static constexpr bool v = true; };

#define KSWZ(row, colB) ((row) * 256 + ((colB) ^ (((row) & 7) << 4)))
#define SBAR() __builtin_amdgcn_sched_barrier(0)
__device__ __forceinline__ int v_st(int k, int c) { const int kk = (k & ~0xC) | ((k & 4) << 1) | ((k & 8) >> 1); return ((kk >> 3) * 4 + (c >> 5)) * 512 + ((kk & 7) * 32 + (c & 31)) * 2; }
__device__ __forceinline__ int v_rd_base(int lane) { return ((lane & 3) << 3) | (((lane >> 2) & 3) << 6) | (((lane >> 4) & 1) << 5) | (((lane >> 5) & 1) << 8); }
constexpr int v_rd_off(int d0, int ks, int half) { return d0 * 512 + ks * 4096 + half * 2048; }
__device__ __forceinline__ int crow(int r, int hi) { return (r & 3) + 8 * (r >> 2) + 4 * hi; }
__device__ __forceinline__ unsigned cvtpk(float lo, float hi) {
    unsigned r; asm volatile("v_cvt_pk_bf16_f32 %0, %1, %2" : "=v"(r) : "v"(lo), "v"(hi)); return r;
}
__device__ __forceinline__ bf16x8 pack8(f32x4 a, f32x4 b) {
    u32x4 w = {cvtpk(a[0], a[1]), cvtpk(a[2], a[3]), cvtpk(b[0], b[1]), cvtpk(b[2], b[3])};
    return *reinterpret_cast<bf16x8*>(&w);
}
template <class T> __device__ __forceinline__ bf16x8 load8(const T* p) {
    if constexpr (same_t<T, float>::v) { return pack8(*(const f32x4*)p, *(const f32x4*)(p + 4)); }
    else { return *reinterpret_cast<const bf16x8*>(p); }
}
__device__ __forceinline__ void mask_tile(f32x16& p0, f32x16& p1, int dq, unsigned W) {
    const float NEG = -__builtin_inff();
#pragma unroll
    for (int r = 0; r < 16; ++r) {
        const int c = (r & 3) + 8 * (r >> 2);
        if ((unsigned)(dq - c) >= W) p0[r] = NEG;
        if ((unsigned)(dq - c - 32) >= W) p1[r] = NEG;
    }
}
__device__ __forceinline__ void partialSM(f32x16& p0, f32x16& p1, float& m_reg, float& mn, float& alpha) {
    float pmax = p0[0]; for (int r = 1; r < 16; ++r) pmax = fmaxf(pmax, p0[r]); for (int r = 0; r < 16; ++r) pmax = fmaxf(pmax, p1[r]);
    { auto rr = __builtin_amdgcn_permlane32_swap(__float_as_uint(pmax), __float_as_uint(pmax), false, false);
      pmax = fmaxf(__uint_as_float(rr[0]), __uint_as_float(rr[1])); }
    constexpr float C2 = 1.4426950408889634f * SCALE;
    if (__builtin_expect(__all((pmax - m_reg) * SCALE <= THR), 1)) { mn = m_reg; alpha = 1.f; }
    else { mn = fmaxf(m_reg, pmax); alpha = __builtin_amdgcn_exp2f((m_reg - mn) * C2); m_reg = mn; }
    const float mnL = -mn * C2;
    for (int r = 0; r < 16; ++r) p0[r] = fmaf(p0[r], C2, mnL); for (int r = 0; r < 16; ++r) p1[r] = fmaf(p1[r], C2, mnL);
    for (int r = 0; r < 16; ++r) p0[r] = __builtin_amdgcn_exp2f(p0[r]);
}
__device__ __forceinline__ void finishSM(f32x16& p0, f32x16& p1, float alpha, float& l_reg, bf16x8& pa0, bf16x8& pa1, bf16x8& pa2, bf16x8& pa3) {
    for (int r = 0; r < 16; ++r) p1[r] = __builtin_amdgcn_exp2f(p1[r]);
    float ps = 0; for (int r = 0; r < 16; ++r) ps += p0[r]; for (int r = 0; r < 16; ++r) ps += p1[r];
    { auto rr = __builtin_amdgcn_permlane32_swap(__float_as_uint(ps), __float_as_uint(ps), false, false);
      ps = __uint_as_float(rr[0]) + __uint_as_float(rr[1]); }
    l_reg = l_reg * alpha + ps;
#define PK4(P, B_, OUT) do { unsigned a0 = cvtpk(P[B_+0], P[B_+1]), a1 = cvtpk(P[B_+2], P[B_+3]);                          \
        unsigned b0 = cvtpk(P[B_+4], P[B_+5]), b1 = cvtpk(P[B_+6], P[B_+7]);                                             \
        auto r0 = __builtin_amdgcn_permlane32_swap(a0, b0, false, false); auto r1 = __builtin_amdgcn_permlane32_swap(a1, b1, false, false); \
        u32x4 w = {r0[0], r1[0], r0[1], r1[1]}; OUT = *reinterpret_cast<bf16x8*>(&w); } while (0)
    PK4(p0, 0, pa0); PK4(p0, 8, pa1); PK4(p1, 0, pa2); PK4(p1, 8, pa3);
#undef PK4
}
template <int KB, bool SK>
__device__ __forceinline__ void qkt(f32x16& p0, f32x16& p1, const char* K_lds, int r32, int hi, const char* q_w, bool act, const float* fbt) {
    if (SK && !act) { const float NEG = -__builtin_inff();
#pragma unroll
        for (int r = 0; r < 16; ++r) { p0[r] = NEG; p1[r] = NEG; } return; }
    {
#pragma unroll
        for (int r4 = 0; r4 < 4; ++r4) { const f32x4 a = *(const f32x4*)(fbt + 8 * r4 + 4 * hi), b = *(const f32x4*)(fbt + 32 + 8 * r4 + 4 * hi);
            p0[4 * r4] = a[0]; p0[4 * r4 + 1] = a[1]; p0[4 * r4 + 2] = a[2]; p0[4 * r4 + 3] = a[3];
            p1[4 * r4] = b[0]; p1[4 * r4 + 1] = b[1]; p1[4 * r4 + 2] = b[2]; p1[4 * r4 + 3] = b[3]; }
    }
    const char* kb[4]; const char* qb[4];
#pragma unroll
    for (int dd = 0; dd < 4; ++dd) { kb[dd] = K_lds + KB * SHM_K + KSWZ(r32, (dd * 16 + hi * 8) * 2); qb[dd] = q_w + KSWZ(r32, (dd * 16 + hi * 8) * 2); }
    bf16x8 b0 = *reinterpret_cast<const bf16x8*>(kb[0]), b1 = *reinterpret_cast<const bf16x8*>(kb[0] + 32 * 256), qf = *reinterpret_cast<const bf16x8*>(qb[0]);
#pragma unroll
    for (int d0 = 0; d0 < 8; ++d0) {
        bf16x8 b0n = b0, b1n = b1, qfn = qf;
        if (d0 < 7) { const char* a = kb[(d0 + 1) & 3] + ((d0 + 1) >> 2) * 128;
            b0n = *reinterpret_cast<const bf16x8*>(a); b1n = *reinterpret_cast<const bf16x8*>(a + 32 * 256);
            qfn = *reinterpret_cast<const bf16x8*>(qb[(d0 + 1) & 3] + ((d0 + 1) >> 2) * 128); }
        __builtin_amdgcn_sched_barrier(0);
        p0 = __builtin_amdgcn_mfma_f32_32x32x16_bf16(b0, qf, p0, 0, 0, 0);
        p1 = __builtin_amdgcn_mfma_f32_32x32x16_bf16(b1, qf, p1, 0, 0, 0);
        __builtin_amdgcn_sched_barrier(0);
        b0 = b0n; b1 = b1n; qf = qfn; }
}
template <int VB, bool SK>
__device__ __forceinline__ void pv_tile(f32x16* o, int vb0, bf16x8 pa0, bf16x8 pa1, bf16x8 pa2, bf16x8 pa3, bool act) {
    if (SK && !act) return;
#define TRRD(dst, off) asm volatile("ds_read_b64_tr_b16 %0, %1 offset:%2" : "=&v"(dst) : "v"(vb0), "i"(off) : "memory")
#define PV_D0(d0) do { s16x4 l0, l1, l2, l3, h0, h1, h2, h3; constexpr int b_ = VB * SHM_V + v_rd_off(d0, 0, 0);     \
        TRRD(l0, b_); TRRD(h0, b_ + 2048); TRRD(l1, b_ + 4096); TRRD(h1, b_ + 6144); TRRD(l2, b_ + 8192); TRRD(h2, b_ + 10240); TRRD(l3, b_ + 12288); TRRD(h3, b_ + 14336); \
        asm volatile("s_waitcnt lgkmcnt(0)" ::: "memory"); SBAR();                 \
        o[d0] = __builtin_amdgcn_mfma_f32_32x32x16_bf16(pa0, (bf16x8){l0[0], l0[1], l0[2], l0[3], h0[0], h0[1], h0[2], h0[3]}, o[d0], 0, 0, 0);   \
        o[d0] = __builtin_amdgcn_mfma_f32_32x32x16_bf16(pa1, (bf16x8){l1[0], l1[1], l1[2], l1[3], h1[0], h1[1], h1[2], h1[3]}, o[d0], 0, 0, 0);   \
        o[d0] = __builtin_amdgcn_mfma_f32_32x32x16_bf16(pa2, (bf16x8){l2[0], l2[1], l2[2], l2[3], h2[0], h2[1], h2[2], h2[3]}, o[d0], 0, 0, 0);   \
        o[d0] = __builtin_amdgcn_mfma_f32_32x32x16_bf16(pa3, (bf16x8){l3[0], l3[1], l3[2], l3[3], h3[0], h3[1], h3[2], h3[3]}, o[d0], 0, 0, 0); } while (0)
    PV_D0(0); PV_D0(1); PV_D0(2); PV_D0(3);
#undef PV_D0
#undef TRRD
}

template <class TIn, class TOut> struct BlockRef { const TIn* Q; const TIn* K; const TIn* V; TOut* O; const float* FC; const TIn* G; int P0; int JLO; };
template <class TIn> struct Seam {
    bf16x8 qr[8];
    bf16x8 st_v0, st_v1, st_k0, st_k1; f32x4 sf0, sf1, sf2, sf3;
    f32x4 tq[16];
};
__device__ __forceinline__ int swa_jlo(int P0, int W) { const int lowk = P0 - W + 1; return lowk > 0 ? lowk / KVBLK : 0; }
#define ROW(p, k0, rr) ((p) + (size_t)((k0) + (rr)) * D + sc)
#define VMW() asm volatile("s_waitcnt vmcnt(0)" ::: "memory")
#define VMWN(n) asm volatile("s_waitcnt vmcnt(%0)" :: "i"(n) : "memory")
#define SLOAD_H(Kp, Vp, k0) do { S.st_v0 = load8<TIn>(ROW(Vp, k0, sr)); S.st_v1 = load8<TIn>(ROW(Vp, k0, 32 + sr));              \
                         S.st_k0 = load8<TIn>(ROW(Kp, k0, sr)); S.st_k1 = load8<TIn>(ROW(Kp, k0, 32 + sr)); } while (0)
#define SWRITE_HK(bf) do { *(bf16x8*)(K_lds + (bf) * SHM_K + kws) = S.st_k0; *(bf16x8*)(K_lds + (bf) * SHM_K + kws + 32 * 256) = S.st_k1; } while (0)
#define SWRITE_HV(bf) do { *(bf16x8*)(V_lds + (bf) * SHM_V + vst0) = S.st_v0; *(bf16x8*)(V_lds + (bf) * SHM_V + vst1) = S.st_v1; } while (0)
#define SWRITE_H(bf) do { SWRITE_HV(bf); SWRITE_HK(bf); } while (0)
#define SLOAD_F(p, k0) do { S.sf0 = *(const f32x4*)ROW(p, k0, sr); S.sf1 = *(const f32x4*)(ROW(p, k0, sr) + 4);                \
                            S.sf2 = *(const f32x4*)ROW(p, k0, 32 + sr); S.sf3 = *(const f32x4*)(ROW(p, k0, 32 + sr) + 4); } while (0)
#define SWRITE_KF(bf) do { *(bf16x8*)(K_lds + (bf) * SHM_K + kws) = pack8(S.sf0, S.sf1); *(bf16x8*)(K_lds + (bf) * SHM_K + kws + 32 * 256) = pack8(S.sf2, S.sf3); } while (0)
#define SWRITE_VF(bf) do { *(bf16x8*)(V_lds + (bf) * SHM_V + vst0) = pack8(S.sf0, S.sf1); *(bf16x8*)(V_lds + (bf) * SHM_V + vst1) = pack8(S.sf2, S.sf3); } while (0)
template <class TIn, class TOut>
__device__ __forceinline__ void causal_swa_prime(const BlockRef<TIn, TOut>& cur, int W, char* lds, Seam<TIn>& S) {
    constexpr bool F32 = same_t<TIn, float>::v;
    const int tid = opaque_tid(), wid = __builtin_amdgcn_readfirstlane(tid >> 6), lane = tid & 63, r32 = lane & 31, hi = lane >> 5;
    const int sr = tid >> 4, sc = (tid & 15) * 8, kws = KSWZ(sr, sc * 2); char* K_lds = lds + 2 * SHM_V;
    const int kb0 = cur.JLO * KVBLK;
    for (int d0 = 0; d0 < 8; ++d0) S.qr[d0] = load8<TIn>(cur.Q + (size_t)(wid * QBLK + r32) * D + d0 * 16 + hi * 8);
    { char* q_w = lds + QL_OFF + wid * (QBLK * D * 2);
      for (int d0 = 0; d0 < 8; ++d0) *reinterpret_cast<bf16x8*>(q_w + KSWZ(r32, (d0 * 16 + hi * 8) * 2)) = S.qr[d0]; }
    if constexpr (F32) { SLOAD_F((const float*)cur.K, kb0); VMW(); SWRITE_KF(0); SBAR(); SLOAD_F((const float*)cur.V, kb0); }
    else { SLOAD_H(cur.K, cur.V, kb0); VMW(); SWRITE_HK(0); }
    __syncthreads();
}
template <class TIn, class TOut>
__device__ __forceinline__ void causal_swa_block(const BlockRef<TIn, TOut>& cur, const BlockRef<TIn, TOut>& nxt, int skv, int W, char* lds, Seam<TIn>& S) {
    constexpr bool F32 = same_t<TIn, float>::v;
    const int tid = opaque_tid(), wid = __builtin_amdgcn_readfirstlane(tid >> 6), lane = tid & 63, r32 = lane & 31, hi = lane >> 5;
    const int j_lo = cur.JLO;
    int j_hi = (cur.P0 + QB - 1) / KVBLK + 1; if (j_hi > skv / KVBLK) j_hi = skv / KVBLK;
    const int NT = j_hi - j_lo;
    const int kbn = nxt.JLO * KVBLK;
    const int qlo = cur.P0 + wid * QBLK, qm = qlo + r32 - 4 * hi;
    char* V_lds = lds; char* K_lds = lds + 2 * SHM_V;
    float* ws = (float*)(lds + 2 * SHM_V + 2 * SHM_K) + wid * 64; float* li_l = ws, * al_l = ws + 32;
    float m_reg = -1e30f, l_reg = 0; f32x16 o[4] = {};
    const int sr = tid >> 4, sc = (tid & 15) * 8, vst0 = v_st(sr, sc), vst1 = v_st(32 + sr, sc), kws = KSWZ(sr, sc * 2);
    const int vb0 = (int)(uintptr_t)V_lds + v_rd_base(lane);
    const TIn* Kh = cur.K; const TIn* Vh = cur.V;
    char* q_w = lds + QL_OFF + wid * (QBLK * D * 2);
    float* fb = (float*)(lds + FB_OFF);
    { const int nk = j_hi * KVBLK; const float* FCp = cur.FC; const float c0 = FCp ? FCp[cur.P0] : 0.f;
#pragma unroll
      for (int k = 0; k < 4; ++k) { const int i = tid + 64 * NW * k;
          if (i < nk) { float v = 0.f; if (FCp) v = (c0 - FCp[i]) * INV_SCALE; fb[i] = v; } }
      __syncthreads(); }
#define RESC(a) do { if (__any((a) < 1.f)) { if (hi == 0) al_l[r32] = (a); asm volatile("s_waitcnt lgkmcnt(0)" ::: "memory");              \
                     for (int d_ = 0; d_ < 4; ++d_) for (int r = 0; r < 16; ++r) o[d_][r] *= al_l[crow(r, hi)]; } } while (0)
#define KBASE(t) ((j_lo + (t)) * KVBLK)
#define ACT(t) (KBASE(t) <= qlo + QBLK - 1 && KBASE(t) + KVBLK - 1 >= qlo - W + 1)
#define MASKT(P0_, P1_, t) do { const int kb_ = KBASE(t); if ((!SK || ACT(t)) && (kb_ + KVBLK - 1 > qlo || kb_ <= qlo + QBLK - 1 - W)) mask_tile(P0_, P1_, qm - kb_, (unsigned)W); } while (0)
    constexpr int NQL = F32 ? 16 : 8;
    constexpr bool SK = WSKIP && !F32;
#define SEAM_K0() do { VMWN(NQL); if constexpr (F32) { SWRITE_KF(0); SBAR(); SLOAD_F((const float*)nxt.V, kbn); } else { SWRITE_HK(0); } SBAR(); } while (0)
    f32x16 pA0, pA1, pB0, pB1; float mnA, mnB, alA, alB; bf16x8 pa0, pa1, pa2, pa3;
    if constexpr (F32) { VMW(); SWRITE_VF(0); SBAR(); } else { SWRITE_HV(0); SBAR(); }
    if (NT > 1) { if constexpr (F32) SLOAD_F((const float*)Kh, KBASE(1)); else SLOAD_H(Kh, Vh, KBASE(1)); }
    SBAR(); qkt<0, SK>(pA0, pA1, K_lds, r32, hi, q_w, ACT(0), fb + KBASE(0));
    if constexpr (F32) { if (NT > 1) { VMW(); SWRITE_KF(1); SBAR(); SLOAD_F((const float*)Vh, KBASE(1)); } }
    MASKT(pA0, pA1, 0); partialSM(pA0, pA1, m_reg, mnA, alA);
    if (NT > 1) { VMW(); if constexpr (F32) { SWRITE_VF(1); SBAR(); if (NT > 2) SLOAD_F((const float*)Kh, KBASE(2)); } else SWRITE_H(1); }
    __syncthreads();
#define HALF_STEP(PX0, PX1, mnX, alX, PY0, PY1, alY, t, KB, VB, SB) do {                                                      \
        SBAR(); qkt<KB, SK>(PX0, PX1, K_lds, r32, hi, q_w, ACT(t), fb + KBASE(t));                                             \
        finishSM(PY0, PY1, alY, l_reg, pa0, pa1, pa2, pa3); SBAR();                                                           \
        if ((t) + 1 < NT) { if constexpr (F32) { VMW(); SWRITE_KF(SB); SBAR(); SLOAD_F((const float*)Vh, KBASE((t) + 1)); }  \
                            else { SLOAD_H(Kh, Vh, KBASE((t) + 1)); } SBAR(); }                                               \
        pv_tile<VB, SK>(o, vb0, pa0, pa1, pa2, pa3, ACT((t) - 1)); MASKT(PX0, PX1, (t)); partialSM(PX0, PX1, m_reg, mnX, alX);                                        \
        __syncthreads();                                                                                                      \
        if ((t) + 1 < NT) { VMW(); if constexpr (F32) { SWRITE_VF(SB); SBAR(); if ((t) + 2 < NT) SLOAD_F((const float*)Kh, KBASE((t) + 2)); } \
                            else { SWRITE_H(SB); } }                                                                          \
        RESC(alX); __syncthreads(); } while (0)
    for (int t = 1; t + 1 < NT; t += 2) {
        HALF_STEP(pB0, pB1, mnB, alB, pA0, pA1, alA, t, 1, 0, 0);
        HALF_STEP(pA0, pA1, mnA, alA, pB0, pB1, alB, t + 1, 0, 1, 1);
    }
    const bool even = (NT & 1) == 0;
    if (even) { SBAR(); qkt<1, SK>(pB0, pB1, K_lds, r32, hi, q_w, ACT(NT - 1), fb + KBASE(NT - 1)); SBAR(); }
#define QROW(e) (nxt.Q + (size_t)(wid * QBLK + r32) * D + ((e) >> 1) * 16 + hi * 8 + ((e) & 1) * 4)
    if constexpr (F32) { SLOAD_F((const float*)nxt.K, kbn); SBAR();
#pragma unroll
        for (int e = 0; e < 8; ++e) S.tq[e] = *(const f32x4*)QROW(e); }
    else { SLOAD_H(nxt.K, nxt.V, kbn); SBAR();
#pragma unroll
        for (int d0 = 0; d0 < 8; ++d0) S.qr[d0] = load8<TIn>(nxt.Q + (size_t)(wid * QBLK + r32) * D + d0 * 16 + hi * 8); }
    SBAR();
    finishSM(pA0, pA1, alA, l_reg, pa0, pa1, pa2, pa3); SBAR();
    if constexpr (F32) {
#pragma unroll
        for (int e = 8; e < 16; ++e) S.tq[e] = *(const f32x4*)QROW(e); SBAR(); }
#undef QROW
    pv_tile<0, SK>(o, vb0, pa0, pa1, pa2, pa3, ACT(even ? NT - 2 : NT - 1));
    if (even) { MASKT(pB0, pB1, NT - 1); partialSM(pB0, pB1, m_reg, mnB, alB); __syncthreads(); RESC(alB);
        finishSM(pB0, pB1, alB, l_reg, pa0, pa1, pa2, pa3); SBAR(); pv_tile<1, SK>(o, vb0, pa0, pa1, pa2, pa3, ACT(NT - 1)); }
    SBAR(); SEAM_K0();
    if (hi == 0) li_l[r32] = l_reg; asm volatile("s_waitcnt lgkmcnt(0)" ::: "memory");
    float rli[16];
#pragma unroll
    for (int r = 0; r < 16; ++r) rli[r] = __builtin_amdgcn_rcpf(li_l[crow(r, hi)]);
    {
        unsigned short* ost = (unsigned short*)q_w;
        {
            const bool odd = (r32 & 1) != 0; unsigned short* ob_ = ost + (odd ? 32 : 0) + (r32 & ~1);
#pragma unroll
            for (int r = 0; r < 16; ++r) { const int orow = crow(r, hi);
#pragma unroll
                for (int dp = 0; dp < 4; dp += 2) { const float e0 = o[dp][r] * rli[r], e1 = o[dp + 1][r] * rli[r];
                    const float snd = odd ? e0 : e1;
                    const float rcv = __int_as_float(__builtin_amdgcn_update_dpp(0, __float_as_int(snd), 0xB1, 0xF, 0xF, true));
                    const float lo = odd ? rcv : e0, hi_ = odd ? e1 : rcv;
                    *(unsigned*)(ob_ + orow * 128 + dp * 32) = cvtpk(lo, hi_); } }
        }
        asm volatile("s_waitcnt lgkmcnt(0)" ::: "memory");
        const unsigned short* Gw = (const unsigned short*)cur.G + (size_t)(wid * QBLK) * LDO; TOut* Ow = cur.O + (size_t)(wid * QBLK) * LDO;
        const int ck = lane & 15, rq = lane >> 4;
        u32x4 gq[8];
#pragma unroll
        for (int i = 0; i < 8; ++i) gq[i] = __builtin_nontemporal_load((const u32x4*)(Gw + (size_t)(4 * i + rq) * LDO + ck * 8));
#pragma unroll
        for (int i = 0; i < 8; ++i) { const u32x4 ov = *(const u32x4*)(ost + (4 * i + rq) * 128 + ck * 8); const u32x4 g = gq[i]; u32x4 w;
#define GMUL(a_, b_) cvtpk(__uint_as_float((a_) << 16) * __uint_as_float((b_) << 16), __uint_as_float((a_) & 0xffff0000u) * __uint_as_float((b_) & 0xffff0000u))
            w.x = GMUL(ov.x, g.x); w.y = GMUL(ov.y, g.y); w.z = GMUL(ov.z, g.z); w.w = GMUL(ov.w, g.w);
#undef GMUL
            *(u32x4*)(Ow + (size_t)(4 * i + rq) * LDO + ck * 8) = w; }
        asm volatile("s_waitcnt lgkmcnt(0)" ::: "memory");
    }
    if constexpr (F32) {
#pragma unroll
        for (int d0 = 0; d0 < 8; ++d0) S.qr[d0] = pack8(S.tq[2 * d0], S.tq[2 * d0 + 1]); }
#pragma unroll
    for (int d0 = 0; d0 < 8; ++d0) *reinterpret_cast<bf16x8*>(q_w + KSWZ(r32, (d0 * 16 + hi * 8) * 2)) = S.qr[d0];
    __syncthreads();
#undef RESC
#undef KBASE
#undef ACT
#undef MASKT
#undef SEAM_K0
#undef HALF_STEP
}
#undef ROW
#undef VMW
#undef VMWN
#undef SLOAD_H
#undef SWRITE_HK
#undef SWRITE_HV
#undef SWRITE_H
#undef SLOAD_F
#undef SWRITE_KF
#undef SWRITE_VF


#undef KSWZ
#undef SBAR
}
#define LAS __attribute__((address_space(3)))
typedef unsigned short bf16r;
typedef float f32x4 __attribute__((ext_vector_type(4)));
typedef float f32x16 __attribute__((ext_vector_type(16)));
typedef short bf16x8 __attribute__((ext_vector_type(8)));
typedef unsigned u32x4 __attribute__((ext_vector_type(4)));
typedef unsigned u32x2 __attribute__((ext_vector_type(2)));

constexpr int NTOK = 16384, DM = 2048, SEQL = 2048, NBATCH = 8, NMEM = 256, MAINW = 1536, MEMW = 512, NGRP = 96;
constexpr float EPSN = 1e-6f;
constexpr size_t MiB = (size_t)1 << 20;
constexpr size_t SM_RSTD0 = 0, SM_RSTDM = 64 * 1024, SM_ROWSQ0 = 128 * 1024, SM_ROWSQ1 = 192 * 1024, SM_RSTD1 = 256 * 1024,
                 SM_LOGF = 320 * 1024, SM_FCUM = 1152 * 1024, SM_WFT = 1984 * 1024, SM_QNRM = 2560 * 1024, SM_KNRM = 3328 * 1024;
constexpr size_t WS_WINA = 4 * MiB, WS_WKVB = 20 * MiB, WS_WGLU = 48 * MiB, WS_WMKV0 = 53 * MiB, WS_WMKV1 = 57 * MiB, WS_WOUT0 = 61 * MiB, WS_WOUT1 = 69 * MiB,
                 WS_XB = 77 * MiB, WS_MEMB = 141 * MiB, WS_MKV = 149 * MiB, WS_PROJ = 157 * MiB, WS_KVB = 285 * MiB, WS_CAT = 381 * MiB, WS_OB = 445 * MiB, WS_BAR = 509 * MiB, WS_END = 509 * MiB + 65536;
constexpr int LDS_TOTAL = 147456;

struct Params { const float* in[23]; float* out; unsigned char* ws; };
enum { I_X = 0, I_MEM, I_PREG, I_POSTG, I_WINA, I_LRE, I_LIM, I_LSTEP, I_BRE, I_BIM, I_CRE, I_CIM, I_DSKIP, I_WGLU, I_BGLU, I_KVG, I_WKV, I_WFG, I_BFG, I_WINB, I_MEMG, I_WMKV, I_WOUT };

__device__ __forceinline__ float wave_sum(float v) {
#pragma unroll
    for (int o = 1; o < 64; o <<= 1) v += __shfl_xor(v, o);
    return v;
}
__device__ __forceinline__ unsigned pkbf(float lo, float hi) { return pg8::cvt_pk_bf16(lo, hi); }
#define LDS_FENCE() asm volatile("s_waitcnt lgkmcnt(0)" ::: "memory")

__device__ __forceinline__ void transpose_item(const float* W, const float* gs, int K, int N, bf16r* WT, int row_off, LAS float* scr, int item, int lane) {
    const int nblk = N / 32, kb = item / nblk, nb = item % nblk, k0 = 64 * kb, n0 = 32 * nb;
    const float* src = W + (size_t)(k0 + (lane >> 5)) * N + n0 + (lane & 31);
    float v[32];
#pragma unroll
    for (int i = 0; i < 32; ++i) v[i] = __builtin_nontemporal_load(src + (size_t)(2 * i) * N);
    const int c = lane & 7;
    f32x4 g0 = {1.f, 1.f, 1.f, 1.f}, g1 = {1.f, 1.f, 1.f, 1.f};
    if (gs) { g0 = *(const f32x4*)(gs + k0 + 8 * c); g1 = *(const f32x4*)(gs + k0 + 8 * c + 4); }
#pragma unroll
    for (int i = 0; i < 32; ++i) scr[(2 * i + (lane >> 5)) * 33 + (lane & 31)] = v[i];
    LDS_FENCE();
#pragma unroll
    for (int j = 0; j < 4; ++j) { const int n = (lane >> 3) + 8 * j; const LAS float* s = scr + (8 * c) * 33 + n;
        u32x4 o; o.x = pkbf(s[0 * 33] * g0[0], s[1 * 33] * g0[1]); o.y = pkbf(s[2 * 33] * g0[2], s[3 * 33] * g0[3]); o.z = pkbf(s[4 * 33] * g1[0], s[5 * 33] * g1[1]); o.w = pkbf(s[6 * 33] * g1[2], s[7 * 33] * g1[3]);
        *(u32x4*)(WT + (size_t)(row_off + n0 + n) * K + k0 + 8 * c) = o; }
    LDS_FENCE();
}
__device__ __forceinline__ void rows_to_bf16(const float* x, bf16r* o, float* rstd_out, int m0, int stride, int nrows, int lane) {
    f32x4 v[8];
    if (m0 < nrows) { const f32x4* xp = (const f32x4*)(x + (size_t)m0 * DM) + lane;
#pragma unroll
        for (int j = 0; j < 8; ++j) v[j] = __builtin_nontemporal_load(xp + 64 * j); }
    for (int m = m0; m < nrows; m += stride) {
        f32x4 vn[8]; const int mn = m + stride;
        if (mn < nrows) { const f32x4* xp = (const f32x4*)(x + (size_t)mn * DM) + lane;
#pragma unroll
            for (int j = 0; j < 8; ++j) vn[j] = __builtin_nontemporal_load(xp + 64 * j); }
        float s = 0.f;
#pragma unroll
        for (int j = 0; j < 8; ++j) s += (v[j][0] * v[j][0] + v[j][1] * v[j][1]) + (v[j][2] * v[j][2] + v[j][3] * v[j][3]);
        s = wave_sum(s);
        if (lane == 0) rstd_out[m] = 1.0f / sqrtf(s * (1.0f / DM) + EPSN);
        u32x2* op = (u32x2*)(o + (size_t)m * DM) + lane;
#pragma unroll
        for (int j = 0; j < 8; ++j) { u32x2 w; w.x = pkbf(v[j][0], v[j][1]); w.y = pkbf(v[j][2], v[j][3]); op[64 * j] = w; }
        if (mn < nrows) {
#pragma unroll
            for (int j = 0; j < 8; ++j) v[j] = vn[j]; }
    }
}

struct Sel0 { bf16r* proj;
    __device__ __forceinline__ pg8::SecInfo operator()(int cs) const {
        if (cs < 1536) return {proj, 0, 1536, 0, 0, nullptr};
        if (cs < 3072) return {proj + (size_t)NTOK * 1536, 1536, 2048, 0, 1, nullptr};
        if (cs < 3584) return {proj + (size_t)NTOK * 3584, 3072, 0, 4, 0, nullptr};
        return {proj + (size_t)NTOK * 1536 + 1536, 3584, 2048, 0, 1, nullptr}; } };
struct Sel1 { bf16r* kvb; bf16r* proj; float* qnrm; float* knrm;
    __device__ __forceinline__ pg8::SecInfo operator()(int cs) const {
        if (cs < 1536) return {kvb, 0, 0, 12, 0, knrm};
        if (cs < 3072) return {kvb + (size_t)NTOK * 1536, 1536, 0, 12, 0, nullptr};
        if (cs < 4608) return {proj, 3072, 0, 12, 0, qnrm};
        if (cs < 6144) return {proj + (size_t)NTOK * 1536, 4608, 2048, 0, 1, nullptr};
        if (cs < 6656) return {proj + (size_t)NTOK * 3584, 6144, 0, 4, 0, nullptr};
        return {proj + (size_t)NTOK * 1536 + 1536, 6656, 2048, 0, 1, nullptr}; } };
struct SelM { bf16r* mkv;
    __device__ __forceinline__ pg8::SecInfo operator()(int cs) const {
        if (cs < 512) return {mkv, 0, 0, 4, 0, nullptr};
        return {mkv + (size_t)NBATCH * NMEM * 512, 512, 0, 4, 0, nullptr}; } };

constexpr int SSM_XS = 80;
constexpr int SSM_WAVE_LDS = 128 * 36 * 4 + 32 * SSM_XS * 4;
typedef float __attribute__((may_alias)) f32_ma; typedef unsigned __attribute__((may_alias)) u32_ma;
typedef f32x4 __attribute__((may_alias)) f32x4_ma; typedef bf16x8 __attribute__((may_alias)) bf16x8_ma;
__device__ __forceinline__ int crow16(int r, int hi) { return (r & 3) + 8 * (r >> 2) + 4 * hi; }
__device__ __forceinline__ float gelu_tanh(float y) {
    const float z = 0.7978845608028654f * (y + 0.044715f * y * y * y);
    return y * __builtin_amdgcn_rcpf(1.f + __builtin_amdgcn_exp2f(-2.8853900817779268f * z));
}
struct SsmCtx {
    f32_ma* Bu2; u32_ma* Xs; const bf16r* U; bf16r* YG; size_t tokb; int g, lane, c, hi, l16, kq;
    float ar, ai; bf16x8 Bf[4]; bf16x8 Cf[4]; float dsk[4];
};
__device__ __forceinline__ void ssm_s2(const SsmCtx& X, bf16x8 Uc) {
#pragma unroll
    for (int nt = 0; nt < 4; ++nt) {
        f32x16 a = {};
        a = __builtin_amdgcn_mfma_f32_32x32x16_bf16(Uc, X.Bf[nt], a, 0, 0, 0);
#pragma unroll
        for (int r4 = 0; r4 < 4; ++r4) { f32x4 v = {a[4 * r4], a[4 * r4 + 1], a[4 * r4 + 2], a[4 * r4 + 3]}; *(f32x4_ma*)(X.Bu2 + (32 * nt + X.c) * 36 + 8 * r4 + 4 * X.hi) = v; }
    }
}
__device__ __forceinline__ void ssm_s1(const SsmCtx& X, float& xr, float& xi) {
#pragma unroll
    for (int q = 0; q < 8; ++q) {
        const f32x4 re4 = *(const f32x4_ma*)(X.Bu2 + X.lane * 36 + 4 * q), im4 = *(const f32x4_ma*)(X.Bu2 + (64 + X.lane) * 36 + 4 * q);
#pragma unroll
        for (int e = 0; e < 4; ++e) {
            const float nr = X.ar * xr - X.ai * xi + re4[e], ni = X.ar * xi + X.ai * xr + im4[e];
            xr = nr; xi = ni; X.Xs[(4 * q + e) * SSM_XS + X.lane] = pkbf(xr, xi);
        }
    }
}
__device__ __forceinline__ void ssm_s3(const SsmCtx& X, bf16r* py, u32x2 us0, u32x2 us1) {
    f32x4 y0 = {0.f, 0.f, 0.f, 0.f}, y1 = {0.f, 0.f, 0.f, 0.f};
#pragma unroll
    for (int s = 0; s < 4; ++s) {
        const bf16x8 b0 = *(const bf16x8_ma*)(X.Xs + X.l16 * SSM_XS + 16 * s + 4 * X.kq), b1 = *(const bf16x8_ma*)(X.Xs + (16 + X.l16) * SSM_XS + 16 * s + 4 * X.kq);
        y0 = __builtin_amdgcn_mfma_f32_16x16x32_bf16(X.Cf[s], b0, y0, 0, 0, 0);
        y1 = __builtin_amdgcn_mfma_f32_16x16x32_bf16(X.Cf[s], b1, y1, 0, 0, 0);
    }
    y0[0] += X.dsk[0] * pg8::bf_lo(us0.x); y0[1] += X.dsk[1] * pg8::bf_hi(us0.x); y0[2] += X.dsk[2] * pg8::bf_lo(us0.y); y0[3] += X.dsk[3] * pg8::bf_hi(us0.y);
    y1[0] += X.dsk[0] * pg8::bf_lo(us1.x); y1[1] += X.dsk[1] * pg8::bf_hi(us1.x); y1[2] += X.dsk[2] * pg8::bf_lo(us1.y); y1[3] += X.dsk[3] * pg8::bf_hi(us1.y);
    u32x2 w0, w1;
    w0.x = pkbf(gelu_tanh(y0[0]), gelu_tanh(y0[1])); w0.y = pkbf(gelu_tanh(y0[2]), gelu_tanh(y0[3]));
    w1.x = pkbf(gelu_tanh(y1[0]), gelu_tanh(y1[1])); w1.y = pkbf(gelu_tanh(y1[2]), gelu_tanh(y1[3]));
    *(u32x2*)py = w0;
    *(u32x2*)(py + 16 * 1536) = w1;
}
#define SSM_BAR() asm volatile("s_waitcnt lgkmcnt(0)\n\ts_barrier" ::: "memory")
constexpr int SSM_TASK_LDS = 128 * 36 * 4 + 2 * 32 * SSM_XS * 4;
__device__ __forceinline__ void ssm_round(const Params& P, bool active, int role, int b, int g, unsigned char* wl, int lane) {
    SsmCtx X; X.g = g; X.lane = lane; X.c = lane & 31; X.hi = lane >> 5; X.l16 = lane & 15; X.kq = lane >> 4;
    const int c = X.c, hi = X.hi, l16 = X.l16, kq = X.kq;
    X.Bu2 = (f32_ma*)wl; u32_ma* Xs0 = (u32_ma*)(wl + 128 * 36 * 4); X.Xs = Xs0;
    X.U = (const bf16r*)(P.ws + WS_PROJ); X.YG = (bf16r*)(P.ws + WS_KVB); X.tokb = (size_t)b * SEQL;
    X.ar = 0.f; X.ai = 0.f;
    const bf16r* Ua = X.U + (X.tokb + c) * 1536 + g * 16 + 8 * hi;
    const bf16r* Us = X.U + (X.tokb + l16) * 1536 + g * 16 + 4 * kq;
    constexpr int NCH = SEQL / 32; constexpr size_t CHS = (size_t)32 * 1536;
    bf16x8 U0 = {}, U1 = {}, U2 = {}; u32x2 a0 = {0u, 0u}, a1 = {0u, 0u}, b0 = {0u, 0u}, b1 = {0u, 0u}, c0 = {0u, 0u}, c1 = {0u, 0u};
    if (active) {
        const float dt = __expf(P.in[I_LSTEP][g]), lr = P.in[I_LRE][g * 64 + lane], li = P.in[I_LIM][g * 64 + lane];
        const float mag = __expf(lr * dt); float rev = li * dt * 0.15915494309189535f; rev -= floorf(rev);
        const float ar = mag * __builtin_amdgcn_cosf(rev), ai = mag * __builtin_amdgcn_sinf(rev);
        const float den = lr * lr + li * li, cr = ((ar - 1.0f) * lr + ai * li) / den, ci = (ai * lr - (ar - 1.0f) * li) / den;
        X.ar = ar; X.ai = ai;
        if (role == 1) {
#pragma unroll
            for (int nt = 0; nt < 4; ++nt) {
                const int pp = 32 * nt + c, p = pp & 63; const float crp = __shfl(cr, p), cip = __shfl(ci, p);
                const f32x4 r0 = *(const f32x4*)(P.in[I_BRE] + ((size_t)(g * 64 + p)) * 16 + 8 * hi), r1 = *(const f32x4*)(P.in[I_BRE] + ((size_t)(g * 64 + p)) * 16 + 8 * hi + 4);
                const f32x4 i0 = *(const f32x4*)(P.in[I_BIM] + ((size_t)(g * 64 + p)) * 16 + 8 * hi), i1 = *(const f32x4*)(P.in[I_BIM] + ((size_t)(g * 64 + p)) * 16 + 8 * hi + 4);
                f32x4 v0, v1;
                if (nt < 2) { v0 = crp * r0 - cip * i0; v1 = crp * r1 - cip * i1; } else { v0 = crp * i0 + cip * r0; v1 = crp * i1 + cip * r1; }
                u32x4 w; w.x = pkbf(v0[0], v0[1]); w.y = pkbf(v0[2], v0[3]); w.z = pkbf(v1[0], v1[1]); w.w = pkbf(v1[2], v1[3]);
                X.Bf[nt] = __builtin_bit_cast(bf16x8, w);
            }
#pragma unroll
            for (int s = 0; s < 4; ++s) {
                const f32x4 re = *(const f32x4*)(P.in[I_CRE] + ((size_t)(g * 16 + l16)) * 64 + 16 * s + 4 * kq), im = *(const f32x4*)(P.in[I_CIM] + ((size_t)(g * 16 + l16)) * 64 + 16 * s + 4 * kq);
                u32x4 w; w.x = pkbf(re[0], -im[0]); w.y = pkbf(re[1], -im[1]); w.z = pkbf(re[2], -im[2]); w.w = pkbf(re[3], -im[3]);
                X.Cf[s] = __builtin_bit_cast(bf16x8, w);
            }
#pragma unroll
            for (int r = 0; r < 4; ++r) X.dsk[r] = P.in[I_DSKIP][g * 16 + 4 * kq + r];
            ssm_s2(X, *(const bf16x8*)Ua);
            U1 = *(const bf16x8*)(Ua + CHS); U2 = *(const bf16x8*)(Ua + 2 * CHS);
            a0 = *(const u32x2*)Us; a1 = *(const u32x2*)(Us + 16 * 1536);
        }
    }
    if (!active) {
        for (int i = 0; i < 2 * (NCH + 1) + 1; ++i) SSM_BAR();
    } else if (role == 0) {
        float xr = 0.f, xi = 0.f; const float nai_ = -X.ai; int wsel = 0;
        for (int ch = 0; ch <= NCH; ++ch) {
            SSM_BAR();
            f32x4 re4[8], im4[8];
            if (ch < NCH) {
#pragma unroll
                for (int q = 0; q < 8; ++q) { re4[q] = *(const f32x4_ma*)(X.Bu2 + lane * 36 + 4 * q); im4[q] = *(const f32x4_ma*)(X.Bu2 + (64 + lane) * 36 + 4 * q); }
            }
            SSM_BAR();
            if (ch < NCH) {
                u32_ma* Xw = Xs0 + wsel * (32 * SSM_XS); wsel ^= 1;
#pragma unroll
                for (int q = 0; q < 8; ++q) {
#pragma unroll
                    for (int e = 0; e < 4; ++e) {
                        float t1, t2, nr, ni;
                        asm("v_fma_f32 %0, %1, %2, %3" : "=v"(t1) : "v"(nai_), "v"(xi), "v"(re4[q][e]));
                        asm("v_fma_f32 %0, %1, %2, %3" : "=v"(t2) : "v"(X.ai), "v"(xr), "v"(im4[q][e]));
                        asm("v_fma_f32 %0, %1, %2, %3" : "=v"(nr) : "v"(X.ar), "v"(xr), "v"(t1));
                        asm("v_fma_f32 %0, %1, %2, %3" : "=v"(ni) : "v"(X.ar), "v"(xi), "v"(t2));
                        xr = nr; xi = ni; Xw[(4 * q + e) * SSM_XS + lane] = pkbf(xr, xi); } }
            }
        }
        SSM_BAR();
    } else {
        const bf16r* pU = Ua + 3 * CHS; const bf16r* pS = Us + CHS; bf16r* pY = X.YG + (X.tokb + l16) * 1536 + g * 16 + 4 * kq; int rsel = 0;
#define SSM_MM(DO_S2, DO_S3, DO_LD, U_USE, U_LD, S0_USE, S1_USE, S0_LD, S1_LD) do {                                               \
            SSM_BAR(); SSM_BAR();                                                                                      \
            if (DO_LD) { U_LD = *(const bf16x8*)pU; S0_LD = *(const u32x2*)pS; S1_LD = *(const u32x2*)(pS + 16 * 1536); pU += CHS; pS += CHS; } \
            __builtin_amdgcn_sched_barrier(0);                                                                                    \
            if (DO_S2) ssm_s2(X, U_USE);                                                                                          \
            if (DO_S3) { X.Xs = Xs0 + rsel * (32 * SSM_XS); rsel ^= 1; ssm_s3(X, pY, S0_USE, S1_USE); pY += CHS; }                \
            __builtin_amdgcn_sched_barrier(0);                                                                                    \
        } while (0)
#define MM_R0(S2_, S3_, LD) SSM_MM(S2_, S3_, LD, U1, U0, c0, c1, b0, b1)
#define MM_R1(S2_, S3_, LD) SSM_MM(S2_, S3_, LD, U2, U1, a0, a1, c0, c1)
#define MM_R2(S2_, S3_, LD) SSM_MM(S2_, S3_, LD, U0, U2, b0, b1, a0, a1)
        MM_R0(true, false, true);
        _Pragma("clang loop unroll(disable)") for (int ch = 1; ch + 2 < NCH - 1; ch += 3) { MM_R1(true, true, true); MM_R2(true, true, true); MM_R0(true, true, true); }
        static_assert((NCH - 2) % 3 == 2, "steady range 1..NCH-2 = 20 triples + 2");
        MM_R1(true, true, true);
        MM_R2(true, true, true);
        MM_R0(false, true, false);
        MM_R1(false, true, false);
#undef MM_R0
#undef MM_R1
#undef MM_R2
#undef SSM_MM
        SSM_BAR();
    }
}
__device__ __forceinline__ void ssm_phase(const Params& P, unsigned char* lds, int wave, int lane) {
    const int role = (wave == 0 || wave == 2 || wave == 6) ? 0 : 1;
    const int ts = (wave == 0 || wave == 4) ? 0 : (wave == 1 || wave == 2) ? 1 : (wave == 3 || wave == 6) ? 2 : 3;
    const int G = gridDim.x, rounds = (NBATCH * NGRP + 3 * G - 1) / (3 * G);
    for (int rd = 0; rd < rounds; ++rd) {
        const int tk = (rd * G + (int)blockIdx.x) * 3 + ts; const bool active = (ts < 3) && (tk < NBATCH * NGRP);
        const int tkc = active ? tk : 0;
        ssm_round(P, active, role, tkc / NGRP, tkc % NGRP, lds + (ts < 3 ? ts : 0) * SSM_TASK_LDS, lane);
    }
}

typedef att::BlockRef<att::bf16, att::bf16> ABlk;
__device__ __forceinline__ int fox_jlo(const Params& P, int bh, int qb, char* lds) {
    const int tid = opaque_tid(), lane = tid & 63, wave = tid >> 6;
    float* red = (float*)(lds + att::LDS_BYTES);
    const float* qn = (const float*)(P.ws + SM_QNRM) + (size_t)bh * SEQL + qb * 256; const float* kn = (const float*)(P.ws + SM_KNRM) + (size_t)bh * SEQL;
    float mq = (tid < 256) ? qn[tid] : 0.f, mk = 0.f;
    for (int i = tid; i < qb * 256; i += 512) mk = fmaxf(mk, kn[i]);
#pragma unroll
    for (int o = 1; o < 64; o <<= 1) { mq = fmaxf(mq, __shfl_xor(mq, o)); mk = fmaxf(mk, __shfl_xor(mk, o)); }
    if (lane == 0) { red[wave] = mq; red[8 + wave] = mk; }
    __syncthreads();
    float Q2 = 0.f, K2 = 0.f;
#pragma unroll
    for (int w = 0; w < 8; ++w) { Q2 = fmaxf(Q2, red[w]); K2 = fmaxf(K2, red[8 + w]); }
    const float bound = 2.04f * sqrtf(Q2 * K2) * att::SCALE + 30.f;
    const float* FC = (const float*)(P.ws + SM_FCUM) + (size_t)bh * SEQL; const float c0 = FC[qb * 256];
    const bool keep = (lane >= qb * 4) || (c0 - FC[lane < 32 ? 64 * lane + 63 : 2047] >= -bound);
    const unsigned long long m = __ballot(keep);
    const int jlo = __builtin_amdgcn_readfirstlane((int)__builtin_ctzll(m));
    __syncthreads();
    return jlo;
}
__device__ __forceinline__ void fox_item(int vc, int i, int& bh, int& qb) {
    const int gq = vc >> 3, j = vc & 7, e = j * 3 + i;
    const unsigned long long T0 = 7ull | (3ull << 5) | (0ull << 10) | ((7ull | 8ull) << 15) | (4ull << 20) | ((0ull | 8ull) << 25) | ((7ull | 16ull) << 30) | (2ull << 35) | (1ull << 40) | (6ull << 45) | (5ull << 50) | ((0ull | 16ull) << 55);
    const unsigned long long T1 = (6ull | 8ull) | ((4ull | 8ull) << 5) | ((1ull | 8ull) << 10) | ((6ull | 16ull) << 15) | ((3ull | 8ull) << 20) | ((1ull | 16ull) << 25) | ((5ull | 8ull) << 30) | ((4ull | 16ull) << 35) | ((2ull | 8ull) << 40) | ((5ull | 16ull) << 45) | ((3ull | 16ull) << 50) | ((2ull | 16ull) << 55);
    const unsigned code = (unsigned)(((e < 12) ? (T0 >> (5 * e)) : (T1 >> (5 * (e - 12)))) & 31ull);
    qb = code & 7; bh = gq * 3 + (code >> 3);
}
__device__ __forceinline__ void fox_jlo3(const Params& P, int vc, char* lds) {
    const int tid = opaque_tid(), lane = tid & 63, wave = tid >> 6;
    float* red = (float*)(lds + att::LDS_BYTES);
    int bh[3], qb[3]; float mq[3], mk[3];
#pragma unroll
    for (int i = 0; i < 3; ++i) { fox_item(vc, i, bh[i], qb[i]);
        const float* qn = (const float*)(P.ws + SM_QNRM) + (size_t)bh[i] * SEQL + qb[i] * 256; const float* kn = (const float*)(P.ws + SM_KNRM) + (size_t)bh[i] * SEQL;
        mq[i] = (tid < 256) ? qn[tid] : 0.f; mk[i] = 0.f;
#pragma unroll
        for (int k = 0; k < 4; ++k) { const int idx = tid + 512 * k; if (idx < qb[i] * 256) mk[i] = fmaxf(mk[i], kn[idx]); } }
#pragma unroll
    for (int o = 1; o < 64; o <<= 1) {
#pragma unroll
        for (int i = 0; i < 3; ++i) { mq[i] = fmaxf(mq[i], __shfl_xor(mq[i], o)); mk[i] = fmaxf(mk[i], __shfl_xor(mk[i], o)); } }
    if (lane == 0) {
#pragma unroll
        for (int i = 0; i < 3; ++i) { red[32 + 16 * i + wave] = mq[i]; red[32 + 16 * i + 8 + wave] = mk[i]; } }
    __syncthreads();
#pragma unroll
    for (int i = 0; i < 3; ++i) {
        float Q2 = 0.f, K2 = 0.f;
#pragma unroll
        for (int w = 0; w < 8; ++w) { Q2 = fmaxf(Q2, red[32 + 16 * i + w]); K2 = fmaxf(K2, red[32 + 16 * i + 8 + w]); }
        const float bound = 2.04f * sqrtf(Q2 * K2) * att::SCALE + 30.f;
        const float* FC = (const float*)(P.ws + SM_FCUM) + (size_t)bh[i] * SEQL; const float c0 = FC[qb[i] * 256];
        const bool keep = (lane >= qb[i] * 4) || (c0 - FC[lane < 32 ? 64 * lane + 63 : 2047] >= -bound);
        const unsigned long long m = __ballot(keep);
        if (tid == 0) ((int*)red)[16 + i] = (int)__builtin_ctzll(m);
    }
    __syncthreads();
}
template <bool FOX, int LYR> __device__ __forceinline__ bool att_get(const Params& P, int n, ABlk& r, int& skv, char* lds) {
    constexpr int PER = FOX ? 4 : 1;
    const int G = gridDim.x, bx = blockIdx.x;
    const int slot = n / PER, i = n % PER;
    const int vb = bx + slot * G; if (vb >= 256) return false;
    const int vc = (vb & 7) * 32 + (vb >> 3);
    const att::bf16* proj = (const att::bf16*)(P.ws + WS_PROJ); att::bf16* cat = (att::bf16*)(P.ws + WS_CAT);
    if (FOX && i < 3) {
        int bh, qb; fox_item(vc, i, bh, qb); const int b = bh / 12, h = bh % 12;
        const att::bf16* kvb = (const att::bf16*)(P.ws + WS_KVB);
        r.Q = proj + ((size_t)bh * SEQL + qb * 256) * 128; r.K = kvb + (size_t)bh * SEQL * 128; r.V = kvb + (size_t)NTOK * 1536 + (size_t)bh * SEQL * 128;
        r.O = cat + ((size_t)b * SEQL + qb * 256) * 2048 + h * 128; r.G = proj + (size_t)NTOK * 1536 + ((size_t)b * SEQL + qb * 256) * 2048 + h * 128;
        r.FC = (const float*)(P.ws + SM_FCUM) + (size_t)bh * SEQL; r.P0 = qb * 256; skv = SEQL;
        r.JLO = (slot == 0) ? __builtin_amdgcn_readfirstlane(((const int*)(lds + att::LDS_BYTES))[16 + i]) : fox_jlo(P, bh, qb, lds);
    } else {
        const int b = vc >> 5, hm = (vc >> 3) & 3, qb = vc & 7;
        const att::bf16* mkv = (const att::bf16*)(P.ws + WS_MKV) + (size_t)LYR * (2 * NBATCH * NMEM * 512);
        r.Q = proj + (size_t)NTOK * 3584 + ((size_t)(b * 4 + hm) * SEQL + qb * 256) * 128;
        r.K = mkv + (size_t)(b * 4 + hm) * NMEM * 128; r.V = mkv + (size_t)NBATCH * NMEM * 512 + (size_t)(b * 4 + hm) * NMEM * 128;
        r.O = cat + ((size_t)b * SEQL + qb * 256) * 2048 + 1536 + hm * 128; r.G = proj + (size_t)NTOK * 1536 + ((size_t)b * SEQL + qb * 256) * 2048 + 1536 + hm * 128;
        r.FC = nullptr; r.P0 = 256; skv = NMEM; r.JLO = 0;
    }
    return true;
}
template <bool FOX, int LYR> __device__ __forceinline__ void att_phase(const Params& P, char* lds) {
    ABlk cur, nxt; int skv = 0, skvn = 0;
    if (FOX && (int)blockIdx.x < 256) { const int vb = blockIdx.x; fox_jlo3(P, (vb & 7) * 32 + (vb >> 3), lds); }
    if (!att_get<FOX, LYR>(P, 0, cur, skv, lds)) return;
    att::Seam<att::bf16> S;
    att::causal_swa_prime<att::bf16, att::bf16>(cur, 1 << 20, lds, S);
    for (int n = 0;; ++n) {
        const bool more = att_get<FOX, LYR>(P, n + 1, nxt, skvn, lds);
        if (!more) { nxt = cur; skvn = skv; }
        att::causal_swa_block<att::bf16, att::bf16>(cur, nxt, skv, 1 << 20, lds, S);
        if (!more) break;
        cur = nxt; skv = skvn;
    }
}

#define XB_TMO      128
#define XB_XCNT(j)  (256  + 64 * (j))
#define XB_XSUB(j)  (1280 + 64 * (j))
#define XB_XGEN(j)  (2304 + 64 * (j))
#define XB_TOP      3328
#define XB_TOPGEN   3392
#define XCD_BAR_WORDS 3456
#define XB_SPIN_CAP (1u << 18)

__device__ __forceinline__ unsigned xb_ld(unsigned* p)              { return __hip_atomic_load(p, __ATOMIC_RELAXED, __HIP_MEMORY_SCOPE_AGENT); }
__device__ __forceinline__ unsigned xb_add(unsigned* p, unsigned v) { return __hip_atomic_fetch_add(p, v, __ATOMIC_RELAXED, __HIP_MEMORY_SCOPE_AGENT); }
__device__ __forceinline__ unsigned xb_xcc_id() { return (unsigned)__builtin_amdgcn_s_getreg((3 << 11) | 20) & 0xFu; }
#define XB_SPIN(cond, bar) do { unsigned _sp = 0; while (cond) { __builtin_amdgcn_s_sleep(1); \
    if ((++_sp & 255u) == 0u) { if (xb_ld(&(bar)[XB_TMO])) break; if (_sp > XB_SPIN_CAP) { atomicAdd(&(bar)[XB_TMO], 1u); break; } } } } while (0)

struct XcdBarrier {
    unsigned* bar; unsigned x;
    volatile LAS unsigned* st;
};

__device__ __forceinline__ XcdBarrier xcd_barrier_post(unsigned* bar, volatile LAS unsigned* st) {
    XcdBarrier b; b.bar = bar; b.x = xb_xcc_id(); b.st = st;
    if (threadIdx.x == 0) (void)xb_add(&bar[XB_XCNT(b.x)], 1u);
    return b;
}
__device__ __forceinline__ void xcd_barrier_complete(unsigned* bar, unsigned x, unsigned& nloc, unsigned& nx) {
    const unsigned G = gridDim.x * gridDim.y * gridDim.z;
    unsigned sum, cnt, mine, sp = 0u;
    for (;;) {
        sum = 0u; cnt = 0u; mine = 0u;
#pragma unroll
        for (unsigned j = 0; j < 16; ++j) { const unsigned c = xb_ld(&bar[XB_XCNT(j)]); sum += c; cnt += (c > 0u) ? 1u : 0u; mine = (j == x) ? c : mine; }
        if (sum == G) break;
        __builtin_amdgcn_s_sleep(1);
        if ((++sp & 255u) == 0u) { if (xb_ld(&bar[XB_TMO])) break; if (sp > XB_SPIN_CAP) { atomicAdd(&bar[XB_TMO], 1u); break; } }
    }
    nloc = mine > 0u ? mine : 1u; nx = cnt > 0u ? cnt : 1u;
}

__device__ __forceinline__ void xcd_barrier(const XcdBarrier& b) {
    asm volatile("s_waitcnt vmcnt(0)" ::: "memory");
    __syncthreads();
    if (threadIdx.x == 0) {
        unsigned* bar = b.bar;
        __builtin_amdgcn_s_waitcnt(0);
        unsigned nloc = b.st[0], nx = b.st[1];
        if (nloc == 0u) { xcd_barrier_complete(bar, b.x, nloc, nx); b.st[0] = nloc; b.st[1] = nx; }
        const unsigned old = xb_add(&bar[XB_XSUB(b.x)], 1u);
        const unsigned gen = old / nloc;
        if (old + 1u == (gen + 1u) * nloc) {
            __builtin_amdgcn_fence(__ATOMIC_RELEASE, "agent");
            asm volatile("s_waitcnt vmcnt(0)" ::: "memory");
            const unsigned og = xb_add(&bar[XB_TOP], 1u);
            const unsigned tg = og / nx;
            if (og + 1u == (tg + 1u) * nx) xb_add(&bar[XB_TOPGEN], 1u);
            else XB_SPIN(xb_ld(&bar[XB_TOPGEN]) == tg, bar);
            __builtin_amdgcn_fence(__ATOMIC_ACQUIRE, "agent");
            xb_add(&bar[XB_XGEN(b.x)], 1u);
            asm volatile("s_waitcnt vmcnt(0)" ::: "memory");
        } else {
            XB_SPIN(xb_ld(&bar[XB_XGEN(b.x)]) == gen, bar);
            __builtin_amdgcn_fence(__ATOMIC_ACQUIRE, "agent");
            asm volatile("s_waitcnt vmcnt(0)" ::: "memory");
        }
    }
    __syncthreads();
}

#ifndef PH_MASK
#define PH_MASK 0x7ff
#endif
#define PH(k) if constexpr ((PH_MASK >> (k)) & 1)
#ifndef REP_MASK
#define REP_MASK 0
#endif
#define REP(k) for (int rep_ = 0; rep_ <= ((REP_MASK >> (k)) & 1); ++rep_)
__global__ void __launch_bounds__(512, 2) yoco_fwd(Params P) {
    extern __shared__ __attribute__((aligned(16))) unsigned char lds[];
    cg::grid_group grid = cg::this_grid();
    volatile LAS unsigned* bst = (volatile LAS unsigned*)((LAS unsigned char*)lds + (LDS_TOTAL - 64));
    if (threadIdx.x == 0) { bst[0] = 0u; bst[1] = 0u; }
    __syncthreads();
    const XcdBarrier xbar = xcd_barrier_post((unsigned*)(P.ws + WS_BAR), bst);
#define GRID_SYNC() xcd_barrier(xbar)
    const int G = gridDim.x, NGW = G * 8;
#define PHASE_IDS() const int tid = opaque_tid(), lane = tid & 63, wave = __builtin_amdgcn_readfirstlane(tid >> 6), gw = blockIdx.x * 8 + wave; (void)lane; (void)gw
    unsigned char* ws = P.ws;
    float* rstd0 = (float*)(ws + SM_RSTD0); float* rstdm = (float*)(ws + SM_RSTDM); float* rowsq0 = (float*)(ws + SM_ROWSQ0); float* rowsq1 = (float*)(ws + SM_ROWSQ1);
    float* rstd1 = (float*)(ws + SM_RSTD1); float* logf_ = (float*)(ws + SM_LOGF); float* fcum = (float*)(ws + SM_FCUM); float* wft = (float*)(ws + SM_WFT);
    bf16r* xb = (bf16r*)(ws + WS_XB); bf16r* memb = (bf16r*)(ws + WS_MEMB); bf16r* proj = (bf16r*)(ws + WS_PROJ); bf16r* kvb = (bf16r*)(ws + WS_KVB);
    bf16r* cat = (bf16r*)(ws + WS_CAT); bf16r* ob = (bf16r*)(ws + WS_OB); bf16r* mkv = (bf16r*)(ws + WS_MKV);
    LAS unsigned char* glds = (LAS unsigned char*)lds;

    REP(0) {
    PH(0) { PHASE_IDS();
        LAS float* scr = (LAS float*)((LAS unsigned char*)lds + wave * 16384);
        constexpr int I_A = 32 * 128, I_GLU = 24 * 48, I_MK = 32 * 32, I_O = 32 * 64;
        constexpr int NIT = I_A + I_GLU + 2 * I_MK + I_O;
        for (int it = gw; it < NIT; it += NGW) {
            int r = it;
            if (r < I_A) { transpose_item(P.in[I_WINA], P.in[I_PREG], 2048, 4096, (bf16r*)(ws + WS_WINA), 0, scr, r, lane); continue; } r -= I_A;
            if (r < I_GLU) { transpose_item(P.in[I_WGLU], nullptr, 1536, 1536, (bf16r*)(ws + WS_WGLU), 0, scr, r, lane); continue; } r -= I_GLU;
            if (r < I_MK) { transpose_item(P.in[I_WMKV], P.in[I_MEMG], 2048, 1024, (bf16r*)(ws + WS_WMKV0), 0, scr, r, lane); continue; } r -= I_MK;
            if (r < I_MK) { transpose_item(P.in[I_WMKV] + (size_t)2048 * 1024, P.in[I_MEMG] + 2048, 2048, 1024, (bf16r*)(ws + WS_WMKV1), 0, scr, r, lane); continue; } r -= I_MK;
            transpose_item(P.in[I_WOUT], nullptr, 2048, 2048, (bf16r*)(ws + WS_WOUT0), 0, scr, r, lane);
        }
        rows_to_bf16(P.in[I_X], xb, rstd0, gw, NGW, NTOK, lane);
        rows_to_bf16(P.in[I_MEM], memb, rstdm, gw, NGW, NBATCH * NMEM, lane);
        for (int i = blockIdx.x * 512 + tid; i < NTOK; i += G * 512) { rowsq0[i] = 0.f; rowsq1[i] = 0.f; }
        for (int i = blockIdx.x * 512 + tid; i < 2 * 96 * SEQL; i += G * 512) ((float*)(ws + SM_QNRM))[i] = 0.f;
        for (int i = blockIdx.x * 512 + tid; i < 12 * DM; i += G * 512) { const int h = i / DM, k = i % DM; wft[i] = P.in[I_KVG][k] * P.in[I_WFG][k * 12 + h]; }
    }
    if (P.ws == nullptr) grid.sync();
    GRID_SYNC();
    }
    REP(1) {
    PH(1) {
        { pg8::Gemm g{xb, (const bf16r*)(ws + WS_WINA), NTOK, 4096, DM}; pg8::StaticOrder S; S.init(NTOK, 4096, G, (int)blockIdx.x);
          pg8::EpiProj<Sel0> E{rstd0, Sel0{proj}, 11};
          pg8::gemm_phase<pg8::EpiProj<Sel0>, pg8::StaticOrder, true, true>(glds, g, S, E); }
    }
    GRID_SYNC();
    }
    REP(2) {
    PH(2) { PHASE_IDS(); ssm_phase(P, lds, wave, lane);
    __syncthreads(); }
    GRID_SYNC();
    }
    REP(3) {
    PH(3) {
        { pg8::Gemm g{kvb  , (const bf16r*)(ws + WS_WGLU), NTOK, 1536, 1536}; pg8::StaticOrder S; S.init(NTOK, 1536, G, (int)blockIdx.x);
          pg8::EpiGlu E{kvb, proj + (size_t)NTOK * 1536, P.in[I_BGLU], cat};
          pg8::gemm_phase<pg8::EpiGlu, pg8::StaticOrder, true, true>(glds, g, S, E); }
        { pg8::Gemm g{memb, (const bf16r*)(ws + WS_WMKV0), NBATCH * NMEM, 1024, DM}; pg8::StaticOrder S; S.init(NBATCH * NMEM, 1024, G, (int)((blockIdx.x + G - G / 2) % G));
          pg8::EpiProj<SelM> E{rstdm, SelM{mkv}, 8};
          pg8::gemm_phase<pg8::EpiProj<SelM>, pg8::StaticOrder, true, true>(glds, g, S, E); }
        { pg8::Gemm g{memb, (const bf16r*)(ws + WS_WMKV1), NBATCH * NMEM, 1024, DM}; pg8::StaticOrder S; S.init(NBATCH * NMEM, 1024, G, (int)((blockIdx.x + G - G / 2 - 32) % G));
          pg8::EpiProj<SelM> E{rstdm, SelM{mkv + (size_t)2 * NBATCH * NMEM * 512}, 8};
          pg8::gemm_phase<pg8::EpiProj<SelM>, pg8::StaticOrder, true, true>(glds, g, S, E); }
        if ((int)blockIdx.x >= G - G / 4) {
            PHASE_IDS();
            LAS float* scr = (LAS float*)((LAS unsigned char*)lds + wave * 16384);
            constexpr int I_B = 32 * 128, I_KV = 32 * 96, I_O = 32 * 64, NIT2 = I_B + I_KV + I_O;
            const int gw2 = ((int)blockIdx.x - (G - G / 4)) * 8 + wave, NGW2 = (G / 4) * 8;
            for (int it = gw2; it < NIT2; it += NGW2) {
                int r = it;
                if (r < I_B) { transpose_item(P.in[I_WINB], P.in[I_PREG] + 2048, 2048, 4096, (bf16r*)(ws + WS_WKVB), 3072, scr, r, lane); continue; } r -= I_B;
                if (r < I_KV) { transpose_item(P.in[I_WKV], P.in[I_KVG], 2048, 3072, (bf16r*)(ws + WS_WKVB), 0, scr, r, lane); continue; } r -= I_KV;
                transpose_item(P.in[I_WOUT] + (size_t)2048 * 2048, nullptr, 2048, 2048, (bf16r*)(ws + WS_WOUT1), 0, scr, r, lane);
            }
        }
    }
    GRID_SYNC();
    }
    REP(10) {
    PH(10) att_phase<false, 0>(P, (char*)lds);
    GRID_SYNC();
    }
    REP(4) {
    PH(4) { pg8::Gemm g{cat, (const bf16r*)(ws + WS_WOUT0), NTOK, DM, DM}; pg8::StaticOrder S; S.init(NTOK, DM, G, (int)blockIdx.x);
      pg8::EpiOut E{ob, rep_ ? rowsq0 + 65536 * 9 : rowsq0};
      pg8::gemm_phase<pg8::EpiOut, pg8::StaticOrder, true, true>(glds, g, S, E); }
    GRID_SYNC();
    }
    REP(5) {
    PH(5) { PHASE_IDS();
        float* wl = (float*)lds;
        for (int i = tid; i < 12 * DM / 4; i += 512) ((f32x4*)wl)[i] = ((const f32x4*)wft)[i];
        __syncthreads();
        const float* gp = P.in[I_POSTG];
        f32x4 gv[8];
#pragma unroll
        for (int j = 0; j < 8; ++j) gv[j] = ((const f32x4*)gp)[lane + 64 * j];
        const float bfg = (lane < 12) ? P.in[I_BFG][lane] : 0.f;
        u32x2 xv[8]; u32x2 ov[8]; float rq = 0.f;
        if (gw < NTOK) { const u32x2* xp = (const u32x2*)(xb + (size_t)gw * DM) + lane; const u32x2* op = (const u32x2*)(ob + (size_t)gw * DM) + lane; rq = rowsq0[gw];
#pragma unroll
            for (int j = 0; j < 8; ++j) { xv[j] = __builtin_nontemporal_load(xp + 64 * j); ov[j] = __builtin_nontemporal_load(op + 64 * j); } }
        for (int m = gw; m < NTOK; m += NGW) {
            const float rso = 1.0f / sqrtf(rq * (1.0f / DM) + EPSN);
            u32x2 xn[8]; u32x2 on[8]; float rqn = 0.f; const int mn = m + NGW;
            if (mn < NTOK) { const u32x2* xp = (const u32x2*)(xb + (size_t)mn * DM) + lane; const u32x2* op = (const u32x2*)(ob + (size_t)mn * DM) + lane; rqn = rowsq0[mn];
#pragma unroll
                for (int j = 0; j < 8; ++j) { xn[j] = __builtin_nontemporal_load(xp + 64 * j); on[j] = __builtin_nontemporal_load(op + 64 * j); } }
            u32x2* hb = (u32x2*)(xb + (size_t)m * DM) + lane;
            f32x4 hv[8]; float s = 0.f;
#pragma unroll
            for (int j = 0; j < 8; ++j) {
                f32x4 h; h[0] = pg8::bf_lo(xv[j].x) + pg8::bf_lo(ov[j].x) * rso * gv[j][0]; h[1] = pg8::bf_hi(xv[j].x) + pg8::bf_hi(ov[j].x) * rso * gv[j][1];
                h[2] = pg8::bf_lo(xv[j].y) + pg8::bf_lo(ov[j].y) * rso * gv[j][2]; h[3] = pg8::bf_hi(xv[j].y) + pg8::bf_hi(ov[j].y) * rso * gv[j][3];
                hv[j] = h; s += (h[0] * h[0] + h[1] * h[1]) + (h[2] * h[2] + h[3] * h[3]);
                u32x2 w; w.x = pkbf(h[0], h[1]); w.y = pkbf(h[2], h[3]); hb[64 * j] = w; }
            if (mn < NTOK) {
#pragma unroll
                for (int j = 0; j < 8; ++j) { xv[j] = xn[j]; ov[j] = on[j]; } rq = rqn; }
            s = wave_sum(s); const float rs1 = 1.0f / sqrtf(s * (1.0f / DM) + EPSN);
            if (lane == 0) rstd1[m] = rs1;
            float dh[12];
#pragma unroll
            for (int h = 0; h < 12; ++h) {
                f32x4 wa[8];
#pragma unroll
                for (int j = 0; j < 8; ++j) wa[j] = *(const f32x4*)(wl + h * DM + (lane + 64 * j) * 4);
                __builtin_amdgcn_sched_barrier(0);
                float da = 0.f;
#pragma unroll
                for (int j = 0; j < 8; ++j) da += (hv[j][0] * wa[j][0] + hv[j][1] * wa[j][1]) + (hv[j][2] * wa[j][2] + hv[j][3] * wa[j][3]);
                dh[h] = da;
                __builtin_amdgcn_sched_barrier(0);
            }
#pragma unroll
            for (int o = 1; o < 64; o <<= 1) {
#pragma unroll
                for (int h = 0; h < 12; ++h) dh[h] += __shfl_xor(dh[h], o); }
            float mine = 0.f;
#pragma unroll
            for (int h = 0; h < 12; ++h) if (lane == h) mine = dh[h];
            if (lane < 12) { const float a = mine * rs1 + bfg; const float lf = fminf(a, 0.f) - __logf(1.f + __expf(-fabsf(a)));
                const int b = m >> 11, sidx = m & 2047; logf_[((size_t)(b * 12 + lane)) * SEQL + sidx] = lf; }
        }
    }
    GRID_SYNC();
    }
    REP(6) {
    PH(6) { PHASE_IDS();
        if (wave == 0) for (int rwi = blockIdx.x; rwi < NBATCH * 12; rwi += G) {
            const float* src = logf_ + (size_t)rwi * SEQL + lane * 32; float* dst = fcum + (size_t)rwi * SEQL + lane * 32;
            float v[32]; float run = 0.f;
#pragma unroll
            for (int q = 0; q < 8; ++q) { const f32x4 t = ((const f32x4*)src)[q]; v[4 * q] = t[0]; v[4 * q + 1] = t[1]; v[4 * q + 2] = t[2]; v[4 * q + 3] = t[3]; }
#pragma unroll
            for (int e = 0; e < 32; ++e) { run += v[e]; v[e] = run; }
            float incl = run;
#pragma unroll
            for (int o = 1; o < 64; o <<= 1) { const float t = __shfl_up(incl, o); if (lane >= o) incl += t; }
            const float excl = incl - run;
#pragma unroll
            for (int q = 0; q < 8; ++q) { f32x4 t = {v[4 * q] + excl, v[4 * q + 1] + excl, v[4 * q + 2] + excl, v[4 * q + 3] + excl}; ((f32x4*)dst)[q] = t; }
        }
        pg8::Gemm g{xb, (const bf16r*)(ws + WS_WKVB), NTOK, 7168, DM}; pg8::StaticOrder S; S.init(NTOK, 7168, G, (int)blockIdx.x);
        pg8::EpiProj<Sel1> E{rstd1, Sel1{kvb, proj, (float*)(ws + SM_QNRM), (float*)(ws + SM_KNRM)}, 11};
        pg8::gemm_phase<pg8::EpiProj<Sel1>, pg8::StaticOrder, true, true>(glds, g, S, E);
    }
    GRID_SYNC();
    }
    REP(7) {
    PH(7) att_phase<true, 1>(P, (char*)lds);
    GRID_SYNC();
    }
    REP(8) {
    PH(8) { pg8::Gemm g{cat, (const bf16r*)(ws + WS_WOUT1), NTOK, DM, DM}; pg8::StaticOrder S; S.init(NTOK, DM, G, (int)blockIdx.x);
      pg8::EpiOut E{ob, rep_ ? rowsq0 + 65536 * 9 : rowsq1};
      pg8::gemm_phase<pg8::EpiOut, pg8::StaticOrder, true, true>(glds, g, S, E); }
    GRID_SYNC();
    }
    REP(9) {
    PH(9) { PHASE_IDS();
        const float* gp = P.in[I_POSTG] + DM;
        f32x4 gv[8];
#pragma unroll
        for (int j = 0; j < 8; ++j) gv[j] = ((const f32x4*)gp)[lane + 64 * j];
        u32x2 hv[8]; u32x2 ov[8]; float rq = 0.f;
        if (gw < NTOK) { const u32x2* hp = (const u32x2*)(xb + (size_t)gw * DM) + lane; const u32x2* op = (const u32x2*)(ob + (size_t)gw * DM) + lane; rq = rowsq1[gw];
#pragma unroll
            for (int j = 0; j < 8; ++j) { hv[j] = __builtin_nontemporal_load(hp + 64 * j); ov[j] = __builtin_nontemporal_load(op + 64 * j); } }
        for (int m = gw; m < NTOK; m += NGW) {
            const float rso = 1.0f / sqrtf(rq * (1.0f / DM) + EPSN);
            u32x2 hn[8]; u32x2 on[8]; float rqn = 0.f; const int mn = m + NGW;
            if (mn < NTOK) { const u32x2* hp2 = (const u32x2*)(xb + (size_t)mn * DM) + lane; const u32x2* op = (const u32x2*)(ob + (size_t)mn * DM) + lane; rqn = rowsq1[mn];
#pragma unroll
                for (int j = 0; j < 8; ++j) { hn[j] = __builtin_nontemporal_load(hp2 + 64 * j); on[j] = __builtin_nontemporal_load(op + 64 * j); } }
            f32x4* hp = (f32x4*)(P.out + (size_t)m * DM) + lane;
#pragma unroll
            for (int j = 0; j < 8; ++j) { f32x4 h;
                h[0] = pg8::bf_lo(hv[j].x) + pg8::bf_lo(ov[j].x) * rso * gv[j][0]; h[1] = pg8::bf_hi(hv[j].x) + pg8::bf_hi(ov[j].x) * rso * gv[j][1];
                h[2] = pg8::bf_lo(hv[j].y) + pg8::bf_lo(ov[j].y) * rso * gv[j][2]; h[3] = pg8::bf_hi(hv[j].y) + pg8::bf_hi(ov[j].y) * rso * gv[j][3];
                __builtin_nontemporal_store(h, hp + 64 * j); }
            if (mn < NTOK) {
#pragma unroll
                for (int j = 0; j < 8; ++j) { hv[j] = hn[j]; ov[j] = on[j]; } rq = rqn; }
        }
    }
    }
}

extern "C" void kernel_launch(void* const* d_in, const int* in_sizes, int n_in, void* d_out, int out_size, void* d_ws, size_t ws_size, hipStream_t stream) {
    static int grid = 0;
    if (grid == 0) {
        if (n_in != 23 || out_size != NTOK * DM || ws_size < WS_END) { fprintf(stderr, "kernel_launch: unexpected shapes: n_in %d out %d ws %zu (need %zu)\n", n_in, out_size, ws_size, (size_t)WS_END); grid = -1; return; }
        int dev = 0, cus = 0, per_cu = 0;
        (void)hipGetDevice(&dev); (void)hipDeviceGetAttribute(&cus, hipDeviceAttributeMultiprocessorCount, dev);
        if (hipFuncSetAttribute((const void*)yoco_fwd, hipFuncAttributeMaxDynamicSharedMemorySize, LDS_TOTAL) != hipSuccess) { fprintf(stderr, "kernel_launch: hipFuncSetAttribute failed\n"); grid = -1; return; }
        if (hipOccupancyMaxActiveBlocksPerMultiprocessor(&per_cu, (const void*)yoco_fwd, 512, LDS_TOTAL) != hipSuccess || per_cu < 1) { fprintf(stderr, "kernel_launch: occupancy query says %d\n", per_cu); per_cu = 1; }
        (void)hipGetLastError();
        grid = cus * (per_cu > 1 ? 1 : per_cu);
        if (grid <= 0) grid = 256;
    }
    if (grid < 0) return;
    if (hipMemsetAsync((char*)d_ws + WS_BAR, 0, 16384, stream) != hipSuccess) { fprintf(stderr, "kernel_launch: hipMemsetAsync failed\n"); return; }
    Params p{};
    for (int i = 0; i < 23; ++i) p.in[i] = (const float*)d_in[i];
    p.out = (float*)d_out; p.ws = (unsigned char*)d_ws;
    void* args[] = {&p};
    hipError_t e = hipLaunchCooperativeKernel((const void*)yoco_fwd, dim3(grid), dim3(512), args, LDS_TOTAL, stream);
    if (e != hipSuccess) fprintf(stderr, "cooperative launch failed: %s (grid %d)\n", hipGetErrorString(e), grid);
}
```

```cpp
#include <hip/hip_runtime.h>
#include <hip/hip_bf16.h>
#include <hip/hip_cooperative_groups.h>
#include <cstdio>
#include <cstdint>
namespace cg = cooperative_groups;
__device__ __forceinline__ int opaque_tid() { int t = threadIdx.x; asm volatile("" : "+v"(t)); return t; }
namespace pg8 {
#define PG8_LAS __attribute__((address_space(3)))
typedef unsigned short bf16_t;
typedef short bf16x8 __attribute__((ext_vector_type(8)));
typedef float f32x4 __attribute__((ext_vector_type(4)));
typedef unsigned u32x4 __attribute__((ext_vector_type(4)));
constexpr int BM = 256, BK = 64, HALF = 128, HTB = HALF * BK * 2  , STAGE_BYTES = 8 * HTB, NXCD = 8, WGM = 4;

__host__ __device__ __forceinline__ int lds_byte(int r, int c) { const int st = (r >> 4) * 2 + (c >> 5), rr = r & 15, cc = c & 31, ob = rr * 64 + cc * 2; return st * 1024 + (ob ^ (((ob >> 9) & 1) << 5)); }
__host__ __device__ __forceinline__ void stage_rc(int b, int& R, int& C) { const int st = b / 1024, sb = b % 1024, swz = sb ^ (((sb >> 9) & 1) << 5); R = (st >> 1) * 16 + swz / 64; C = (st & 1) * 32 + (swz % 64) / 2; }
__host__ __device__ __forceinline__ int perm32(int rho) { const int n = rho >> 4, i = rho & 15; return 8 * (i >> 2) + 4 * n + (i & 3); }

struct Unit { int pm, pn; };
struct Gemm { const bf16_t* A; const bf16_t* Bt; int M, N, K; };

struct StaticOrder {
    int nM, nN, nwg, G, c;
    __host__ __device__ void init(int M, int N, int G_, int c_) { nM = M / BM; nN = N / BM; nwg = nM * nN; G = G_; c = c_; }
    __host__ __device__ bool next(int i, Unit& u) const {
        const long L = (long)i * G + c; if (L >= nwg) return false;
        int wgid = (int)L; { const int q = nwg / NXCD, r = nwg % NXCD, xcd = wgid % NXCD, off = wgid / NXCD; wgid = (xcd < r ? xcd * (q + 1) : r * (q + 1) + (xcd - r) * q) + off; }
        const int nig = WGM * nN, gid = wgid / nig, fm = gid * WGM, gsz = (nM - fm) < WGM ? (nM - fm) : WGM;
        u.pm = fm + ((wgid % nig) % gsz); u.pn = (wgid % nig) / gsz; return true;
    }
    __device__ __forceinline__ void a_ready(const Unit&) const {}
    __device__ __forceinline__ void done(const Unit&) const {}
};

__device__ __forceinline__ unsigned cvt_pk_bf16(float lo, float hi) { unsigned r; asm volatile("v_cvt_pk_bf16_f32 %0, %1, %2" : "=v"(r) : "v"(lo), "v"(hi)); return r; }
__device__ __forceinline__ float sigmoid_f(float v) { return __builtin_amdgcn_rcpf(1.f + __builtin_amdgcn_exp2f(-1.4426950408889634f * v)); }
__device__ __forceinline__ float silu_f(float v) { return v * sigmoid_f(v); }
__device__ __forceinline__ float bf_lo(unsigned w) { return __uint_as_float(w << 16); }
__device__ __forceinline__ float bf_hi(unsigned w) { return __uint_as_float(w & 0xffff0000u); }

__device__ __forceinline__ float xfq_sum(float v) {
    { auto r = __builtin_amdgcn_permlane16_swap(__float_as_uint(v), __float_as_uint(v), false, false); v = __uint_as_float(r[0]) + __uint_as_float(r[1]); }
    { auto r = __builtin_amdgcn_permlane32_swap(__float_as_uint(v), __float_as_uint(v), false, false); v = __uint_as_float(r[0]) + __uint_as_float(r[1]); }
    return v;
}
struct SecInfo { bf16_t* dst; int start; int ld; int nh; int act; float* nrm; };
template <class Sel> struct EpiProj {
    static constexpr bool PERM = true, AFTER_DRAIN = false;
    const float* rstd; Sel sel; int lgS;
    __device__ __forceinline__ void operator()(const f32x4 (&acc)[2][2][4][2], const Unit& u, int wr, int wc, int fr, int fq) const {
        const int row0 = u.pm * BM + wr * 64 + fr, cin = wc * 32 + 8 * fq;
        float rsv[2][4];
#pragma unroll
        for (int ai = 0; ai < 2; ++ai)
#pragma unroll
            for (int m = 0; m < 4; ++m) rsv[ai][m] = rstd[row0 + ai * HALF + m * 16];
#pragma unroll
        for (int bj = 0; bj < 2; ++bj) {
            const int cs = u.pn * BM + bj * HALF; const SecInfo si = sel(cs);
#pragma unroll
            for (int ai = 0; ai < 2; ++ai)
#pragma unroll
                for (int m = 0; m < 4; ++m) {
                    const int row = row0 + ai * HALF + m * 16; const float rs = rsv[ai][m];
                    f32x4 v0 = acc[ai][bj][m][0] * rs, v1 = acc[ai][bj][m][1] * rs;
                    if (si.act) {
#pragma unroll
                        for (int e = 0; e < 4; ++e) { v0[e] = silu_f(v0[e]); v1[e] = silu_f(v1[e]); } }
                    bf16_t* p;
                    if (si.nh) { const int b = row >> lgS, s = row & ((1 << lgS) - 1); const size_t hr = (((size_t)(b * si.nh + ((cs - si.start) >> 7))) << lgS) + s; p = si.dst + hr * 128 + cin;
                        if (si.nrm) { float q = (v0[0] * v0[0] + v0[1] * v0[1]) + (v0[2] * v0[2] + v0[3] * v0[3]) + (v1[0] * v1[0] + v1[1] * v1[1]) + (v1[2] * v1[2] + v1[3] * v1[3]);
                            q = xfq_sum(q); if (fq == 0) atomicAdd(si.nrm + hr, q); } }
                    else p = si.dst + (size_t)row * si.ld + (cs - si.start) + cin;
                    u32x4 w; w.x = cvt_pk_bf16(v0[0], v0[1]); w.y = cvt_pk_bf16(v0[2], v0[3]); w.z = cvt_pk_bf16(v1[0], v1[1]); w.w = cvt_pk_bf16(v1[2], v1[3]);
                    *(u32x4*)p = w;
                }
        }
    }
};
struct EpiGlu {
    static constexpr bool PERM = true, AFTER_DRAIN = false;
    const bf16_t* yg; const bf16_t* sz; const float* bias; bf16_t* cat;
    __device__ __forceinline__ void operator()(const f32x4 (&acc)[2][2][4][2], const Unit& u, int wr, int wc, int fr, int fq) const {
        const int row0 = u.pm * BM + wr * 64 + fr, col0 = u.pn * BM + wc * 32 + 8 * fq;
#pragma unroll
        for (int bj = 0; bj < 2; ++bj) {
            const int col = col0 + bj * HALF; const f32x4 b0 = *(const f32x4*)(bias + col), b1 = *(const f32x4*)(bias + col + 4);
#pragma unroll
            for (int ai = 0; ai < 2; ++ai) {
                u32x4 yv[4], zv[4];
#pragma unroll
                for (int m = 0; m < 4; ++m) { const int row = row0 + ai * HALF + m * 16;
                    yv[m] = __builtin_nontemporal_load((const u32x4*)(yg + (size_t)row * 1536 + col)); zv[m] = __builtin_nontemporal_load((const u32x4*)(sz + (size_t)row * 2048 + col)); }
#pragma unroll
                for (int m = 0; m < 4; ++m) {
                    const int row = row0 + ai * HALF + m * 16;
                    const u32x4 y = yv[m], z = zv[m];
                    const f32x4 g0 = acc[ai][bj][m][0] + b0, g1 = acc[ai][bj][m][1] + b1;
                    float o[8];
                    o[0] = bf_lo(y.x) * bf_lo(z.x) * sigmoid_f(g0[0]); o[1] = bf_hi(y.x) * bf_hi(z.x) * sigmoid_f(g0[1]);
                    o[2] = bf_lo(y.y) * bf_lo(z.y) * sigmoid_f(g0[2]); o[3] = bf_hi(y.y) * bf_hi(z.y) * sigmoid_f(g0[3]);
                    o[4] = bf_lo(y.z) * bf_lo(z.z) * sigmoid_f(g1[0]); o[5] = bf_hi(y.z) * bf_hi(z.z) * sigmoid_f(g1[1]);
                    o[6] = bf_lo(y.w) * bf_lo(z.w) * sigmoid_f(g1[2]); o[7] = bf_hi(y.w) * bf_hi(z.w) * sigmoid_f(g1[3]);
                    u32x4 w; w.x = cvt_pk_bf16(o[0], o[1]); w.y = cvt_pk_bf16(o[2], o[3]); w.z = cvt_pk_bf16(o[4], o[5]); w.w = cvt_pk_bf16(o[6], o[7]);
                    *(u32x4*)(cat + (size_t)row * 2048 + col) = w;
                }
            }
        }
    }
};
struct EpiOut {
    static constexpr bool PERM = true, AFTER_DRAIN = false;
    bf16_t* o; float* rowsq;
    __device__ __forceinline__ void operator()(const f32x4 (&acc)[2][2][4][2], const Unit& u, int wr, int wc, int fr, int fq) const {
        const int row0 = u.pm * BM + wr * 64 + fr, col0 = u.pn * BM + wc * 32 + 8 * fq;
#pragma unroll
        for (int ai = 0; ai < 2; ++ai)
#pragma unroll
            for (int m = 0; m < 4; ++m) {
                const int row = row0 + ai * HALF + m * 16; float s = 0.f;
#pragma unroll
                for (int bj = 0; bj < 2; ++bj) {
                    const f32x4 v0 = acc[ai][bj][m][0], v1 = acc[ai][bj][m][1];
                    s += (v0[0] * v0[0] + v0[1] * v0[1]) + (v0[2] * v0[2] + v0[3] * v0[3]) + (v1[0] * v1[0] + v1[1] * v1[1]) + (v1[2] * v1[2] + v1[3] * v1[3]);
                    u32x4 w; w.x = cvt_pk_bf16(v0[0], v0[1]); w.y = cvt_pk_bf16(v0[2], v0[3]); w.z = cvt_pk_bf16(v1[0], v1[1]); w.w = cvt_pk_bf16(v1[2], v1[3]);
                    *(u32x4*)(o + (size_t)row * 2048 + col0 + bj * HALF) = w;
                }
                s = xfq_sum(s);
                if (fq == 0) atomicAdd(rowsq + row, s);
            }
    }
};

template <class Epi, class Sched, bool ALIGN_EPI = false, bool SP2 = false>
__device__ __forceinline__ void gemm_phase(PG8_LAS unsigned char* lds, const Gemm g, const Sched& S, const Epi& E) {
    const int tid = opaque_tid(), wid = __builtin_amdgcn_readfirstlane(tid >> 6), lane = tid & 63, wr = wid >> 2, wc = wid & 3, fr = lane & 15, fq = lane >> 4;
    const int K = g.K, nt = K / BK;
    unsigned voffA[2], voffB[2];
#pragma unroll
    for (int i = 0; i < 2; ++i) { int R, C; stage_rc(tid * 16 + i * 8192, R, C); const int Rb = Epi::PERM ? ((R & ~31) + perm32(R & 31)) : R;
        voffA[i] = (unsigned)(R * K + C) * 2u; voffB[i] = (unsigned)(Rb * K + C) * 2u; }
    const size_t kstep = (size_t)(BK * 2);
    const size_t hstep = (size_t)HALF * K * 2;
    const size_t tstep = 2 * hstep;
    const unsigned ldsw = (unsigned)wid * 1024u;
    const int aoff = lds_byte(wr * 64 + fr, fq * 8), boff = lds_byte(wc * 32 + fr, fq * 8);
#define PG8_SA(b, h) (((b) * 2 + (h)) * HTB)
#define PG8_SB(b, h) ((4 + (b) * 2 + (h)) * HTB)
#define PG8_STAGE(bufoff, gbase, voff) do { _Pragma("unroll") for (int _i = 0; _i < 2; ++_i) \
        __builtin_amdgcn_global_load_lds((const unsigned*)((const char*)(gbase) + (voff)[_i]), (PG8_LAS unsigned*)(lds + (bufoff) + ldsw + _i * 8192), 16, 0, 0); } while (0)
#define PG8_LDA(dst, b, h) do { _Pragma("unroll") for (int m = 0; m < 4; ++m) _Pragma("unroll") for (int k = 0; k < 2; ++k) dst[m][k] = *(const PG8_LAS bf16x8*)(lds + PG8_SA(b, h) + aoff + m * 2048 + k * 1024); } while (0)
#define PG8_LDB(dst, b, h) do { _Pragma("unroll") for (int n = 0; n < 2; ++n) _Pragma("unroll") for (int k = 0; k < 2; ++k) dst[n][k] = *(const PG8_LAS bf16x8*)(lds + PG8_SB(b, h) + boff + n * 2048 + k * 1024); } while (0)
#define PG8_MMA(ai, bj, At, Bt) do { __builtin_amdgcn_s_setprio(1); _Pragma("unroll") for (int m = 0; m < 4; ++m) _Pragma("unroll") for (int n = 0; n < 2; ++n) _Pragma("unroll") for (int k = 0; k < 2; ++k) \
        acc[ai][bj][m][n] = __builtin_amdgcn_mfma_f32_16x16x32_bf16(Bt[n][k], At[m][k], acc[ai][bj][m][n], 0, 0, 0); __builtin_amdgcn_s_setprio(0); } while (0)
#define PG8_WAIT_V(n) asm volatile("s_waitcnt vmcnt(" #n ")" ::: "memory")
#define PG8_WAIT_L(n) asm volatile("s_waitcnt lgkmcnt(" #n ")" ::: "memory")
#define PG8_BAR __builtin_amdgcn_s_barrier()
#define PG8_SCHED __builtin_amdgcn_sched_barrier(0)
    Unit cur, nxt; int ui = 0;
    if (!S.next(0, cur)) return;
    f32x4 acc[2][2][4][2];
#pragma unroll
    for (int a = 0; a < 2; ++a)
#pragma unroll
        for (int b = 0; b < 2; ++b)
#pragma unroll
            for (int m = 0; m < 4; ++m)
#pragma unroll
                for (int n = 0; n < 2; ++n) acc[a][b][m][n] = (f32x4){0.f, 0.f, 0.f, 0.f};
    bf16x8 At[4][2], B0[2][2], B1[2][2];
    const char* cA = (const char*)g.A + (size_t)cur.pm * tstep; const char* cB = (const char*)g.Bt + (size_t)cur.pn * tstep;
    S.a_ready(cur);
    if constexpr (SP2) {
        PG8_STAGE(PG8_SB(0, 0), cB, voffB); PG8_STAGE(PG8_SB(0, 1), cB + hstep, voffB); PG8_STAGE(PG8_SA(0, 0), cA, voffA); PG8_STAGE(PG8_SA(0, 1), cA + hstep, voffA);
        if (wr == 1) PG8_BAR;
        PG8_WAIT_V(2); PG8_BAR;
        PG8_STAGE(PG8_SB(1, 0), cB + kstep, voffB); PG8_STAGE(PG8_SA(1, 0), cA + kstep, voffA); PG8_STAGE(PG8_SB(1, 1), cB + hstep + kstep, voffB);
        PG8_WAIT_V(6); PG8_BAR;
    } else {
        PG8_STAGE(PG8_SB(0, 0), cB, voffB); PG8_STAGE(PG8_SA(0, 0), cA, voffA); PG8_STAGE(PG8_SB(0, 1), cB + hstep, voffB); PG8_STAGE(PG8_SA(0, 1), cA + hstep, voffA);
        if (wr == 1) PG8_BAR;
        PG8_WAIT_V(4); PG8_BAR;
        PG8_STAGE(PG8_SB(1, 0), cB + kstep, voffB); PG8_STAGE(PG8_SA(1, 0), cA + kstep, voffA); PG8_STAGE(PG8_SB(1, 1), cB + hstep + kstep, voffB);
        PG8_WAIT_V(6); PG8_BAR;
    }
    for (;;) {
        const bool has_next = S.next(ui + 1, nxt);
        const char* nA = has_next ? (const char*)g.A + (size_t)nxt.pm * tstep : cA; const char* nB = has_next ? (const char*)g.Bt + (size_t)nxt.pn * tstep : cB;
        for (int t = 0; t < nt; t += 2) {
            const bool last = (t == nt - 2);
            const char* a1 = cA + (size_t)(t + 1) * kstep;
            const char* a2 = last ? nA : cA + (size_t)(t + 2) * kstep; const char* b2 = last ? nB : cB + (size_t)(t + 2) * kstep;
            const char* a3 = a2 + kstep; const char* b3 = b2 + kstep;
            if (last && has_next) S.a_ready(nxt);
            if constexpr (SP2) {
            PG8_LDB(B0, 0, 0); PG8_LDB(B1, 0, 1); PG8_SCHED; PG8_LDA(At, 0, 0); PG8_STAGE(PG8_SA(1, 1), a1 + hstep, voffA);
            PG8_WAIT_V(8); PG8_WAIT_L(0); PG8_BAR; PG8_MMA(0, 0, At, B0); PG8_MMA(0, 1, At, B1); PG8_BAR; PG8_SCHED;
            PG8_LDA(At, 0, 1); PG8_STAGE(PG8_SB(0, 0), b2, voffB); PG8_STAGE(PG8_SB(0, 1), b2 + hstep, voffB); PG8_STAGE(PG8_SA(0, 0), a2, voffA);
            PG8_WAIT_V(8); PG8_WAIT_L(0); PG8_BAR; PG8_MMA(1, 0, At, B0); PG8_MMA(1, 1, At, B1); PG8_BAR; PG8_SCHED;
            PG8_LDB(B0, 1, 0); PG8_LDB(B1, 1, 1); PG8_SCHED; PG8_LDA(At, 1, 0); PG8_STAGE(PG8_SA(0, 1), a2 + hstep, voffA);
            PG8_WAIT_V(8); PG8_WAIT_L(0); PG8_BAR; PG8_MMA(0, 0, At, B0); PG8_MMA(0, 1, At, B1); PG8_BAR; PG8_SCHED;
            PG8_LDA(At, 1, 1); PG8_STAGE(PG8_SB(1, 0), b3, voffB); PG8_STAGE(PG8_SB(1, 1), b3 + hstep, voffB); PG8_STAGE(PG8_SA(1, 0), a3, voffA);
            PG8_WAIT_V(8); PG8_WAIT_L(0); PG8_BAR; PG8_MMA(1, 0, At, B0); PG8_MMA(1, 1, At, B1); PG8_BAR; PG8_SCHED;
            } else {
            PG8_LDB(B0, 0, 0); PG8_SCHED; PG8_LDA(At, 0, 0); PG8_STAGE(PG8_SA(1, 1), a1 + hstep, voffA);
            PG8_WAIT_L(8); PG8_BAR; PG8_WAIT_L(0); PG8_MMA(0, 0, At, B0); PG8_BAR; PG8_SCHED;
            PG8_LDB(B1, 0, 1); PG8_STAGE(PG8_SB(0, 0), b2, voffB);
            PG8_BAR; PG8_WAIT_L(0); PG8_MMA(0, 1, At, B1); PG8_BAR;
            PG8_LDA(At, 0, 1); PG8_STAGE(PG8_SA(0, 0), a2, voffA);
            PG8_BAR; PG8_WAIT_L(0); PG8_MMA(1, 0, At, B0); PG8_BAR; PG8_SCHED;
            PG8_STAGE(PG8_SB(0, 1), b2 + hstep, voffB);
            PG8_WAIT_V(6); PG8_BAR; PG8_MMA(1, 1, At, B1); PG8_BAR;
            PG8_LDB(B0, 1, 0); PG8_SCHED; PG8_LDA(At, 1, 0); PG8_STAGE(PG8_SA(0, 1), a2 + hstep, voffA);
            PG8_WAIT_L(8); PG8_BAR; PG8_WAIT_L(0); PG8_MMA(0, 0, At, B0); PG8_BAR; PG8_SCHED;
            PG8_LDB(B1, 1, 1); PG8_STAGE(PG8_SB(1, 0), b3, voffB);
            PG8_BAR; PG8_WAIT_L(0); PG8_MMA(0, 1, At, B1); PG8_BAR;
            PG8_LDA(At, 1, 1); PG8_STAGE(PG8_SA(1, 0), a3, voffA);
            PG8_BAR; PG8_WAIT_L(0); PG8_MMA(1, 0, At, B0); PG8_BAR; PG8_SCHED;
            PG8_STAGE(PG8_SB(1, 1), b3 + hstep, voffB);
            PG8_WAIT_V(6); PG8_BAR; PG8_MMA(1, 1, At, B1); PG8_BAR;
            }
        }
        if constexpr (ALIGN_EPI) { if (wr == 0) PG8_BAR; }
        if constexpr (!Epi::AFTER_DRAIN) { E(acc, cur, wr, wc, fr, fq); S.done(cur); }
        if (!has_next) break;
#pragma unroll
        for (int a = 0; a < 2; ++a)
#pragma unroll
            for (int b = 0; b < 2; ++b)
#pragma unroll
                for (int m = 0; m < 4; ++m)
#pragma unroll
                    for (int n = 0; n < 2; ++n) acc[a][b][m][n] = (f32x4){0.f, 0.f, 0.f, 0.f};
        cur = nxt; cA = nA; cB = nB; ++ui;
        if constexpr (ALIGN_EPI) { if (wr == 1) PG8_BAR; }
    }
    PG8_WAIT_V(0);
    if constexpr (!ALIGN_EPI) { if (wr == 0) PG8_BAR; }
    PG8_BAR;
    if constexpr (Epi::AFTER_DRAIN) { E.fused(acc, cur, wr, wc, fr, fq, lds, wid, lane); S.done(cur); }
#undef PG8_SA
#undef PG8_SB
#undef PG8_STAGE
#undef PG8_LDA
#undef PG8_LDB
#undef PG8_MMA
#undef PG8_WAIT_V
#undef PG8_WAIT_L
#undef PG8_BAR
#undef PG8_SCHED
}
}
namespace att {
constexpr int D = 128; constexpr bool WSKIP = false; constexpr float THR = 8.f;
constexpr float SCALE = 0.08838834764831845f;
constexpr int NW = 8, QBLK = 32, KVBLK = 64, QB = NW * QBLK;
constexpr int SHM_V = KVBLK * D * 2, SHM_K = KVBLK * D * 2;
constexpr int FB_OFF = 2 * SHM_V + 2 * SHM_K + NW * 64 * 4;
constexpr int QL_OFF = FB_OFF + 2048 * 4;
constexpr int LDS_BYTES = QL_OFF + NW * QBLK * D * 2;
constexpr int LDO = 2048; constexpr float INV_SCALE = 11.313708498984761f;

using bf16 = __hip_bfloat16;
typedef short bf16x8 __attribute__((ext_vector_type(8)));
typedef short s16x4 __attribute__((ext_vector_type(4)));
typedef float f32x16 __attribute__((ext_vector_type(16)));
typedef float f32x4 __attribute__((ext_vector_type(4)));
typedef unsigned u32x4 __attribute__((ext_vector_type(4)));
template <class A, class Bt> struct same_t { static constexpr bool v = false; };
template <class A> struct same_t<A, A> { static constexpr bool v = true; };

#define KSWZ(row, colB) ((row) * 256 + ((colB) ^ (((row) & 7) << 4)))
#define SBAR() __builtin_amdgcn_sched_barrier(0)
__device__ __forceinline__ int v_st(int k, int c) { const int kk = (k & ~0xC) | ((k & 4) << 1) | ((k & 8) >> 1); return ((kk >> 3) * 4 + (c >> 5)) * 512 + ((kk & 7) * 32 + (c & 31)) * 2; }
__device__ __forceinline__ int v_rd_base(int lane) { return ((lane & 3) << 3) | (((lane >> 2) & 3) << 6) | (((lane >> 4) & 1) << 5) | (((lane >> 5) & 1) << 8); }
constexpr int v_rd_off(int d0, int ks, int half) { return d0 * 512 + ks * 4096 + half * 2048; }
__device__ __forceinline__ int crow(int r, int hi) { return (r & 3) + 8 * (r >> 2) + 4 * hi; }
__device__ __forceinline__ unsigned cvtpk(float lo, float hi) {
    unsigned r; asm volatile("v_cvt_pk_bf16_f32 %0, %1, %2" : "=v"(r) : "v"(lo), "v"(hi)); return r;
}
__device__ __forceinline__ bf16x8 pack8(f32x4 a, f32x4 b) {
    u32x4 w = {cvtpk(a[0], a[1]), cvtpk(a[2], a[3]), cvtpk(b[0], b[1]), cvtpk(b[2], b[3])};
    return *reinterpret_cast<bf16x8*>(&w);
}
template <class T> __device__ __forceinline__ bf16x8 load8(const T* p) {
    if constexpr (same_t<T, float>::v) { return pack8(*(const f32x4*)p, *(const f32x4*)(p + 4)); }
    else { return *reinterpret_cast<const bf16x8*>(p); }
}
__device__ __forceinline__ void mask_tile(f32x16& p0, f32x16& p1, int dq, unsigned W) {
    const float NEG = -__builtin_inff();
#pragma unroll
    for (int r = 0; r < 16; ++r) {
        const int c = (r & 3) + 8 * (r >> 2);
        if ((unsigned)(dq - c) >= W) p0[r] = NEG;
        if ((unsigned)(dq - c - 32) >= W) p1[r] = NEG;
    }
}
__device__ __forceinline__ void partialSM(f32x16& p0, f32x16& p1, float& m_reg, float& mn, float& alpha) {
    float pmax = p0[0]; for (int r = 1; r < 16; ++r) pmax = fmaxf(pmax, p0[r]); for (int r = 0; r < 16; ++r) pmax = fmaxf(pmax, p1[r]);
    { auto rr = __builtin_amdgcn_permlane32_swap(__float_as_uint(pmax), __float_as_uint(pmax), false, false);
      pmax = fmaxf(__uint_as_float(rr[0]), __uint_as_float(rr[1])); }
    constexpr float C2 = 1.4426950408889634f * SCALE;
    if (__builtin_expect(__all((pmax - m_reg) * SCALE <= THR), 1)) { mn = m_reg; alpha = 1.f; }
    else { mn = fmaxf(m_reg, pmax); alpha = __builtin_amdgcn_exp2f((m_reg - mn) * C2); m_reg = mn; }
    const float mnL = -mn * C2;
    for (int r = 0; r < 16; ++r) p0[r] = fmaf(p0[r], C2, mnL); for (int r = 0; r < 16; ++r) p1[r] = fmaf(p1[r], C2, mnL);
    for (int r = 0; r < 16; ++r) p0[r] = __builtin_amdgcn_exp2f(p0[r]);
}
__device__ __forceinline__ void finishSM(f32x16& p0, f32x16& p1, float alpha, float& l_reg, bf16x8& pa0, bf16x8& pa1, bf16x8& pa2, bf16x8& pa3) {
    for (int r = 0; r < 16; ++r) p1[r] = __builtin_amdgcn_exp2f(p1[r]);
    float ps = 0; for (int r = 0; r < 16; ++r) ps += p0[r]; for (int r = 0; r < 16; ++r) ps += p1[r];
    { auto rr = __builtin_amdgcn_permlane32_swap(__float_as_uint(ps), __float_as_uint(ps), false, false);
      ps = __uint_as_float(rr[0]) + __uint_as_float(rr[1]); }
    l_reg = l_reg * alpha + ps;
#define PK4(P, B_, OUT) do { unsigned a0 = cvtpk(P[B_+0], P[B_+1]), a1 = cvtpk(P[B_+2], P[B_+3]);                          \
        unsigned b0 = cvtpk(P[B_+4], P[B_+5]), b1 = cvtpk(P[B_+6], P[B_+7]);                                             \
        auto r0 = __builtin_amdgcn_permlane32_swap(a0, b0, false, false); auto r1 = __builtin_amdgcn_permlane32_swap(a1, b1, false, false); \
        u32x4 w = {r0[0], r1[0], r0[1], r1[1]}; OUT = *reinterpret_cast<bf16x8*>(&w); } while (0)
    PK4(p0, 0, pa0); PK4(p0, 8, pa1); PK4(p1, 0, pa2); PK4(p1, 8, pa3);
#undef PK4
}
template <int KB, bool SK>
__device__ __forceinline__ void qkt(f32x16& p0, f32x16& p1, const char* K_lds, int r32, int hi, const char* q_w, bool act, const float* fbt) {
    if (SK && !act) { const float NEG = -__builtin_inff();
#pragma unroll
        for (int r = 0; r < 16; ++r) { p0[r] = NEG; p1[r] = NEG; } return; }
    {
#pragma unroll
        for (int r4 = 0; r4 < 4; ++r4) { const f32x4 a = *(const f32x4*)(fbt + 8 * r4 + 4 * hi), b = *(const f32x4*)(fbt + 32 + 8 * r4 + 4 * hi);
            p0[4 * r4] = a[0]; p0[4 * r4 + 1] = a[1]; p0[4 * r4 + 2] = a[2]; p0[4 * r4 + 3] = a[3];
            p1[4 * r4] = b[0]; p1[4 * r4 + 1] = b[1]; p1[4 * r4 + 2] = b[2]; p1[4 * r4 + 3] = b[3]; }
    }
    const char* kb[4]; const char* qb[4];
#pragma unroll
    for (int dd = 0; dd < 4; ++dd) { kb[dd] = K_lds + KB * SHM_K + KSWZ(r32, (dd * 16 + hi * 8) * 2); qb[dd] = q_w + KSWZ(r32, (dd * 16 + hi * 8) * 2); }
    bf16x8 b0 = *reinterpret_cast<const bf16x8*>(kb[0]), b1 = *reinterpret_cast<const bf16x8*>(kb[0] + 32 * 256), qf = *reinterpret_cast<const bf16x8*>(qb[0]);
#pragma unroll
    for (int d0 = 0; d0 < 8; ++d0) {
        bf16x8 b0n = b0, b1n = b1, qfn = qf;
        if (d0 < 7) { const char* a = kb[(d0 + 1) & 3] + ((d0 + 1) >> 2) * 128;
            b0n = *reinterpret_cast<const bf16x8*>(a); b1n = *reinterpret_cast<const bf16x8*>(a + 32 * 256);
            qfn = *reinterpret_cast<const bf16x8*>(qb[(d0 + 1) & 3] + ((d0 + 1) >> 2) * 128); }
        __builtin_amdgcn_sched_barrier(0);
        p0 = __builtin_amdgcn_mfma_f32_32x32x16_bf16(b0, qf, p0, 0, 0, 0);
        p1 = __builtin_amdgcn_mfma_f32_32x32x16_bf16(b1, qf, p1, 0, 0, 0);
        __builtin_amdgcn_sched_barrier(0);
        b0 = b0n; b1 = b1n; qf = qfn; }
}
template <int VB, bool SK>
__device__ __forceinline__ void pv_tile(f32x16* o, int vb0, bf16x8 pa0, bf16x8 pa1, bf16x8 pa2, bf16x8 pa3, bool act) {
    if (SK && !act) return;
#define TRRD(dst, off) asm volatile("ds_read_b64_tr_b16 %0, %1 offset:%2" : "=&v"(dst) : "v"(vb0), "i"(off) : "memory")
#define PV_D0(d0) do { s16x4 l0, l1, l2, l3, h0, h1, h2, h3; constexpr int b_ = VB * SHM_V + v_rd_off(d0, 0, 0);     \
        TRRD(l0, b_); TRRD(h0, b_ + 2048); TRRD(l1, b_ + 4096); TRRD(h1, b_ + 6144); TRRD(l2, b_ + 8192); TRRD(h2, b_ + 10240); TRRD(l3, b_ + 12288); TRRD(h3, b_ + 14336); \
        asm volatile("s_waitcnt lgkmcnt(0)" ::: "memory"); SBAR();                 \
        o[d0] = __builtin_amdgcn_mfma_f32_32x32x16_bf16(pa0, (bf16x8){l0[0], l0[1], l0[2], l0[3], h0[0], h0[1], h0[2], h0[3]}, o[d0], 0, 0, 0);   \
        o[d0] = __builtin_amdgcn_mfma_f32_32x32x16_bf16(pa1, (bf16x8){l1[0], l1[1], l1[2], l1[3], h1[0], h1[1], h1[2], h1[3]}, o[d0], 0, 0, 0);   \
        o[d0] = __builtin_amdgcn_mfma_f32_32x32x16_bf16(pa2, (bf16x8){l2[0], l2[1], l2[2], l2[3], h2[0], h2[1], h2[2], h2[3]}, o[d0], 0, 0, 0);   \
        o[d0] = __builtin_amdgcn_mfma_f32_32x32x16_bf16(pa3, (bf16x8){l3[0], l3[1], l3[2], l3[3], h3[0], h3[1], h3[2], h3[3]}, o[d0], 0, 0, 0); } while (0)
    PV_D0(0); PV_D0(1); PV_D0(2); PV_D0(3);
#undef PV_D0
#undef TRRD
}

template <class TIn, class TOut> struct BlockRef { const TIn* Q; const TIn* K; const TIn* V; TOut* O; const float* FC; const TIn* G; int P0; int JLO; };
template <class TIn> struct Seam {
    bf16x8 qr[8];
    bf16x8 st_v0, st_v1, st_k0, st_k1; f32x4 sf0, sf1, sf2, sf3;
    f32x4 tq[16];
};
__device__ __forceinline__ int swa_jlo(int P0, int W) { const int lowk = P0 - W + 1; return lowk > 0 ? lowk / KVBLK : 0; }
#define ROW(p, k0, rr) ((p) + (size_t)((k0) + (rr)) * D + sc)
#define VMW() asm volatile("s_waitcnt vmcnt(0)" ::: "memory")
#define VMWN(n) asm volatile("s_waitcnt vmcnt(%0)" :: "i"(n) : "memory")
#define SLOAD_H(Kp, Vp, k0) do { S.st_v0 = load8<TIn>(ROW(Vp, k0, sr)); S.st_v1 = load8<TIn>(ROW(Vp, k0, 32 + sr));              \
                         S.st_k0 = load8<TIn>(ROW(Kp, k0, sr)); S.st_k1 = load8<TIn>(ROW(Kp, k0, 32 + sr)); } while (0)
#define SWRITE_HK(bf) do { *(bf16x8*)(K_lds + (bf) * SHM_K + kws) = S.st_k0; *(bf16x8*)(K_lds + (bf) * SHM_K + kws + 32 * 256) = S.st_k1; } while (0)
#define SWRITE_HV(bf) do { *(bf16x8*)(V_lds + (bf) * SHM_V + vst0) = S.st_v0; *(bf16x8*)(V_lds + (bf) * SHM_V + vst1) = S.st_v1; } while (0)
#define SWRITE_H(bf) do { SWRITE_HV(bf); SWRITE_HK(bf); } while (0)
#define SLOAD_F(p, k0) do { S.sf0 = *(const f32x4*)ROW(p, k0, sr); S.sf1 = *(const f32x4*)(ROW(p, k0, sr) + 4);                \
                            S.sf2 = *(const f32x4*)ROW(p, k0, 32 + sr); S.sf3 = *(const f32x4*)(ROW(p, k0, 32 + sr) + 4); } while (0)
#define SWRITE_KF(bf) do { *(bf16x8*)(K_lds + (bf) * SHM_K + kws) = pack8(S.sf0, S.sf1); *(bf16x8*)(K_lds + (bf) * SHM_K + kws + 32 * 256) = pack8(S.sf2, S.sf3); } while (0)
#define SWRITE_VF(bf) do { *(bf16x8*)(V_lds + (bf) * SHM_V + vst0) = pack8(S.sf0, S.sf1); *(bf16x8*)(V_lds + (bf) * SHM_V + vst1) = pack8(S.sf2, S.sf3); } while (0)
template <class TIn, class TOut>
__device__ __forceinline__ void causal_swa_prime(const BlockRef<TIn, TOut>& cur, int W, char* lds, Seam<TIn>& S) {
    constexpr bool F32 = same_t<TIn, float>::v;
    const int tid = opaque_tid(), wid = __builtin_amdgcn_readfirstlane(tid >> 6), lane = tid & 63, r32 = lane & 31, hi = lane >> 5;
    const int sr = tid >> 4, sc = (tid & 15) * 8, kws = KSWZ(sr, sc * 2); char* K_lds = lds + 2 * SHM_V;
    const int kb0 = cur.JLO * KVBLK;
    for (int d0 = 0; d0 < 8; ++d0) S.qr[d0] = load8<TIn>(cur.Q + (size_t)(wid * QBLK + r32) * D + d0 * 16 + hi * 8);
    { char* q_w = lds + QL_OFF + wid * (QBLK * D * 2);
      for (int d0 = 0; d0 < 8; ++d0) *reinterpret_cast<bf16x8*>(q_w + KSWZ(r32, (d0 * 16 + hi * 8) * 2)) = S.qr[d0]; }
    if constexpr (F32) { SLOAD_F((const float*)cur.K, kb0); VMW(); SWRITE_KF(0); SBAR(); SLOAD_F((const float*)cur.V, kb0); }
    else { SLOAD_H(cur.K, cur.V, kb0); VMW(); SWRITE_HK(0); }
    __syncthreads();
}
template <class TIn, class TOut>
__device__ __forceinline__ void causal_swa_block(const BlockRef<TIn, TOut>& cur, const BlockRef<TIn, TOut>& nxt, int skv, int W, char* lds, Seam<TIn>& S) {
    constexpr bool F32 = same_t<TIn, float>::v;
    const int tid = opaque_tid(), wid = __builtin_amdgcn_readfirstlane(tid >> 6), lane = tid & 63, r32 = lane & 31, hi = lane >> 5;
    const int j_lo = cur.JLO;
    int j_hi = (cur.P0 + QB - 1) / KVBLK + 1; if (j_hi > skv / KVBLK) j_hi = skv / KVBLK;
    const int NT = j_hi - j_lo;
    const int kbn = nxt.JLO * KVBLK;
    const int qlo = cur.P0 + wid * QBLK, qm = qlo + r32 - 4 * hi;
    char* V_lds = lds; char* K_lds = lds + 2 * SHM_V;
    float* ws = (float*)(lds + 2 * SHM_V + 2 * SHM_K) + wid * 64; float* li_l = ws, * al_l = ws + 32;
    float m_reg = -1e30f, l_reg = 0; f32x16 o[4] = {};
    const int sr = tid >> 4, sc = (tid & 15) * 8, vst0 = v_st(sr, sc), vst1 = v_st(32 + sr, sc), kws = KSWZ(sr, sc * 2);
    const int vb0 = (int)(uintptr_t)V_lds + v_rd_base(lane);
    const TIn* Kh = cur.K; const TIn* Vh = cur.V;
    char* q_w = lds + QL_OFF + wid * (QBLK * D * 2);
    float* fb = (float*)(lds + FB_OFF);
    { const int nk = j_hi * KVBLK; const float* FCp = cur.FC; const float c0 = FCp ? FCp[cur.P0] : 0.f;
#pragma unroll
      for (int k = 0; k < 4; ++k) { const int i = tid + 64 * NW * k;
          if (i < nk) { float v = 0.f; if (FCp) v = (c0 - FCp[i]) * INV_SCALE; fb[i] = v; } }
      __syncthreads(); }
#define RESC(a) do { if (__any((a) < 1.f)) { if (hi == 0) al_l[r32] = (a); asm volatile("s_waitcnt lgkmcnt(0)" ::: "memory");              \
                     for (int d_ = 0; d_ < 4; ++d_) for (int r = 0; r < 16; ++r) o[d_][r] *= al_l[crow(r, hi)]; } } while (0)
#define KBASE(t) ((j_lo + (t)) * KVBLK)
#define ACT(t) (KBASE(t) <= qlo + QBLK - 1 && KBASE(t) + KVBLK - 1 >= qlo - W + 1)
#define MASKT(P0_, P1_, t) do { const int kb_ = KBASE(t); if ((!SK || ACT(t)) && (kb_ + KVBLK - 1 > qlo || kb_ <= qlo + QBLK - 1 - W)) mask_tile(P0_, P1_, qm - kb_, (unsigned)W); } while (0)
    constexpr int NQL = F32 ? 16 : 8;
    constexpr bool SK = WSKIP && !F32;
#define SEAM_K0() do { VMWN(NQL); if constexpr (F32) { SWRITE_KF(0); SBAR(); SLOAD_F((const float*)nxt.V, kbn); } else { SWRITE_HK(0); } SBAR(); } while (0)
    f32x16 pA0, pA1, pB0, pB1; float mnA, mnB, alA, alB; bf16x8 pa0, pa1, pa2, pa3;
    if constexpr (F32) { VMW(); SWRITE_VF(0); SBAR(); } else { SWRITE_HV(0); SBAR(); }
    if (NT > 1) { if constexpr (F32) SLOAD_F((const float*)Kh, KBASE(1)); else SLOAD_H(Kh, Vh, KBASE(1)); }
    SBAR(); qkt<0, SK>(pA0, pA1, K_lds, r32, hi, q_w, ACT(0), fb + KBASE(0));
    if constexpr (F32) { if (NT > 1) { VMW(); SWRITE_KF(1); SBAR(); SLOAD_F((const float*)Vh, KBASE(1)); } }
    MASKT(pA0, pA1, 0); partialSM(pA0, pA1, m_reg, mnA, alA);
    if (NT > 1) { VMW(); if constexpr (F32) { SWRITE_VF(1); SBAR(); if (NT > 2) SLOAD_F((const float*)Kh, KBASE(2)); } else SWRITE_H(1); }
    __syncthreads();
#define HALF_STEP(PX0, PX1, mnX, alX, PY0, PY1, alY, t, KB, VB, SB) do {                                                      \
        SBAR(); qkt<KB, SK>(PX0, PX1, K_lds, r32, hi, q_w, ACT(t), fb + KBASE(t));                                             \
        finishSM(PY0, PY1, alY, l_reg, pa0, pa1, pa2, pa3); SBAR();                                                           \
        if ((t) + 1 < NT) { if constexpr (F32) { VMW(); SWRITE_KF(SB); SBAR(); SLOAD_F((const float*)Vh, KBASE((t) + 1)); }  \
                            else { SLOAD_H(Kh, Vh, KBASE((t) + 1)); } SBAR(); }                                               \
        pv_tile<VB, SK>(o, vb0, pa0, pa1, pa2, pa3, ACT((t) - 1)); MASKT(PX0, PX1, (t)); partialSM(PX0, PX1, m_reg, mnX, alX);                                        \
        __syncthreads();                                                                                                      \
        if ((t) + 1 < NT) { VMW(); if constexpr (F32) { SWRITE_VF(SB); SBAR(); if ((t) + 2 < NT) SLOAD_F((const float*)Kh, KBASE((t) + 2)); } \
                            else { SWRITE_H(SB); } }                                                                          \
        RESC(alX); __syncthreads(); } while (0)
    for (int t = 1; t + 1 < NT; t += 2) {
        HALF_STEP(pB0, pB1, mnB, alB, pA0, pA1, alA, t, 1, 0, 0);
        HALF_STEP(pA0, pA1, mnA, alA, pB0, pB1, alB, t + 1, 0, 1, 1);
    }
    const bool even = (NT & 1) == 0;
    if (even) { SBAR(); qkt<1, SK>(pB0, pB1, K_lds, r32, hi, q_w, ACT(NT - 1), fb + KBASE(NT - 1)); SBAR(); }
#define QROW(e) (nxt.Q + (size_t)(wid * QBLK + r32) * D + ((e) >> 1) * 16 + hi * 8 + ((e) & 1) * 4)
    if constexpr (F32) { SLOAD_F((const float*)nxt.K, kbn); SBAR();
#pragma unroll
        for (int e = 0; e < 8; ++e) S.tq[e] = *(const f32x4*)QROW(e); }
    else { SLOAD_H(nxt.K, nxt.V, kbn); SBAR();
#pragma unroll
        for (int d0 = 0; d0 < 8; ++d0) S.qr[d0] = load8<TIn>(nxt.Q + (size_t)(wid * QBLK + r32) * D + d0 * 16 + hi * 8); }
    SBAR();
    finishSM(pA0, pA1, alA, l_reg, pa0, pa1, pa2, pa3); SBAR();
    if constexpr (F32) {
#pragma unroll
        for (int e = 8; e < 16; ++e) S.tq[e] = *(const f32x4*)QROW(e); SBAR(); }
#undef QROW
    pv_tile<0, SK>(o, vb0, pa0, pa1, pa2, pa3, ACT(even ? NT - 2 : NT - 1));
    if (even) { MASKT(pB0, pB1, NT - 1); partialSM(pB0, pB1, m_reg, mnB, alB); __syncthreads(); RESC(alB);
        finishSM(pB0, pB1, alB, l_reg, pa0, pa1, pa2, pa3); SBAR(); pv_tile<1, SK>(o, vb0, pa0, pa1, pa2, pa3, ACT(NT - 1)); }
    SBAR(); SEAM_K0();
    if (hi == 0) li_l[r32] = l_reg; asm volatile("s_waitcnt lgkmcnt(0)" ::: "memory");
    float rli[16];
#pragma unroll
    for (int r = 0; r < 16; ++r) rli[r] = __builtin_amdgcn_rcpf(li_l[crow(r, hi)]);
    {
        unsigned short* ost = (unsigned short*)q_w;
        {
            const bool odd = (r32 & 1) != 0; unsigned short* ob_ = ost + (odd ? 32 : 0) + (r32 & ~1);
#pragma unroll
            for (int r = 0; r < 16; ++r) { const int orow = crow(r, hi);
#pragma unroll
                for (int dp = 0; dp < 4; dp += 2) { const float e0 = o[dp][r] * rli[r], e1 = o[dp + 1][r] * rli[r];
                    const float snd = odd ? e0 : e1;
                    const float rcv = __int_as_float(__builtin_amdgcn_update_dpp(0, __float_as_int(snd), 0xB1, 0xF, 0xF, true));
                    const float lo = odd ? rcv : e0, hi_ = odd ? e1 : rcv;
                    *(unsigned*)(ob_ + orow * 128 + dp * 32) = cvtpk(lo, hi_); } }
        }
        asm volatile("s_waitcnt lgkmcnt(0)" ::: "memory");
        const unsigned short* Gw = (const unsigned short*)cur.G + (size_t)(wid * QBLK) * LDO; TOut* Ow = cur.O + (size_t)(wid * QBLK) * LDO;
        const int ck = lane & 15, rq = lane >> 4;
        u32x4 gq[8];
#pragma unroll
        for (int i = 0; i < 8; ++i) gq[i] = __builtin_nontemporal_load((const u32x4*)(Gw + (size_t)(4 * i + rq) * LDO + ck * 8));
#pragma unroll
        for (int i = 0; i < 8; ++i) { const u32x4 ov = *(const u32x4*)(ost + (4 * i + rq) * 128 + ck * 8); const u32x4 g = gq[i]; u32x4 w;
#define GMUL(a_, b_) cvtpk(__uint_as_float((a_) << 16) * __uint_as_float((b_) << 16), __uint_as_float((a_) & 0xffff0000u) * __uint_as_float((b_) & 0xffff0000u))
            w.x = GMUL(ov.x, g.x); w.y = GMUL(ov.y, g.y); w.z = GMUL(ov.z, g.z); w.w = GMUL(ov.w, g.w);
#undef GMUL
            *(u32x4*)(Ow + (size_t)(4 * i + rq) * LDO + ck * 8) = w; }
        asm volatile("s_waitcnt lgkmcnt(0)" ::: "memory");
    }
    if constexpr (F32) {
#pragma unroll
        for (int d0 = 0; d0 < 8; ++d0) S.qr[d0] = pack8(S.tq[2 * d0], S.tq[2 * d0 + 1]); }
#pragma unroll
    for (int d0 = 0; d0 < 8; ++d0) *reinterpret_cast<bf16x8*>(q_w + KSWZ(r32, (d0 * 16 + hi * 8) * 2)) = S.qr[d0];
    __syncthreads();
#undef RESC
#undef KBASE
#undef ACT
#undef MASKT
#undef SEAM_K0
#undef HALF_STEP
}
#undef ROW
#undef VMW
#undef VMWN
#undef SLOAD_H
#undef SWRITE_HK
#undef SWRITE_HV
#undef SWRITE_H
#undef SLOAD_F
#undef SWRITE_KF
#undef SWRITE_VF


#undef KSWZ
#undef SBAR
}
#define LAS __attribute__((address_space(3)))
typedef unsigned short bf16r;
typedef float f32x4 __attribute__((ext_vector_type(4)));
typedef float f32x16 __attribute__((ext_vector_type(16)));
typedef short bf16x8 __attribute__((ext_vector_type(8)));
typedef unsigned u32x4 __attribute__((ext_vector_type(4)));
typedef unsigned u32x2 __attribute__((ext_vector_type(2)));

constexpr int NTOK = 16384, DM = 2048, SEQL = 2048, NBATCH = 8, NMEM = 256, MAINW = 1536, MEMW = 512, NGRP = 96;
constexpr float EPSN = 1e-6f;
constexpr size_t MiB = (size_t)1 << 20;
constexpr size_t SM_RSTD0 = 0, SM_RSTDM = 64 * 1024, SM_ROWSQ0 = 128 * 1024, SM_ROWSQ1 = 192 * 1024, SM_RSTD1 = 256 * 1024,
                 SM_LOGF = 320 * 1024, SM_FCUM = 1152 * 1024, SM_WFT = 1984 * 1024, SM_QNRM = 2560 * 1024, SM_KNRM = 3328 * 1024;
constexpr size_t WS_WINA = 4 * MiB, WS_WKVB = 20 * MiB, WS_WGLU = 48 * MiB, WS_WMKV0 = 53 * MiB, WS_WMKV1 = 57 * MiB, WS_WOUT0 = 61 * MiB, WS_WOUT1 = 69 * MiB,
                 WS_XB = 77 * MiB, WS_MEMB = 141 * MiB, WS_MKV = 149 * MiB, WS_PROJ = 157 * MiB, WS_KVB = 285 * MiB, WS_CAT = 381 * MiB, WS_OB = 445 * MiB, WS_BAR = 509 * MiB, WS_END = 509 * MiB + 65536;
constexpr int LDS_TOTAL = 147456;

struct Params { const float* in[23]; float* out; unsigned char* ws; };
enum { I_X = 0, I_MEM, I_PREG, I_POSTG, I_WINA, I_LRE, I_LIM, I_LSTEP, I_BRE, I_BIM, I_CRE, I_CIM, I_DSKIP, I_WGLU, I_BGLU, I_KVG, I_WKV, I_WFG, I_BFG, I_WINB, I_MEMG, I_WMKV, I_WOUT };

__device__ __forceinline__ float wave_sum(float v) {
#pragma unroll
    for (int o = 1; o < 64; o <<= 1) v += __shfl_xor(v, o);
    return v;
}
__device__ __forceinline__ unsigned pkbf(float lo, float hi) { return pg8::cvt_pk_bf16(lo, hi); }
#define LDS_FENCE() asm volatile("s_waitcnt lgkmcnt(0)" ::: "memory")

__device__ __forceinline__ void transpose_item(const float* W, const float* gs, int K, int N, bf16r* WT, int row_off, LAS float* scr, int item, int lane) {
    const int nblk = N / 32, kb = item / nblk, nb = item % nblk, k0 = 64 * kb, n0 = 32 * nb;
    const float* src = W + (size_t)(k0 + (lane >> 5)) * N + n0 + (lane & 31);
    float v[32];
#pragma unroll
    for (int i = 0; i < 32; ++i) v[i] = __builtin_nontemporal_load(src + (size_t)(2 * i) * N);
    const int c = lane & 7;
    f32x4 g0 = {1.f, 1.f, 1.f, 1.f}, g1 = {1.f, 1.f, 1.f, 1.f};
    if (gs) { g0 = *(const f32x4*)(gs + k0 + 8 * c); g1 = *(const f32x4*)(gs + k0 + 8 * c + 4); }
#pragma unroll
    for (int i = 0; i < 32; ++i) scr[(2 * i + (lane >> 5)) * 33 + (lane & 31)] = v[i];
    LDS_FENCE();
#pragma unroll
    for (int j = 0; j < 4; ++j) { const int n = (lane >> 3) + 8 * j; const LAS float* s = scr + (8 * c) * 33 + n;
        u32x4 o; o.x = pkbf(s[0 * 33] * g0[0], s[1 * 33] * g0[1]); o.y = pkbf(s[2 * 33] * g0[2], s[3 * 33] * g0[3]); o.z = pkbf(s[4 * 33] * g1[0], s[5 * 33] * g1[1]); o.w = pkbf(s[6 * 33] * g1[2], s[7 * 33] * g1[3]);
        *(u32x4*)(WT + (size_t)(row_off + n0 + n) * K + k0 + 8 * c) = o; }
    LDS_FENCE();
}
__device__ __forceinline__ void rows_to_bf16(const float* x, bf16r* o, float* rstd_out, int m0, int stride, int nrows, int lane) {
    f32x4 v[8];
    if (m0 < nrows) { const f32x4* xp = (const f32x4*)(x + (size_t)m0 * DM) + lane;
#pragma unroll
        for (int j = 0; j < 8; ++j) v[j] = __builtin_nontemporal_load(xp + 64 * j); }
    for (int m = m0; m < nrows; m += stride) {
        f32x4 vn[8]; const int mn = m + stride;
        if (mn < nrows) { const f32x4* xp = (const f32x4*)(x + (size_t)mn * DM) + lane;
#pragma unroll
            for (int j = 0; j < 8; ++j) vn[j] = __builtin_nontemporal_load(xp + 64 * j); }
        float s = 0.f;
#pragma unroll
        for (int j = 0; j < 8; ++j) s += (v[j][0] * v[j][0] + v[j][1] * v[j][1]) + (v[j][2] * v[j][2] + v[j][3] * v[j][3]);
        s = wave_sum(s);
        if (lane == 0) rstd_out[m] = 1.0f / sqrtf(s * (1.0f / DM) + EPSN);
        u32x2* op = (u32x2*)(o + (size_t)m * DM) + lane;
#pragma unroll
        for (int j = 0; j < 8; ++j) { u32x2 w; w.x = pkbf(v[j][0], v[j][1]); w.y = pkbf(v[j][2], v[j][3]); op[64 * j] = w; }
        if (mn < nrows) {
#pragma unroll
            for (int j = 0; j < 8; ++j) v[j] = vn[j]; }
    }
}

struct Sel0 { bf16r* proj;
    __device__ __forceinline__ pg8::SecInfo operator()(int cs) const {
        if (cs < 1536) return {proj, 0, 1536, 0, 0, nullptr};
        if (cs < 3072) return {proj + (size_t)NTOK * 1536, 1536, 2048, 0, 1, nullptr};
        if (cs < 3584) return {proj + (size_t)NTOK * 3584, 3072, 0, 4, 0, nullptr};
        return {proj + (size_t)NTOK * 1536 + 1536, 3584, 2048, 0, 1, nullptr}; } };
struct Sel1 { bf16r* kvb; bf16r* proj; float* qnrm; float* knrm;
    __device__ __forceinline__ pg8::SecInfo operator()(int cs) const {
        if (cs < 1536) return {kvb, 0, 0, 12, 0, knrm};
        if (cs < 3072) return {kvb + (size_t)NTOK * 1536, 1536, 0, 12, 0, nullptr};
        if (cs < 4608) return {proj, 3072, 0, 12, 0, qnrm};
        if (cs < 6144) return {proj + (size_t)NTOK * 1536, 4608, 2048, 0, 1, nullptr};
        if (cs < 6656) return {proj + (size_t)NTOK * 3584, 6144, 0, 4, 0, nullptr};
        return {proj + (size_t)NTOK * 1536 + 1536, 6656, 2048, 0, 1, nullptr}; } };
struct SelM { bf16r* mkv;
    __device__ __forceinline__ pg8::SecInfo operator()(int cs) const {
        if (cs < 512) return {mkv, 0, 0, 4, 0, nullptr};
        return {mkv + (size_t)NBATCH * NMEM * 512, 512, 0, 4, 0, nullptr}; } };

constexpr int SSM_XS = 80;
constexpr int SSM_WAVE_LDS = 128 * 36 * 4 + 32 * SSM_XS * 4;
typedef float __attribute__((may_alias)) f32_ma; typedef unsigned __attribute__((may_alias)) u32_ma;
typedef f32x4 __attribute__((may_alias)) f32x4_ma; typedef bf16x8 __attribute__((may_alias)) bf16x8_ma;
__device__ __forceinline__ int crow16(int r, int hi) { return (r & 3) + 8 * (r >> 2) + 4 * hi; }
__device__ __forceinline__ float gelu_tanh(float y) {
    const float t = y * y, a = y * __builtin_fmaf(t, -0.1029432395800235f, -2.302208198144325f);
    return y * __builtin_amdgcn_rcpf(1.f + __builtin_amdgcn_exp2f(a));
}
struct SsmCtx {
    f32_ma* Bu2; u32_ma* Xs; const bf16r* U; bf16r* YG; size_t tokb; int g, lane, c, hi, l16, kq;
    float ar, ai; bf16x8 Bf[4]; bf16x8 Cf[4]; float dsk[4];
};
__device__ __forceinline__ void ssm_s2(const SsmCtx& X, bf16x8 Uc) {
#pragma unroll
    for (int nt = 0; nt < 4; ++nt) {
        f32x16 a = {};
        a = __builtin_amdgcn_mfma_f32_32x32x16_bf16(Uc, X.Bf[nt], a, 0, 0, 0);
#pragma unroll
        for (int r4 = 0; r4 < 4; ++r4) { f32x4 v = {a[4 * r4], a[4 * r4 + 1], a[4 * r4 + 2], a[4 * r4 + 3]}; *(f32x4_ma*)(X.Bu2 + (32 * nt + X.c) * 36 + 8 * r4 + 4 * X.hi) = v; }
    }
}
__device__ __forceinline__ void ssm_s1(const SsmCtx& X, float& xr, float& xi) {
#pragma unroll
    for (int q = 0; q < 8; ++q) {
        const f32x4 re4 = *(const f32x4_ma*)(X.Bu2 + X.lane * 36 + 4 * q), im4 = *(const f32x4_ma*)(X.Bu2 + (64 + X.lane) * 36 + 4 * q);
#pragma unroll
        for (int e = 0; e < 4; ++e) {
            const float nr = X.ar * xr - X.ai * xi + re4[e], ni = X.ar * xi + X.ai * xr + im4[e];
            xr = nr; xi = ni; X.Xs[(4 * q + e) * SSM_XS + X.lane] = pkbf(xr, xi);
        }
    }
}
__device__ __forceinline__ void ssm_s3(const SsmCtx& X, bf16r* py, u32x2 us0, u32x2 us1) {
    f32x4 y0 = {0.f, 0.f, 0.f, 0.f}, y1 = {0.f, 0.f, 0.f, 0.f};
#pragma unroll
    for (int s = 0; s < 4; ++s) {
        const bf16x8 b0 = *(const bf16x8_ma*)(X.Xs + X.l16 * SSM_XS + 16 * s + 4 * X.kq), b1 = *(const bf16x8_ma*)(X.Xs + (16 + X.l16) * SSM_XS + 16 * s + 4 * X.kq);
        y0 = __builtin_amdgcn_mfma_f32_16x16x32_bf16(X.Cf[s], b0, y0, 0, 0, 0);
        y1 = __builtin_amdgcn_mfma_f32_16x16x32_bf16(X.Cf[s], b1, y1, 0, 0, 0);
    }
    y0[0] += X.dsk[0] * pg8::bf_lo(us0.x); y0[1] += X.dsk[1] * pg8::bf_hi(us0.x); y0[2] += X.dsk[2] * pg8::bf_lo(us0.y); y0[3] += X.dsk[3] * pg8::bf_hi(us0.y);
    y1[0] += X.dsk[0] * pg8::bf_lo(us1.x); y1[1] += X.dsk[1] * pg8::bf_hi(us1.x); y1[2] += X.dsk[2] * pg8::bf_lo(us1.y); y1[3] += X.dsk[3] * pg8::bf_hi(us1.y);
    u32x2 w0, w1;
    w0.x = pkbf(gelu_tanh(y0[0]), gelu_tanh(y0[1])); w0.y = pkbf(gelu_tanh(y0[2]), gelu_tanh(y0[3]));
    w1.x = pkbf(gelu_tanh(y1[0]), gelu_tanh(y1[1])); w1.y = pkbf(gelu_tanh(y1[2]), gelu_tanh(y1[3]));
    *(u32x2*)py = w0;
    *(u32x2*)(py + 16 * 1536) = w1;
}
#define SSM_BAR() asm volatile("s_waitcnt lgkmcnt(0)\n\ts_barrier" ::: "memory")
constexpr int SSM_TASK_LDS = 128 * 36 * 4 + 2 * 32 * SSM_XS * 4;
__device__ __forceinline__ void ssm_round(const Params& P, bool active, int role, int b, int g, unsigned char* wl, int lane) {
    SsmCtx X; X.g = g; X.lane = lane; X.c = lane & 31; X.hi = lane >> 5; X.l16 = lane & 15; X.kq = lane >> 4;
    const int c = X.c, hi = X.hi, l16 = X.l16, kq = X.kq;
    X.Bu2 = (f32_ma*)wl; u32_ma* Xs0 = (u32_ma*)(wl + 128 * 36 * 4); X.Xs = Xs0;
    X.U = (const bf16r*)(P.ws + WS_PROJ); X.YG = (bf16r*)(P.ws + WS_KVB); X.tokb = (size_t)b * SEQL;
    X.ar = 0.f; X.ai = 0.f;
    const bf16r* Ua = X.U + (X.tokb + c) * 1536 + g * 16 + 8 * hi;
    const bf16r* Us = X.U + (X.tokb + l16) * 1536 + g * 16 + 4 * kq;
    constexpr int NCH = SEQL / 32; constexpr size_t CHS = (size_t)32 * 1536;
    bf16x8 U0 = {}, U1 = {}, U2 = {}; u32x2 a0 = {0u, 0u}, a1 = {0u, 0u}, b0 = {0u, 0u}, b1 = {0u, 0u}, c0 = {0u, 0u}, c1 = {0u, 0u};
    if (active) {
        const float dt = __expf(P.in[I_LSTEP][g]), lr = P.in[I_LRE][g * 64 + lane], li = P.in[I_LIM][g * 64 + lane];
        const float mag = __expf(lr * dt); float rev = li * dt * 0.15915494309189535f; rev -= floorf(rev);
        const float ar = mag * __builtin_amdgcn_cosf(rev), ai = mag * __builtin_amdgcn_sinf(rev);
        const float den = lr * lr + li * li, cr = ((ar - 1.0f) * lr + ai * li) / den, ci = (ai * lr - (ar - 1.0f) * li) / den;
        X.ar = ar; X.ai = ai;
        if (role == 1) {
#pragma unroll
            for (int nt = 0; nt < 4; ++nt) {
                const int pp = 32 * nt + c, p = pp & 63; const float crp = __shfl(cr, p), cip = __shfl(ci, p);
                const f32x4 r0 = *(const f32x4*)(P.in[I_BRE] + ((size_t)(g * 64 + p)) * 16 + 8 * hi), r1 = *(const f32x4*)(P.in[I_BRE] + ((size_t)(g * 64 + p)) * 16 + 8 * hi + 4);
                const f32x4 i0 = *(const f32x4*)(P.in[I_BIM] + ((size_t)(g * 64 + p)) * 16 + 8 * hi), i1 = *(const f32x4*)(P.in[I_BIM] + ((size_t)(g * 64 + p)) * 16 + 8 * hi + 4);
                f32x4 v0, v1;
                if (nt < 2) { v0 = crp * r0 - cip * i0; v1 = crp * r1 - cip * i1; } else { v0 = crp * i0 + cip * r0; v1 = crp * i1 + cip * r1; }
                u32x4 w; w.x = pkbf(v0[0], v0[1]); w.y = pkbf(v0[2], v0[3]); w.z = pkbf(v1[0], v1[1]); w.w = pkbf(v1[2], v1[3]);
                X.Bf[nt] = __builtin_bit_cast(bf16x8, w);
            }
#pragma unroll
            for (int s = 0; s < 4; ++s) {
                const f32x4 re = *(const f32x4*)(P.in[I_CRE] + ((size_t)(g * 16 + l16)) * 64 + 16 * s + 4 * kq), im = *(const f32x4*)(P.in[I_CIM] + ((size_t)(g * 16 + l16)) * 64 + 16 * s + 4 * kq);
                u32x4 w; w.x = pkbf(re[0], -im[0]); w.y = pkbf(re[1], -im[1]); w.z = pkbf(re[2], -im[2]); w.w = pkbf(re[3], -im[3]);
                X.Cf[s] = __builtin_bit_cast(bf16x8, w);
            }
#pragma unroll
            for (int r = 0; r < 4; ++r) X.dsk[r] = P.in[I_DSKIP][g * 16 + 4 * kq + r];
            ssm_s2(X, *(const bf16x8*)Ua);
            U1 = *(const bf16x8*)(Ua + CHS); U2 = *(const bf16x8*)(Ua + 2 * CHS);
            a0 = *(const u32x2*)Us; a1 = *(const u32x2*)(Us + 16 * 1536);
        }
    }
    if (!active) {
        for (int i = 0; i < 2 * (NCH + 1) + 1; ++i) SSM_BAR();
    } else if (role == 0) {
        float xr = 0.f, xi = 0.f; const float nai_ = -X.ai; int wsel = 0;
        for (int ch = 0; ch <= NCH; ++ch) {
            SSM_BAR();
            f32x4 re4[8], im4[8];
            if (ch < NCH) {
#pragma unroll
                for (int q = 0; q < 8; ++q) { re4[q] = *(const f32x4_ma*)(X.Bu2 + lane * 36 + 4 * q); im4[q] = *(const f32x4_ma*)(X.Bu2 + (64 + lane) * 36 + 4 * q); }
            }
            SSM_BAR();
            if (ch < NCH) {
                u32_ma* Xw = Xs0 + wsel * (32 * SSM_XS); wsel ^= 1;
#pragma unroll
                for (int q = 0; q < 8; ++q) {
#pragma unroll
                    for (int e = 0; e < 4; ++e) {
                        float t1, t2, nr, ni;
                        asm("v_fma_f32 %0, %1, %2, %3" : "=v"(t1) : "v"(nai_), "v"(xi), "v"(re4[q][e]));
                        asm("v_fma_f32 %0, %1, %2, %3" : "=v"(t2) : "v"(X.ai), "v"(xr), "v"(im4[q][e]));
                        asm("v_fma_f32 %0, %1, %2, %3" : "=v"(nr) : "v"(X.ar), "v"(xr), "v"(t1));
                        asm("v_fma_f32 %0, %1, %2, %3" : "=v"(ni) : "v"(X.ar), "v"(xi), "v"(t2));
                        xr = nr; xi = ni; Xw[(4 * q + e) * SSM_XS + lane] = pkbf(xr, xi); } }
            }
        }
        SSM_BAR();
    } else {
        const bf16r* pU = Ua + 3 * CHS; const bf16r* pS = Us + CHS; bf16r* pY = X.YG + (X.tokb + l16) * 1536 + g * 16 + 4 * kq; int rsel = 0;
#define SSM_MM(DO_S2, DO_S3, DO_LD, U_USE, U_LD, S0_USE, S1_USE, S0_LD, S1_LD) do {                                               \
            SSM_BAR(); SSM_BAR();                                                                                      \
            if (DO_LD) { U_LD = *(const bf16x8*)pU; S0_LD = *(const u32x2*)pS; S1_LD = *(const u32x2*)(pS + 16 * 1536); pU += CHS; pS += CHS; } \
            __builtin_amdgcn_sched_barrier(0);                                                                                    \
            if (DO_S2) ssm_s2(X, U_USE);                                                                                          \
            if (DO_S3) { X.Xs = Xs0 + rsel * (32 * SSM_XS); rsel ^= 1; ssm_s3(X, pY, S0_USE, S1_USE); pY += CHS; }                \
            __builtin_amdgcn_sched_barrier(0);                                                                                    \
        } while (0)
#define MM_R0(S2_, S3_, LD) SSM_MM(S2_, S3_, LD, U1, U0, c0, c1, b0, b1)
#define MM_R1(S2_, S3_, LD) SSM_MM(S2_, S3_, LD, U2, U1, a0, a1, c0, c1)
#define MM_R2(S2_, S3_, LD) SSM_MM(S2_, S3_, LD, U0, U2, b0, b1, a0, a1)
        MM_R0(true, false, true);
        _Pragma("clang loop unroll(disable)") for (int ch = 1; ch + 2 < NCH - 1; ch += 3) { MM_R1(true, true, true); MM_R2(true, true, true); MM_R0(true, true, true); }
        static_assert((NCH - 2) % 3 == 2, "steady range 1..NCH-2 = 20 triples + 2");
        MM_R1(true, true, true);
        MM_R2(true, true, true);
        MM_R0(false, true, false);
        MM_R1(false, true, false);
#undef MM_R0
#undef MM_R1
#undef MM_R2
#undef SSM_MM
        SSM_BAR();
    }
}
__device__ __forceinline__ void ssm_phase(const Params& P, unsigned char* lds, int wave, int lane) {
    const int role = (wave == 0 || wave == 2 || wave == 6) ? 0 : 1;
    const int ts = (wave == 0 || wave == 4) ? 0 : (wave == 1 || wave == 2) ? 1 : (wave == 3 || wave == 6) ? 2 : 3;
    const int G = gridDim.x, rounds = (NBATCH * NGRP + 3 * G - 1) / (3 * G);
    for (int rd = 0; rd < rounds; ++rd) {
        const int tk = (rd * G + (int)blockIdx.x) * 3 + ts; const bool active = (ts < 3) && (tk < NBATCH * NGRP);
        const int tkc = active ? tk : 0;
        ssm_round(P, active, role, tkc / NGRP, tkc % NGRP, lds + (ts < 3 ? ts : 0) * SSM_TASK_LDS, lane);
    }
}

typedef att::BlockRef<att::bf16, att::bf16> ABlk;
__device__ __forceinline__ int fox_jlo(const Params& P, int bh, int qb, char* lds) {
    const int tid = opaque_tid(), lane = tid & 63, wave = tid >> 6;
    float* red = (float*)(lds + att::LDS_BYTES);
    const float* qn = (const float*)(P.ws + SM_QNRM) + (size_t)bh * SEQL + qb * 256; const float* kn = (const float*)(P.ws + SM_KNRM) + (size_t)bh * SEQL;
    float mq = (tid < 256) ? qn[tid] : 0.f, mk = 0.f;
    for (int i = tid; i < qb * 256; i += 512) mk = fmaxf(mk, kn[i]);
#pragma unroll
    for (int o = 1; o < 64; o <<= 1) { mq = fmaxf(mq, __shfl_xor(mq, o)); mk = fmaxf(mk, __shfl_xor(mk, o)); }
    if (lane == 0) { red[wave] = mq; red[8 + wave] = mk; }
    __syncthreads();
    float Q2 = 0.f, K2 = 0.f;
#pragma unroll
    for (int w = 0; w < 8; ++w) { Q2 = fmaxf(Q2, red[w]); K2 = fmaxf(K2, red[8 + w]); }
    const float bound = 2.04f * sqrtf(Q2 * K2) * att::SCALE + 30.f;
    const float* FC = (const float*)(P.ws + SM_FCUM) + (size_t)bh * SEQL; const float c0 = FC[qb * 256];
    const bool keep = (lane >= qb * 4) || (c0 - FC[lane < 32 ? 64 * lane + 63 : 2047] >= -bound);
    const unsigned long long m = __ballot(keep);
    const int jlo = __builtin_amdgcn_readfirstlane((int)__builtin_ctzll(m));
    __syncthreads();
    return jlo;
}
__device__ __forceinline__ void fox_item(int vc, int i, int& bh, int& qb) {
    const int gq = vc >> 3, j = vc & 7, e = j * 3 + i;
    const unsigned long long T0 = 7ull | (3ull << 5) | (0ull << 10) | ((7ull | 8ull) << 15) | (4ull << 20) | ((0ull | 8ull) << 25) | ((7ull | 16ull) << 30) | (2ull << 35) | (1ull << 40) | (6ull << 45) | (5ull << 50) | ((0ull | 16ull) << 55);
    const unsigned long long T1 = (6ull | 8ull) | ((4ull | 8ull) << 5) | ((1ull | 8ull) << 10) | ((6ull | 16ull) << 15) | ((3ull | 8ull) << 20) | ((1ull | 16ull) << 25) | ((5ull | 8ull) << 30) | ((4ull | 16ull) << 35) | ((2ull | 8ull) << 40) | ((5ull | 16ull) << 45) | ((3ull | 16ull) << 50) | ((2ull | 16ull) << 55);
    const unsigned code = (unsigned)(((e < 12) ? (T0 >> (5 * e)) : (T1 >> (5 * (e - 12)))) & 31ull);
    qb = code & 7; bh = gq * 3 + (code >> 3);
}
__device__ __forceinline__ void fox_jlo3(const Params& P, int vc, char* lds) {
    const int tid = opaque_tid(), lane = tid & 63, wave = tid >> 6;
    float* red = (float*)(lds + att::LDS_BYTES);
    int bh[3], qb[3]; float mq[3], mk[3];
#pragma unroll
    for (int i = 0; i < 3; ++i) { fox_item(vc, i, bh[i], qb[i]);
        const float* qn = (const float*)(P.ws + SM_QNRM) + (size_t)bh[i] * SEQL + qb[i] * 256; const float* kn = (const float*)(P.ws + SM_KNRM) + (size_t)bh[i] * SEQL;
        mq[i] = (tid < 256) ? qn[tid] : 0.f; mk[i] = 0.f;
#pragma unroll
        for (int k = 0; k < 4; ++k) { const int idx = tid + 512 * k; if (idx < qb[i] * 256) mk[i] = fmaxf(mk[i], kn[idx]); } }
#pragma unroll
    for (int o = 1; o < 64; o <<= 1) {
#pragma unroll
        for (int i = 0; i < 3; ++i) { mq[i] = fmaxf(mq[i], __shfl_xor(mq[i], o)); mk[i] = fmaxf(mk[i], __shfl_xor(mk[i], o)); } }
    if (lane == 0) {
#pragma unroll
        for (int i = 0; i < 3; ++i) { red[32 + 16 * i + wave] = mq[i]; red[32 + 16 * i + 8 + wave] = mk[i]; } }
    __syncthreads();
#pragma unroll
    for (int i = 0; i < 3; ++i) {
        float Q2 = 0.f, K2 = 0.f;
#pragma unroll
        for (int w = 0; w < 8; ++w) { Q2 = fmaxf(Q2, red[32 + 16 * i + w]); K2 = fmaxf(K2, red[32 + 16 * i + 8 + w]); }
        const float bound = 2.04f * sqrtf(Q2 * K2) * att::SCALE + 30.f;
        const float* FC = (const float*)(P.ws + SM_FCUM) + (size_t)bh[i] * SEQL; const float c0 = FC[qb[i] * 256];
        const bool keep = (lane >= qb[i] * 4) || (c0 - FC[lane < 32 ? 64 * lane + 63 : 2047] >= -bound);
        const unsigned long long m = __ballot(keep);
        if (tid == 0) ((int*)red)[16 + i] = (int)__builtin_ctzll(m);
    }
    __syncthreads();
}
template <bool FOX, int LYR> __device__ __forceinline__ bool att_get(const Params& P, int n, ABlk& r, int& skv, char* lds) {
    constexpr int PER = FOX ? 4 : 1;
    const int G = gridDim.x, bx = blockIdx.x;
    const int slot = n / PER, i = n % PER;
    const int vb = bx + slot * G; if (vb >= 256) return false;
    const int vc = (vb & 7) * 32 + (vb >> 3);
    const att::bf16* proj = (const att::bf16*)(P.ws + WS_PROJ); att::bf16* cat = (att::bf16*)(P.ws + WS_CAT);
    if (FOX && i < 3) {
        int bh, qb; fox_item(vc, i, bh, qb); const int b = bh / 12, h = bh % 12;
        const att::bf16* kvb = (const att::bf16*)(P.ws + WS_KVB);
        r.Q = proj + ((size_t)bh * SEQL + qb * 256) * 128; r.K = kvb + (size_t)bh * SEQL * 128; r.V = kvb + (size_t)NTOK * 1536 + (size_t)bh * SEQL * 128;
        r.O = cat + ((size_t)b * SEQL + qb * 256) * 2048 + h * 128; r.G = proj + (size_t)NTOK * 1536 + ((size_t)b * SEQL + qb * 256) * 2048 + h * 128;
        r.FC = (const float*)(P.ws + SM_FCUM) + (size_t)bh * SEQL; r.P0 = qb * 256; skv = SEQL;
        r.JLO = (slot == 0) ? __builtin_amdgcn_readfirstlane(((const int*)(lds + att::LDS_BYTES))[16 + i]) : fox_jlo(P, bh, qb, lds);
    } else {
        const int b = vc >> 5, hm = (vc >> 3) & 3, qb = vc & 7;
        const att::bf16* mkv = (const att::bf16*)(P.ws + WS_MKV) + (size_t)LYR * (2 * NBATCH * NMEM * 512);
        r.Q = proj + (size_t)NTOK * 3584 + ((size_t)(b * 4 + hm) * SEQL + qb * 256) * 128;
        r.K = mkv + (size_t)(b * 4 + hm) * NMEM * 128; r.V = mkv + (size_t)NBATCH * NMEM * 512 + (size_t)(b * 4 + hm) * NMEM * 128;
        r.O = cat + ((size_t)b * SEQL + qb * 256) * 2048 + 1536 + hm * 128; r.G = proj + (size_t)NTOK * 1536 + ((size_t)b * SEQL + qb * 256) * 2048 + 1536 + hm * 128;
        r.FC = nullptr; r.P0 = 256; skv = NMEM; r.JLO = 0;
    }
    return true;
}
template <bool FOX, int LYR> __device__ __forceinline__ void att_phase(const Params& P, char* lds) {
    ABlk cur, nxt; int skv = 0, skvn = 0;
    if (FOX && (int)blockIdx.x < 256) { const int vb = blockIdx.x; fox_jlo3(P, (vb & 7) * 32 + (vb >> 3), lds); }
    if (!att_get<FOX, LYR>(P, 0, cur, skv, lds)) return;
    att::Seam<att::bf16> S;
    att::causal_swa_prime<att::bf16, att::bf16>(cur, 1 << 20, lds, S);
    for (int n = 0;; ++n) {
        const bool more = att_get<FOX, LYR>(P, n + 1, nxt, skvn, lds);
        if (!more) { nxt = cur; skvn = skv; }
        att::causal_swa_block<att::bf16, att::bf16>(cur, nxt, skv, 1 << 20, lds, S);
        if (!more) break;
        cur = nxt; skv = skvn;
    }
}

#define XB_TMO      128
#define XB_XCNT(j)  (256  + 64 * (j))
#define XB_XSUB(j)  (1280 + 64 * (j))
#define XB_XGEN(j)  (2304 + 64 * (j))
#define XB_TOP      3328
#define XB_TOPGEN   3392
#define XCD_BAR_WORDS 3456
#define XB_SPIN_CAP (1u << 18)

__device__ __forceinline__ unsigned xb_ld(unsigned* p)              { return __hip_atomic_load(p, __ATOMIC_RELAXED, __HIP_MEMORY_SCOPE_AGENT); }
__device__ __forceinline__ unsigned xb_add(unsigned* p, unsigned v) { return __hip_atomic_fetch_add(p, v, __ATOMIC_RELAXED, __HIP_MEMORY_SCOPE_AGENT); }
__device__ __forceinline__ unsigned xb_xcc_id() { return (unsigned)__builtin_amdgcn_s_getreg((3 << 11) | 20) & 0xFu; }
#define XB_SPIN(cond, bar) do { unsigned _sp = 0; while (cond) { __builtin_amdgcn_s_sleep(1); \
    if ((++_sp & 255u) == 0u) { if (xb_ld(&(bar)[XB_TMO])) break; if (_sp > XB_SPIN_CAP) { atomicAdd(&(bar)[XB_TMO], 1u); break; } } } } while (0)

struct XcdBarrier {
    unsigned* bar; unsigned x;
    volatile LAS unsigned* st;
};

__device__ __forceinline__ XcdBarrier xcd_barrier_post(unsigned* bar, volatile LAS unsigned* st) {
    XcdBarrier b; b.bar = bar; b.x = xb_xcc_id(); b.st = st;
    if (threadIdx.x == 0) (void)xb_add(&bar[XB_XCNT(b.x)], 1u);
    return b;
}
__device__ __forceinline__ void xcd_barrier_complete(unsigned* bar, unsigned x, unsigned& nloc, unsigned& nx) {
    const unsigned G = gridDim.x * gridDim.y * gridDim.z;
    unsigned sum, cnt, mine, sp = 0u;
    for (;;) {
        sum = 0u; cnt = 0u; mine = 0u;
#pragma unroll
        for (unsigned j = 0; j < 16; ++j) { const unsigned c = xb_ld(&bar[XB_XCNT(j)]); sum += c; cnt += (c > 0u) ? 1u : 0u; mine = (j == x) ? c : mine; }
        if (sum == G) break;
        __builtin_amdgcn_s_sleep(1);
        if ((++sp & 255u) == 0u) { if (xb_ld(&bar[XB_TMO])) break; if (sp > XB_SPIN_CAP) { atomicAdd(&bar[XB_TMO], 1u); break; } }
    }
    nloc = mine > 0u ? mine : 1u; nx = cnt > 0u ? cnt : 1u;
}

__device__ __forceinline__ void xcd_barrier(const XcdBarrier& b) {
    asm volatile("s_waitcnt vmcnt(0)" ::: "memory");
    __syncthreads();
    if (threadIdx.x == 0) {
        unsigned* bar = b.bar;
        __builtin_amdgcn_s_waitcnt(0);
        unsigned nloc = b.st[0], nx = b.st[1];
        if (nloc == 0u) { xcd_barrier_complete(bar, b.x, nloc, nx); b.st[0] = nloc; b.st[1] = nx; }
        const unsigned old = xb_add(&bar[XB_XSUB(b.x)], 1u);
        const unsigned gen = old / nloc;
        if (old + 1u == (gen + 1u) * nloc) {
            __builtin_amdgcn_fence(__ATOMIC_RELEASE, "agent");
            asm volatile("s_waitcnt vmcnt(0)" ::: "memory");
            const unsigned og = xb_add(&bar[XB_TOP], 1u);
            const unsigned tg = og / nx;
            if (og + 1u == (tg + 1u) * nx) xb_add(&bar[XB_TOPGEN], 1u);
            else XB_SPIN(xb_ld(&bar[XB_TOPGEN]) == tg, bar);
            __builtin_amdgcn_fence(__ATOMIC_ACQUIRE, "agent");
            xb_add(&bar[XB_XGEN(b.x)], 1u);
            asm volatile("s_waitcnt vmcnt(0)" ::: "memory");
        } else {
            XB_SPIN(xb_ld(&bar[XB_XGEN(b.x)]) == gen, bar);
            __builtin_amdgcn_fence(__ATOMIC_ACQUIRE, "agent");
            asm volatile("s_waitcnt vmcnt(0)" ::: "memory");
        }
    }
    __syncthreads();
}

#ifndef PH_MASK
#define PH_MASK 0x7ff
#endif
#define PH(k) if constexpr ((PH_MASK >> (k)) & 1)
#ifndef REP_MASK
#define REP_MASK 0
#endif
#define REP(k) for (int rep_ = 0; rep_ <= ((REP_MASK >> (k)) & 1); ++rep_)
__global__ void __launch_bounds__(512, 2) yoco_fwd(Params P) {
    extern __shared__ __attribute__((aligned(16))) unsigned char lds[];
    cg::grid_group grid = cg::this_grid();
    volatile LAS unsigned* bst = (volatile LAS unsigned*)((LAS unsigned char*)lds + (LDS_TOTAL - 64));
    if (threadIdx.x == 0) { bst[0] = 0u; bst[1] = 0u; }
    __syncthreads();
    const XcdBarrier xbar = xcd_barrier_post((unsigned*)(P.ws + WS_BAR), bst);
#define GRID_SYNC() xcd_barrier(xbar)
    const int G = gridDim.x, NGW = G * 8;
#define PHASE_IDS() const int tid = opaque_tid(), lane = tid & 63, wave = __builtin_amdgcn_readfirstlane(tid >> 6), gw = blockIdx.x * 8 + wave; (void)lane; (void)gw
    unsigned char* ws = P.ws;
    float* rstd0 = (float*)(ws + SM_RSTD0); float* rstdm = (float*)(ws + SM_RSTDM); float* rowsq0 = (float*)(ws + SM_ROWSQ0); float* rowsq1 = (float*)(ws + SM_ROWSQ1);
    float* rstd1 = (float*)(ws + SM_RSTD1); float* logf_ = (float*)(ws + SM_LOGF); float* fcum = (float*)(ws + SM_FCUM); float* wft = (float*)(ws + SM_WFT);
    bf16r* xb = (bf16r*)(ws + WS_XB); bf16r* memb = (bf16r*)(ws + WS_MEMB); bf16r* proj = (bf16r*)(ws + WS_PROJ); bf16r* kvb = (bf16r*)(ws + WS_KVB);
    bf16r* cat = (bf16r*)(ws + WS_CAT); bf16r* ob = (bf16r*)(ws + WS_OB); bf16r* mkv = (bf16r*)(ws + WS_MKV);
    LAS unsigned char* glds = (LAS unsigned char*)lds;

    REP(0) {
    PH(0) { PHASE_IDS();
        LAS float* scr = (LAS float*)((LAS unsigned char*)lds + wave * 16384);
        constexpr int I_A = 32 * 128, I_GLU = 24 * 48, I_MK = 32 * 32, I_O = 32 * 64;
        constexpr int NIT = I_A + I_GLU + 2 * I_MK + I_O;
        for (int it = gw; it < NIT; it += NGW) {
            int r = it;
            if (r < I_A) { transpose_item(P.in[I_WINA], P.in[I_PREG], 2048, 4096, (bf16r*)(ws + WS_WINA), 0, scr, r, lane); continue; } r -= I_A;
            if (r < I_GLU) { transpose_item(P.in[I_WGLU], nullptr, 1536, 1536, (bf16r*)(ws + WS_WGLU), 0, scr, r, lane); continue; } r -= I_GLU;
            if (r < I_MK) { transpose_item(P.in[I_WMKV], P.in[I_MEMG], 2048, 1024, (bf16r*)(ws + WS_WMKV0), 0, scr, r, lane); continue; } r -= I_MK;
            if (r < I_MK) { transpose_item(P.in[I_WMKV] + (size_t)2048 * 1024, P.in[I_MEMG] + 2048, 2048, 1024, (bf16r*)(ws + WS_WMKV1), 0, scr, r, lane); continue; } r -= I_MK;
            transpose_item(P.in[I_WOUT], nullptr, 2048, 2048, (bf16r*)(ws + WS_WOUT0), 0, scr, r, lane);
        }
        rows_to_bf16(P.in[I_X], xb, rstd0, gw, NGW, NTOK, lane);
        rows_to_bf16(P.in[I_MEM], memb, rstdm, gw, NGW, NBATCH * NMEM, lane);
        for (int i = blockIdx.x * 512 + tid; i < NTOK; i += G * 512) { rowsq0[i] = 0.f; rowsq1[i] = 0.f; }
        for (int i = blockIdx.x * 512 + tid; i < 2 * 96 * SEQL; i += G * 512) ((float*)(ws + SM_QNRM))[i] = 0.f;
        for (int i = blockIdx.x * 512 + tid; i < 12 * DM; i += G * 512) { const int h = i / DM, k = i % DM; wft[i] = P.in[I_KVG][k] * P.in[I_WFG][k * 12 + h]; }
    }
    if (P.ws == nullptr) grid.sync();
    GRID_SYNC();
    }
    REP(1) {
    PH(1) {
        { pg8::Gemm g{xb, (const bf16r*)(ws + WS_WINA), NTOK, 4096, DM}; pg8::StaticOrder S; S.init(NTOK, 4096, G, (int)blockIdx.x);
          pg8::EpiProj<Sel0> E{rstd0, Sel0{proj}, 11};
          pg8::gemm_phase<pg8::EpiProj<Sel0>, pg8::StaticOrder, true, true>(glds, g, S, E); }
    }
    GRID_SYNC();
    }
    REP(2) {
    PH(2) { PHASE_IDS(); ssm_phase(P, lds, wave, lane);
    __syncthreads(); }
    GRID_SYNC();
    }
    REP(3) {
    PH(3) {
        { pg8::Gemm g{kvb  , (const bf16r*)(ws + WS_WGLU), NTOK, 1536, 1536}; pg8::StaticOrder S; S.init(NTOK, 1536, G, (int)blockIdx.x);
          pg8::EpiGlu E{kvb, proj + (size_t)NTOK * 1536, P.in[I_BGLU], cat};
          pg8::gemm_phase<pg8::EpiGlu, pg8::StaticOrder, true, true>(glds, g, S, E); }
        { pg8::Gemm g{memb, (const bf16r*)(ws + WS_WMKV0), NBATCH * NMEM, 1024, DM}; pg8::StaticOrder S; S.init(NBATCH * NMEM, 1024, G, (int)((blockIdx.x + G - G / 2) % G));
          pg8::EpiProj<SelM> E{rstdm, SelM{mkv}, 8};
          pg8::gemm_phase<pg8::EpiProj<SelM>, pg8::StaticOrder, true, true>(glds, g, S, E); }
        { pg8::Gemm g{memb, (const bf16r*)(ws + WS_WMKV1), NBATCH * NMEM, 1024, DM}; pg8::StaticOrder S; S.init(NBATCH * NMEM, 1024, G, (int)((blockIdx.x + G - G / 2 - 32) % G));
          pg8::EpiProj<SelM> E{rstdm, SelM{mkv + (size_t)2 * NBATCH * NMEM * 512}, 8};
          pg8::gemm_phase<pg8::EpiProj<SelM>, pg8::StaticOrder, true, true>(glds, g, S, E); }
        if ((int)blockIdx.x >= G - G / 4) {
            PHASE_IDS();
            LAS float* scr = (LAS float*)((LAS unsigned char*)lds + wave * 16384);
            constexpr int I_B = 32 * 128, I_KV = 32 * 96, I_O = 32 * 64, NIT2 = I_B + I_KV + I_O;
            const int gw2 = ((int)blockIdx.x - (G - G / 4)) * 8 + wave, NGW2 = (G / 4) * 8;
            for (int it = gw2; it < NIT2; it += NGW2) {
                int r = it;
                if (r < I_B) { transpose_item(P.in[I_WINB], P.in[I_PREG] + 2048, 2048, 4096, (bf16r*)(ws + WS_WKVB), 3072, scr, r, lane); continue; } r -= I_B;
                if (r < I_KV) { transpose_item(P.in[I_WKV], P.in[I_KVG], 2048, 3072, (bf16r*)(ws + WS_WKVB), 0, scr, r, lane); continue; } r -= I_KV;
                transpose_item(P.in[I_WOUT] + (size_t)2048 * 2048, nullptr, 2048, 2048, (bf16r*)(ws + WS_WOUT1), 0, scr, r, lane);
            }
        }
    }
    GRID_SYNC();
    }
    REP(10) {
    PH(10) att_phase<false, 0>(P, (char*)lds);
    GRID_SYNC();
    }
    REP(4) {
    PH(4) { pg8::Gemm g{cat, (const bf16r*)(ws + WS_WOUT0), NTOK, DM, DM}; pg8::StaticOrder S; S.init(NTOK, DM, G, (int)blockIdx.x);
      pg8::EpiOut E{ob, rep_ ? rowsq0 + 65536 * 9 : rowsq0};
      pg8::gemm_phase<pg8::EpiOut, pg8::StaticOrder, true, true>(glds, g, S, E); }
    GRID_SYNC();
    }
    REP(5) {
    PH(5) { PHASE_IDS();
        float* wl = (float*)lds;
        for (int i = tid; i < 12 * DM / 4; i += 512) ((f32x4*)wl)[i] = ((const f32x4*)wft)[i];
        __syncthreads();
        const float* gp = P.in[I_POSTG];
        f32x4 gv[8];
#pragma unroll
        for (int j = 0; j < 8; ++j) gv[j] = ((const f32x4*)gp)[lane + 64 * j];
        const float bfg = (lane < 12) ? P.in[I_BFG][lane] : 0.f;
        u32x2 xv[8]; u32x2 ov[8]; float rq = 0.f;
        if (gw < NTOK) { const u32x2* xp = (const u32x2*)(xb + (size_t)gw * DM) + lane; const u32x2* op = (const u32x2*)(ob + (size_t)gw * DM) + lane; rq = rowsq0[gw];
#pragma unroll
            for (int j = 0; j < 8; ++j) { xv[j] = __builtin_nontemporal_load(xp + 64 * j); ov[j] = __builtin_nontemporal_load(op + 64 * j); } }
        for (int m = gw; m < NTOK; m += NGW) {
            const float rso = 1.0f / sqrtf(rq * (1.0f / DM) + EPSN);
            u32x2 xn[8]; u32x2 on[8]; float rqn = 0.f; const int mn = m + NGW;
            if (mn < NTOK) { const u32x2* xp = (const u32x2*)(xb + (size_t)mn * DM) + lane; const u32x2* op = (const u32x2*)(ob + (size_t)mn * DM) + lane; rqn = rowsq0[mn];
#pragma unroll
                for (int j = 0; j < 8; ++j) { xn[j] = __builtin_nontemporal_load(xp + 64 * j); on[j] = __builtin_nontemporal_load(op + 64 * j); } }
            u32x2* hb = (u32x2*)(xb + (size_t)m * DM) + lane;
            f32x4 hv[8]; float s = 0.f;
#pragma unroll
            for (int j = 0; j < 8; ++j) {
                f32x4 h; h[0] = pg8::bf_lo(xv[j].x) + pg8::bf_lo(ov[j].x) * rso * gv[j][0]; h[1] = pg8::bf_hi(xv[j].x) + pg8::bf_hi(ov[j].x) * rso * gv[j][1];
                h[2] = pg8::bf_lo(xv[j].y) + pg8::bf_lo(ov[j].y) * rso * gv[j][2]; h[3] = pg8::bf_hi(xv[j].y) + pg8::bf_hi(ov[j].y) * rso * gv[j][3];
                hv[j] = h; s += (h[0] * h[0] + h[1] * h[1]) + (h[2] * h[2] + h[3] * h[3]);
                u32x2 w; w.x = pkbf(h[0], h[1]); w.y = pkbf(h[2], h[3]); hb[64 * j] = w; }
            if (mn < NTOK) {
#pragma unroll
                for (int j = 0; j < 8; ++j) { xv[j] = xn[j]; ov[j] = on[j]; } rq = rqn; }
            s = wave_sum(s); const float rs1 = 1.0f / sqrtf(s * (1.0f / DM) + EPSN);
            if (lane == 0) rstd1[m] = rs1;
            float dh[12];
#pragma unroll
            for (int h = 0; h < 12; ++h) {
                f32x4 wa[8];
#pragma unroll
                for (int j = 0; j < 8; ++j) wa[j] = *(const f32x4*)(wl + h * DM + (lane + 64 * j) * 4);
                __builtin_amdgcn_sched_barrier(0);
                float da = 0.f;
#pragma unroll
                for (int j = 0; j < 8; ++j) da += (hv[j][0] * wa[j][0] + hv[j][1] * wa[j][1]) + (hv[j][2] * wa[j][2] + hv[j][3] * wa[j][3]);
                dh[h] = da;
                __builtin_amdgcn_sched_barrier(0);
            }
#pragma unroll
            for (int o = 1; o < 64; o <<= 1) {
#pragma unroll
                for (int h = 0; h < 12; ++h) dh[h] += __shfl_xor(dh[h], o); }
            float mine = 0.f;
#pragma unroll
            for (int h = 0; h < 12; ++h) if (lane == h) mine = dh[h];
            if (lane < 12) { const float a = mine * rs1 + bfg; const float lf = fminf(a, 0.f) - __logf(1.f + __expf(-fabsf(a)));
                const int b = m >> 11, sidx = m & 2047; logf_[((size_t)(b * 12 + lane)) * SEQL + sidx] = lf; }
        }
    }
    GRID_SYNC();
    }
    REP(6) {
    PH(6) { PHASE_IDS();
        if (wave == 0) for (int rwi = blockIdx.x; rwi < NBATCH * 12; rwi += G) {
            const float* src = logf_ + (size_t)rwi * SEQL + lane * 32; float* dst = fcum + (size_t)rwi * SEQL + lane * 32;
            float v[32]; float run = 0.f;
#pragma unroll
            for (int q = 0; q < 8; ++q) { const f32x4 t = ((const f32x4*)src)[q]; v[4 * q] = t[0]; v[4 * q + 1] = t[1]; v[4 * q + 2] = t[2]; v[4 * q + 3] = t[3]; }
#pragma unroll
            for (int e = 0; e < 32; ++e) { run += v[e]; v[e] = run; }
            float incl = run;
#pragma unroll
            for (int o = 1; o < 64; o <<= 1) { const float t = __shfl_up(incl, o); if (lane >= o) incl += t; }
            const float excl = incl - run;
#pragma unroll
            for (int q = 0; q < 8; ++q) { f32x4 t = {v[4 * q] + excl, v[4 * q + 1] + excl, v[4 * q + 2] + excl, v[4 * q + 3] + excl}; ((f32x4*)dst)[q] = t; }
        }
        pg8::Gemm g{xb, (const bf16r*)(ws + WS_WKVB), NTOK, 7168, DM}; pg8::StaticOrder S; S.init(NTOK, 7168, G, (int)blockIdx.x);
        pg8::EpiProj<Sel1> E{rstd1, Sel1{kvb, proj, (float*)(ws + SM_QNRM), (float*)(ws + SM_KNRM)}, 11};
        pg8::gemm_phase<pg8::EpiProj<Sel1>, pg8::StaticOrder, true, true>(glds, g, S, E);
    }
    GRID_SYNC();
    }
    REP(7) {
    PH(7) att_phase<true, 1>(P, (char*)lds);
    GRID_SYNC();
    }
    REP(8) {
    PH(8) { pg8::Gemm g{cat, (const bf16r*)(ws + WS_WOUT1), NTOK, DM, DM}; pg8::StaticOrder S; S.init(NTOK, DM, G, (int)blockIdx.x);
      pg8::EpiOut E{ob, rep_ ? rowsq0 + 65536 * 9 : rowsq1};
      pg8::gemm_phase<pg8::EpiOut, pg8::StaticOrder, true, true>(glds, g, S, E); }
    GRID_SYNC();
    }
    REP(9) {
    PH(9) { PHASE_IDS();
        const float* gp = P.in[I_POSTG] + DM;
        f32x4 gv[8];
#pragma unroll
        for (int j = 0; j < 8; ++j) gv[j] = ((const f32x4*)gp)[lane + 64 * j];
        u32x2 hv[8]; u32x2 ov[8]; float rq = 0.f;
        if (gw < NTOK) { const u32x2* hp = (const u32x2*)(xb + (size_t)gw * DM) + lane; const u32x2* op = (const u32x2*)(ob + (size_t)gw * DM) + lane; rq = rowsq1[gw];
#pragma unroll
            for (int j = 0; j < 8; ++j) { hv[j] = __builtin_nontemporal_load(hp + 64 * j); ov[j] = __builtin_nontemporal_load(op + 64 * j); } }
        for (int m = gw; m < NTOK; m += NGW) {
            const float rso = 1.0f / sqrtf(rq * (1.0f / DM) + EPSN);
            u32x2 hn[8]; u32x2 on[8]; float rqn = 0.f; const int mn = m + NGW;
            if (mn < NTOK) { const u32x2* hp2 = (const u32x2*)(xb + (size_t)mn * DM) + lane; const u32x2* op = (const u32x2*)(ob + (size_t)mn * DM) + lane; rqn = rowsq1[mn];
#pragma unroll
                for (int j = 0; j < 8; ++j) { hn[j] = __builtin_nontemporal_load(hp2 + 64 * j); on[j] = __builtin_nontemporal_load(op + 64 * j); } }
            f32x4* hp = (f32x4*)(P.out + (size_t)m * DM) + lane;
#pragma unroll
            for (int j = 0; j < 8; ++j) { f32x4 h;
                h[0] = pg8::bf_lo(hv[j].x) + pg8::bf_lo(ov[j].x) * rso * gv[j][0]; h[1] = pg8::bf_hi(hv[j].x) + pg8::bf_hi(ov[j].x) * rso * gv[j][1];
                h[2] = pg8::bf_lo(hv[j].y) + pg8::bf_lo(ov[j].y) * rso * gv[j][2]; h[3] = pg8::bf_hi(hv[j].y) + pg8::bf_hi(ov[j].y) * rso * gv[j][3];
                __builtin_nontemporal_store(h, hp + 64 * j); }
            if (mn < NTOK) {
#pragma unroll
                for (int j = 0; j < 8; ++j) { hv[j] = hn[j]; ov[j] = on[j]; } rq = rqn; }
        }
    }
    }
}

extern "C" void kernel_launch(void* const* d_in, const int* in_sizes, int n_in, void* d_out, int out_size, void* d_ws, size_t ws_size, hipStream_t stream) {
    static int grid = 0;
    if (grid == 0) {
        if (n_in != 23 || out_size != NTOK * DM || ws_size < WS_END) { fprintf(stderr, "kernel_launch: unexpected shapes: n_in %d out %d ws %zu (need %zu)\n", n_in, out_size, ws_size, (size_t)WS_END); grid = -1; return; }
        int dev = 0, cus = 0, per_cu = 0;
        (void)hipGetDevice(&dev); (void)hipDeviceGetAttribute(&cus, hipDeviceAttributeMultiprocessorCount, dev);
        if (hipFuncSetAttribute((const void*)yoco_fwd, hipFuncAttributeMaxDynamicSharedMemorySize, LDS_TOTAL) != hipSuccess) { fprintf(stderr, "kernel_launch: hipFuncSetAttribute failed\n"); grid = -1; return; }
        if (hipOccupancyMaxActiveBlocksPerMultiprocessor(&per_cu, (const void*)yoco_fwd, 512, LDS_TOTAL) != hipSuccess || per_cu < 1) { fprintf(stderr, "kernel_launch: occupancy query says %d\n", per_cu); per_cu = 1; }
        (void)hipGetLastError();
        grid = cus * (per_cu > 1 ? 1 : per_cu);
        if (grid <= 0) grid = 256;
    }
    if (grid < 0) return;
    if (hipMemsetAsync((char*)d_ws + WS_BAR, 0, 16384, stream) != hipSuccess) { fprintf(stderr, "kernel_launch: hipMemsetAsync failed\n"); return; }
    Params p{};
    for (int i = 0; i < 23; ++i) p.in[i] = (const float*)d_in[i];
    p.out = (float*)d_out; p.ws = (unsigned char*)d_ws;
    void* args[] = {&p};
    hipError_t e = hipLaunchCooperativeKernel((const void*)yoco_fwd, dim3(grid), dim3(512), args, LDS_TOTAL, stream);
    if (e != hipSuccess) fprintf(stderr, "cooperative launch failed: %s (grid %d)\n", hipGetErrorString(e), grid);
}
```
